# Optimizing an MI355X kernel written in HIP

```python
import math
import jax
import jax.numpy as jnp
from jax import lax
import numpy as np

D_MODEL = 1024
BATCH = 4
SEQ = 8192
DEPTH = 2

GRID_W = 64
CTX_LEN = 256
N_BRANCH = 4
BRANCH_W = D_MODEL // N_BRANCH
HEAD_DIM = 64
BRANCH_HEADS = BRANCH_W // HEAD_DIM
BLOCK = 128
ROPE_BASE = 10000.0
NORM_EPS = 1e-6
NEG_INF = -1e30
ATT_Q_HEADS = BRANCH_HEADS
ATT_KV_HEADS = BRANCH_HEADS // 2
WINDOW = 128
RET_HEADS = BRANCH_HEADS
RET_CHUNK = 128
RET_GN_EPS = 1e-5
MLA_HEADS = BRANCH_HEADS
MLA_Q_RANK = 256
MLA_KV_RANK = 128
MLA_NOPE = HEAD_DIM
MLA_ROPE = HEAD_DIM // 2
MLA_V = HEAD_DIM
RWKV_HEADS = BRANCH_HEADS
RWKV_DECAY_RANK = 64
RWKV_A_RANK = 64
RWKV_GATE_RANK = 128
RWKV_GN_EPS = 64e-5
N_EXPERTS = 64
N_GROUPS = 8
EXPERTS_PER_GROUP = N_EXPERTS // N_GROUPS
TOP_K = 2
EXPERT_FF = 512
MOE_BLOCK = 256
A_SIZES = (ATT_Q_HEADS * HEAD_DIM, ATT_KV_HEADS * HEAD_DIM, ATT_KV_HEADS * HEAD_DIM)
RET_SIZES = (BRANCH_W,) * 5
MLA_SIZES = (MLA_Q_RANK, MLA_KV_RANK, MLA_ROPE)
RWKV_SIZES = (BRANCH_W, BRANCH_W, BRANCH_W, RWKV_DECAY_RANK, RWKV_DECAY_RANK,
              RWKV_A_RANK, RWKV_A_RANK, RWKV_GATE_RANK)
GROUP_SIZES = (sum(A_SIZES), sum(RET_SIZES), sum(MLA_SIZES), sum(RWKV_SIZES))
N_IN = sum(GROUP_SIZES)
F32 = jnp.float32

kernel_name = 'hybrid_gated_four_mixer_moe_dit'


def split_sizes(x, sizes):
    out, o = [], 0
    for n in sizes:
        out.append(x[..., o:o + n])
        o += n
    return out


def heads(x, h):
    return x.reshape(x.shape[:-1] + (h, x.shape[-1] // h))


def rms_norm(x, g):
    xf = x.astype(F32)
    y = xf * lax.rsqrt(jnp.mean(xf * xf, axis=-1, keepdims=True) + NORM_EPS)
    return (y * g.astype(F32)).astype(x.dtype)


def head_norm(x, eps):
    xf = x.astype(F32)
    xc = xf - jnp.mean(xf, axis=-1, keepdims=True)
    return xc * lax.rsqrt(jnp.mean(xc * xc, axis=-1, keepdims=True) + eps)


def adaln(h, g, shift, scale):
    return rms_norm(h, g) * (1 + scale) + shift


def rope_tables(pos, dim):
    inv = ROPE_BASE ** (-jnp.arange(0, dim, 2, dtype=F32) / dim)
    ang = pos[:, None] * inv[None, :]
    return jnp.cos(ang), jnp.sin(ang)


def rope_rotate(x, cos, sin):
    m = x.shape[-1] // 2
    x1, x2 = x[..., :m], x[..., m:]
    c = cos[None, :, None, :]
    s = sin[None, :, None, :]
    return jnp.concatenate([x1 * c - x2 * s, x2 * c + x1 * s], axis=-1).astype(x.dtype)


def axial_tables(seq, dim):
    rows = seq // GRID_W
    row = jnp.repeat(jnp.arange(rows, dtype=F32), GRID_W)
    col = jnp.broadcast_to(jnp.arange(GRID_W, dtype=F32)[None, :], (rows, GRID_W)).reshape(-1)
    return rope_tables(row, dim // 2), rope_tables(col, dim // 2)


def axial_rope(x, tabs):
    (cos_r, sin_r), (cos_c, sin_c) = tabs
    half = x.shape[-1] // 2
    return jnp.concatenate([rope_rotate(x[..., :half], cos_r, sin_r),
                            rope_rotate(x[..., half:], cos_c, sin_c)], axis=-1)


def window_gqa(q, k, v, k_ctx, v_ctx, sink):
    b, s, hq, d = q.shape
    g = hq // ATT_KV_HEADS
    nb = s // BLOCK
    nw = 3 * BLOCK
    nc = k_ctx.shape[1]
    qb = (q * d ** -0.5).reshape(b, nb, BLOCK, ATT_KV_HEADS, g, d)
    pad = ((0, 0), (BLOCK, BLOCK), (0, 0), (0, 0))
    kp = jnp.pad(k, pad).reshape(b, nb + 2, BLOCK, ATT_KV_HEADS, d)
    vp = jnp.pad(v, pad).reshape(b, nb + 2, BLOCK, ATT_KV_HEADS, d)
    kw = jnp.concatenate([kp[:, :-2], kp[:, 1:-1], kp[:, 2:]], axis=2)
    vw = jnp.concatenate([vp[:, :-2], vp[:, 1:-1], vp[:, 2:]], axis=2)
    blk0 = jnp.arange(nb)[:, None, None] * BLOCK
    q_pos = blk0 + jnp.arange(BLOCK)[None, :, None]
    k_pos = blk0 - BLOCK + jnp.arange(nw)[None, None, :]
    valid = (jnp.abs(k_pos - q_pos) <= WINDOW) & (k_pos >= 0) & (k_pos < s)
    s_win = jnp.einsum('bnqhgd,bnkhd->bnhgqk', qb, kw).astype(F32)
    s_win = jnp.where(valid[None, :, None, None], s_win, NEG_INF)
    s_ctx = jnp.einsum('bnqhgd,bchd->bnhgqc', qb, k_ctx).astype(F32)
    s_sink = jnp.broadcast_to(sink.astype(F32).reshape(ATT_KV_HEADS, g, 1, 1), s_win.shape[:-1] + (1,))
    p = jax.nn.softmax(jnp.concatenate([s_win, s_ctx, s_sink], axis=-1), axis=-1).astype(v.dtype)
    o = (jnp.einsum('bnhgqk,bnkhd->bnqhgd', p[..., :nw], vw)
         + jnp.einsum('bnhgqc,bchd->bnqhgd', p[..., nw:nw + nc], v_ctx))
    return o.reshape(b, s, hq * d)


def ctx_gqa(q, k, v, sink):
    b, l, hq, d = q.shape
    g = hq // ATT_KV_HEADS
    qg = (q * d ** -0.5).reshape(b, l, ATT_KV_HEADS, g, d)
    sc = jnp.einsum('bqhgd,bkhd->bhgqk', qg, k).astype(F32)
    s_sink = jnp.broadcast_to(sink.astype(F32).reshape(ATT_KV_HEADS, g, 1, 1), sc.shape[:-1] + (1,))
    p = jax.nn.softmax(jnp.concatenate([sc, s_sink], axis=-1), axis=-1).astype(v.dtype)
    o = jnp.einsum('bhgqk,bkhd->bqhgd', p[..., :l], v)
    return o.reshape(b, l, hq * d)


def retention_log_gammas():
    lg = jnp.log(1.0 - jnp.exp(jnp.linspace(math.log(1.0 / 32), math.log(1.0 / 512), 2 * RET_HEADS, dtype=F32)))
    return lg[0::2], lg[1::2]


def retention_chunked(q, k, v, log_gamma, s0):
    b, t, h, d = q.shape
    n = t // RET_CHUNK
    cl = RET_CHUNK
    qc = q.reshape(b, n, cl, h, d).astype(F32)
    kc = k.reshape(b, n, cl, h, d).astype(F32)
    vc = v.reshape(b, n, cl, h, d).astype(F32)
    idx = jnp.arange(cl, dtype=F32)
    rel = idx[:, None] - idx[None, :]
    d_intra = jnp.where(rel >= 0, jnp.exp(jnp.maximum(rel, 0.0)[None] * log_gamma[:, None, None]), 0.0)
    a_int = jnp.einsum('bnihd,bnjhd->bnhij', qc, kc) * d_intra
    o = jnp.einsum('bnhij,bnjhe->bnihe', a_int, vc)
    k_dec = kc * jnp.exp((cl - 1 - idx)[:, None] * log_gamma[None, :])[..., None]
    kv = jnp.einsum('bnjhd,bnjhe->nbhde', k_dec, vc)
    g_chunk = jnp.exp(cl * log_gamma)[:, None, None]

    def step(state, kv_n):
        return state * g_chunk + kv_n, state

    s_fin, s_prev = lax.scan(step, s0, kv)
    q_dec = qc * jnp.exp((idx + 1)[:, None] * log_gamma[None, :])[..., None]
    o = o + jnp.einsum('bnihd,nbhde->bnihe', q_dec, s_prev)
    return o.reshape(b, t, h, d), s_fin


def retention_mix(pb, cos, sin, lg_f, lg_b, s0f, s0b):
    bsz, t = pb.shape[:2]
    q, k, v, gf, gb = split_sizes(pb, RET_SIZES)
    q = rope_rotate(heads(q, RET_HEADS), cos, sin)
    k = rope_rotate(heads(k, RET_HEADS), cos, sin) * HEAD_DIM ** -0.5
    v = heads(v, RET_HEADS)
    yf, sf = retention_chunked(q, k, v, lg_f, s0f)
    yb, sb = retention_chunked(q[:, ::-1], k[:, ::-1], v[:, ::-1], lg_b, s0b)
    out = (jax.nn.silu(gf) * head_norm(yf, RET_GN_EPS).reshape(bsz, t, -1)
           + jax.nn.silu(gb) * head_norm(yb[:, ::-1], RET_GN_EPS).reshape(bsz, t, -1))
    return out.astype(pb.dtype), sf, sb


def mla_project(pc, lp):
    cq, ckv, kr = split_sizes(pc, MLA_SIZES)
    q = heads(rms_norm(cq, lp['g_qnorm']) @ lp['w_uq'], MLA_HEADS)
    kv = heads(rms_norm(ckv, lp['g_kvnorm']) @ lp['w_ukv'], MLA_HEADS)
    return q[..., :MLA_NOPE], q[..., MLA_NOPE:], kv[..., :MLA_NOPE], kr[:, :, None, :], kv[..., MLA_NOPE:]


def mla_attend(qn, qr, kn, kr, v):
    b, t, h, _ = qn.shape
    nb = t // BLOCK
    scale = (MLA_NOPE + MLA_ROPE) ** -0.5
    kr2 = kr[:, :, 0]

    def one_block(args):
        qn_b, qr_b = args
        sc = (jnp.einsum('bqhd,bkhd->bhqk', qn_b, kn) + jnp.einsum('bqhr,bkr->bhqk', qr_b, kr2)).astype(F32) * scale
        p = jax.nn.softmax(sc, axis=-1).astype(v.dtype)
        return jnp.einsum('bhqk,bkhd->bqhd', p, v)

    def to_blocks(z):
        return jnp.moveaxis(z.reshape(b, nb, BLOCK, h, z.shape[-1]), 1, 0)

    o = lax.map(one_block, (to_blocks(qn), to_blocks(qr)))
    return jnp.moveaxis(o, 0, 1).reshape(b, t, h * MLA_V)


def centred_shift(p):
    prev = jnp.pad(p, ((0, 0), (1, 0), (0, 0)))[:, :-1]
    nxt = jnp.pad(p, ((0, 0), (0, 1), (0, 0)))[:, 1:]
    return 0.5 * (prev + nxt)


def rwkv_features(pd, lp):
    z = pd + (centred_shift(pd) - pd) * lp['rwkv_mu']
    zr, zk, zv, zwf, zwb, zaf, zab, zg = split_sizes(z, RWKV_SIZES)
    r = heads(zr, RWKV_HEADS)
    k = heads(zk, RWKV_HEADS)
    v = heads(zv, RWKV_HEADS)
    g = jax.nn.sigmoid(zg) @ lp['rwkv_g_up']
    kk = (k * heads(lp['rwkv_k_k'], RWKV_HEADS)).astype(F32)
    kk = kk / jnp.maximum(jnp.sqrt(jnp.sum(kk * kk, axis=-1, keepdims=True)), 1e-12)
    k_a = heads(lp['rwkv_k_a'], RWKV_HEADS)
    dirs = []
    for di, (zw, za) in enumerate(((zwf, zaf), (zwb, zab))):
        logw = -jax.nn.softplus(-(lp['rwkv_w0'][di] + jnp.tanh(zw) @ lp['rwkv_w_up'][di]).astype(F32)) - 0.5
        w = heads(jnp.exp(-jnp.exp(logw)), RWKV_HEADS)
        a = heads(jax.nn.sigmoid((lp['rwkv_a0'][di] + za @ lp['rwkv_a_up'][di]).astype(F32)), RWKV_HEADS)
        dirs.append((w, k * (1 + (a - 1) * k_a), kk * a))
    return r, v, g, kk, dirs


def rwkv_scan(r, w, k, v, kk, b_, s0, reverse):
    xs = tuple(jnp.moveaxis(z.astype(F32), 1, 0) for z in (r, w, k, v, kk, b_))

    def step(st, inp):
        r_t, w_t, k_t, v_t, kk_t, b_t = inp
        sa = jnp.einsum('bhvk,bhk->bhv', st, -kk_t)
        st = st * w_t[:, :, None, :] + sa[..., None] * b_t[:, :, None, :] + v_t[..., None] * k_t[:, :, None, :]
        return st, jnp.einsum('bhvk,bhk->bhv', st, r_t)

    s_fin, y = lax.scan(step, s0, xs, reverse=reverse)
    return jnp.moveaxis(y, 0, 1), s_fin


def rwkv_mix(feat, lp, s0f, s0b):
    r, v, g, kk, dirs = feat
    (wf, kf, bf), (wb, kb, bb) = dirs
    yf, sf = rwkv_scan(r, wf, kf, v, kk, bf, s0f, False)
    yb, sb = rwkv_scan(r, wb, kb, v, kk, bb, s0b, True)
    y = head_norm(yf + yb, RWKV_GN_EPS) * heads(lp['rwkv_lnx_w'], RWKV_HEADS) + heads(lp['rwkv_lnx_b'], RWKV_HEADS)
    bonus = jnp.sum(r * (kf + kb) * lp['rwkv_r_k'], axis=-1, keepdims=True) * v
    out = (y + bonus).reshape(g.shape) * g
    return out.astype(g.dtype), sf, sb


def merge_branches(u, ys, lp):
    acc = jnp.zeros_like(u)
    for n in range(N_BRANCH):
        gate = jax.nn.sigmoid(u @ lp['w_gate'][n] + lp['b_gate'][n])
        acc = acc + gate * (ys[n].astype(u.dtype) @ lp['w_branch'][n])
    return acc @ lp['w_out']


def token_mixers(u_ctx, u_lat, lp, need_ctx):
    b, s, _ = u_lat.shape
    l = u_ctx.shape[1]
    pa_l, pb_l, pc_l, pd_l = split_sizes(u_lat @ lp['w_in'], GROUP_SIZES)
    pa_c, pb_c, pc_c, pd_c = split_sizes(u_ctx @ lp['w_in'], GROUP_SIZES)
    tab_att = axial_tables(s, HEAD_DIM)
    tab_mla = axial_tables(s, MLA_ROPE)

    aq_l, ak_l, av_l = split_sizes(pa_l, A_SIZES)
    aq_c, ak_c, av_c = split_sizes(pa_c, A_SIZES)
    k_c = heads(ak_c, ATT_KV_HEADS)
    v_c = heads(av_c, ATT_KV_HEADS)
    ya_l = window_gqa(axial_rope(heads(aq_l, ATT_Q_HEADS), tab_att),
                      axial_rope(heads(ak_l, ATT_KV_HEADS), tab_att),
                      heads(av_l, ATT_KV_HEADS), k_c, v_c, lp['sink'])

    lg_f, lg_b = retention_log_gammas()
    cos_c, sin_c = rope_tables(jnp.arange(l, dtype=F32), HEAD_DIM)
    cos_l, sin_l = rope_tables(l + jnp.arange(s, dtype=F32), HEAD_DIM)
    zero_ret = jnp.zeros((b, RET_HEADS, HEAD_DIM, HEAD_DIM), F32)
    yb_c, sbf, sbb = retention_mix(pb_c, cos_c, sin_c, lg_f, lg_b, zero_ret, zero_ret)
    yb_l, _, _ = retention_mix(pb_l, cos_l, sin_l, lg_f, lg_b, sbf, sbb)

    qn_l, qr_l, kn_l, kr_l, vm_l = mla_project(pc_l, lp)
    qn_c, qr_c, kn_c, kr_c, vm_c = mla_project(pc_c, lp)
    qr_l = axial_rope(qr_l, tab_mla)
    kr_l = axial_rope(kr_l, tab_mla)
    yc_l = mla_attend(qn_l, qr_l, jnp.concatenate([kn_c, kn_l], axis=1),
                      jnp.concatenate([kr_c, kr_l], axis=1), jnp.concatenate([vm_c, vm_l], axis=1))

    zero_wkv = jnp.zeros((b, RWKV_HEADS, HEAD_DIM, HEAD_DIM), F32)
    yd_c, sdf, sdb = rwkv_mix(rwkv_features(pd_c, lp), lp, zero_wkv, zero_wkv)
    yd_l, _, _ = rwkv_mix(rwkv_features(pd_l, lp), lp, sdf, sdb)

    m_lat = merge_branches(u_lat, (ya_l, yb_l, yc_l, yd_l), lp)
    if not need_ctx:
        return None, m_lat
    ya_c = ctx_gqa(heads(aq_c, ATT_Q_HEADS), k_c, v_c, lp['sink'])
    yc_c = mla_attend(qn_c, qr_c, kn_c, kr_c, vm_c)
    m_ctx = merge_branches(u_ctx, (ya_c, yb_c, yc_c, yd_c), lp)
    return m_ctx, m_lat


def moe_ffn(x, router_w, router_b, w_e_gate, w_e_up, w_e_down):
    n_tok, dm = x.shape
    scores = jax.nn.sigmoid(x.astype(F32) @ router_w.astype(F32))
    grp = (scores + router_b.astype(F32)).reshape(n_tok, N_GROUPS, EXPERTS_PER_GROUP)
    g_sel = jnp.argmax(jnp.sum(lax.top_k(grp, TOP_K)[0], axis=-1), axis=-1)
    in_grp = lax.top_k(jnp.take_along_axis(grp, g_sel[:, None, None], axis=1)[:, 0], TOP_K)[1]
    e_idx = g_sel[:, None] * EXPERTS_PER_GROUP + in_grp
    w_sel = jnp.take_along_axis(scores, e_idx, axis=1)
    w_sel = w_sel / jnp.sum(w_sel, axis=-1, keepdims=True)
    n_asg = n_tok * TOP_K
    flat_e = e_idx.reshape(-1)
    flat_tok = jnp.repeat(jnp.arange(n_tok, dtype=jnp.int32), TOP_K)
    flat_w = w_sel.reshape(-1)
    order = jnp.argsort(flat_e)
    se = flat_e[order]
    counts = jnp.bincount(flat_e, length=N_EXPERTS)
    padded = (counts + MOE_BLOCK - 1) // MOE_BLOCK * MOE_BLOCK
    pad_end = jnp.cumsum(padded)
    pad_start = pad_end - padded
    start = jnp.cumsum(counts) - counts
    dest = pad_start[se] + jnp.arange(n_asg) - start[se]
    n_blocks = -(-n_asg // MOE_BLOCK) + N_EXPERTS
    n_rows = n_blocks * MOE_BLOCK
    row_tok = jnp.zeros((n_rows,), jnp.int32).at[dest].set(flat_tok[order])
    row_w = jnp.zeros((n_rows,), F32).at[dest].set(flat_w[order])
    blk_e = jnp.minimum(jnp.searchsorted(pad_end, jnp.arange(n_blocks) * MOE_BLOCK, side='right'), N_EXPERTS - 1)
    xb = x[row_tok].reshape(n_blocks, MOE_BLOCK, dm)

    def expert_block(args):
        xblk, e = args
        hid = jax.nn.silu(xblk @ w_e_gate[e]) * (xblk @ w_e_up[e])
        return hid @ w_e_down[e]

    yb = lax.map(expert_block, (xb, blk_e)).reshape(n_rows, dm)
    yb = yb * row_w[:, None].astype(yb.dtype)
    return jnp.zeros_like(x).at[row_tok].add(yb.astype(x.dtype))


def layer(h_ctx, h_lat, c, c_ctx, lp, router_w, router_b, need_ctx):
    b, s, d = h_lat.shape
    l = h_ctx.shape[1]
    m_lat = jnp.split((jax.nn.silu(c) @ lp['w_ada'] + lp['b_ada'])[:, None, :], 6, axis=-1)
    m_ctx = jnp.split(jax.nn.silu(c_ctx) @ lp['w_ada'] + lp['b_ada'], 6, axis=-1)
    u_lat = adaln(h_lat, lp['g_norm1'], m_lat[0], m_lat[1])
    u_ctx = adaln(h_ctx, lp['g_norm1'], m_ctx[0], m_ctx[1])
    mix_ctx, mix_lat = token_mixers(u_ctx, u_lat, lp, need_ctx)
    h_lat = h_lat + m_lat[2] * mix_lat
    f_lat = adaln(h_lat, lp['g_norm2'], m_lat[3], m_lat[4]).reshape(b * s, d)
    if not need_ctx:
        ffn = moe_ffn(f_lat, router_w, router_b, lp['w_e_gate'], lp['w_e_up'], lp['w_e_down'])
        return h_ctx, h_lat + m_lat[5] * ffn.reshape(b, s, d)
    h_ctx = h_ctx + m_ctx[2] * mix_ctx
    f_ctx = adaln(h_ctx, lp['g_norm2'], m_ctx[3], m_ctx[4]).reshape(b * l, d)
    ffn = moe_ffn(jnp.concatenate([f_ctx, f_lat], axis=0), router_w, router_b,
                  lp['w_e_gate'], lp['w_e_up'], lp['w_e_down'])
    h_ctx = h_ctx + m_ctx[5] * ffn[:b * l].reshape(b, l, d)
    h_lat = h_lat + m_lat[5] * ffn[b * l:].reshape(b, s, d)
    return h_ctx, h_lat


def setup_inputs(seed: int = 0) -> dict:
    key = jax.random.key(seed)
    ks = iter(jax.random.split(key, 48))
    D = D_MODEL
    L = DEPTH

    def nrm(shape, scale):
        return scale * jax.random.normal(next(ks), shape, F32)

    rwkv_in = sum(RWKV_SIZES)
    return {
        'x': nrm((BATCH, SEQ, D), 1.0),
        'c': nrm((BATCH, D), 1.0),
        'ctx': nrm((BATCH, CTX_LEN, D), 1.0),
        'c_ctx': nrm((D,), 1.0),
        'w_ada': nrm((L, D, 6 * D), 0.5 * D ** -0.5),
        'b_ada': nrm((L, 6 * D), 0.02),
        'g_norm1': 1.0 + nrm((L, D), 0.02),
        'g_norm2': 1.0 + nrm((L, D), 0.02),
        'w_in': nrm((L, D, N_IN), D ** -0.5),
        'sink': nrm((L, ATT_Q_HEADS), 0.5),
        'g_qnorm': 1.0 + nrm((L, MLA_Q_RANK), 0.02),
        'g_kvnorm': 1.0 + nrm((L, MLA_KV_RANK), 0.02),
        'w_uq': nrm((L, MLA_Q_RANK, MLA_HEADS * (MLA_NOPE + MLA_ROPE)), MLA_Q_RANK ** -0.5),
        'w_ukv': nrm((L, MLA_KV_RANK, MLA_HEADS * (MLA_NOPE + MLA_V)), MLA_KV_RANK ** -0.5),
        'rwkv_mu': jax.random.uniform(next(ks), (L, rwkv_in), F32, 0.0, 1.0),
        'rwkv_w0': jnp.linspace(-6.0, -1.0, BRANCH_W, dtype=F32)[None, None, :] + nrm((L, 2, BRANCH_W), 0.1),
        'rwkv_w_up': nrm((L, 2, RWKV_DECAY_RANK, BRANCH_W), 0.1 * RWKV_DECAY_RANK ** -0.5),
        'rwkv_a0': nrm((L, 2, BRANCH_W), 0.1),
        'rwkv_a_up': nrm((L, 2, RWKV_A_RANK, BRANCH_W), 0.5 * RWKV_A_RANK ** -0.5),
        'rwkv_g_up': nrm((L, RWKV_GATE_RANK, BRANCH_W), RWKV_GATE_RANK ** -0.5),
        'rwkv_k_k': 0.85 + nrm((L, BRANCH_W), 0.02),
        'rwkv_k_a': 1.0 + nrm((L, BRANCH_W), 0.02),
        'rwkv_r_k': nrm((L, RWKV_HEADS, HEAD_DIM), 0.1),
        'rwkv_lnx_w': 1.0 + nrm((L, BRANCH_W), 0.02),
        'rwkv_lnx_b': nrm((L, BRANCH_W), 0.02),
        'w_gate': nrm((L, N_BRANCH, D, D), D ** -0.5),
        'b_gate': nrm((L, N_BRANCH, D), 0.02),
        'w_branch': nrm((L, N_BRANCH, BRANCH_W, D), BRANCH_W ** -0.5),
        'w_out': nrm((L, D, D), D ** -0.5),
        'router_w': nrm((D, N_EXPERTS), D ** -0.5),
        'router_b': nrm((N_EXPERTS,), 0.01),
        'w_e_gate': nrm((L, N_EXPERTS, D, EXPERT_FF), D ** -0.5),
        'w_e_up': nrm((L, N_EXPERTS, D, EXPERT_FF), D ** -0.5),
        'w_e_down': nrm((L, N_EXPERTS, EXPERT_FF, D), EXPERT_FF ** -0.5),
        'g_final': 1.0 + nrm((D,), 0.02),
    }


def reference(x, c, ctx, c_ctx, w_ada, b_ada, g_norm1, g_norm2, w_in, sink, g_qnorm, g_kvnorm,
              w_uq, w_ukv, rwkv_mu, rwkv_w0, rwkv_w_up, rwkv_a0, rwkv_a_up, rwkv_g_up, rwkv_k_k,
              rwkv_k_a, rwkv_r_k, rwkv_lnx_w, rwkv_lnx_b, w_gate, b_gate, w_branch, w_out,
              router_w, router_b, w_e_gate, w_e_up, w_e_down, g_final):
    names = ('w_ada', 'b_ada', 'g_norm1', 'g_norm2', 'w_in', 'sink', 'g_qnorm', 'g_kvnorm', 'w_uq',
             'w_ukv', 'rwkv_mu', 'rwkv_w0', 'rwkv_w_up', 'rwkv_a0', 'rwkv_a_up', 'rwkv_g_up',
             'rwkv_k_k', 'rwkv_k_a', 'rwkv_r_k', 'rwkv_lnx_w', 'rwkv_lnx_b', 'w_gate', 'b_gate',
             'w_branch', 'w_out', 'w_e_gate', 'w_e_up', 'w_e_down')
    stacked = (w_ada, b_ada, g_norm1, g_norm2, w_in, sink, g_qnorm, g_kvnorm, w_uq, w_ukv, rwkv_mu,
               rwkv_w0, rwkv_w_up, rwkv_a0, rwkv_a_up, rwkv_g_up, rwkv_k_k, rwkv_k_a, rwkv_r_k,
               rwkv_lnx_w, rwkv_lnx_b, w_gate, b_gate, w_branch, w_out, w_e_gate, w_e_up, w_e_down)
    h_ctx, h_lat = ctx, x
    for i in range(DEPTH):
        lp = {n: a[i] for n, a in zip(names, stacked)}
        h_ctx, h_lat = layer(h_ctx, h_lat, c, c_ctx, lp, router_w, router_b, i < DEPTH - 1)
    return rms_norm(h_lat, g_final)
```

```cpp
#include <hip/hip_runtime.h>
#include <cstdio>
#include <cstdint>

constexpr int D = 1024, NB = 4, SEQ = 8192, CTXL = 256, DEPTH = 2;
constexpr int MLAT = NB * SEQ;
constexpr int MCTX = NB * CTXL;
constexpr int MALL = MLAT + MCTX;
constexpr int NIN = 3360, NINP = 3584;
constexpr float NORM_EPS = 1e-6f;

constexpr size_t MiB = 1u << 20;
constexpr size_t WS_CTL = 0, CTL_BYTES = 1 * MiB;
constexpr size_t WS_MOD = 1 * MiB;
constexpr size_t WS_TAB = WS_MOD + 512 * 1024;
constexpr size_t WS_SMALLW = 2 * MiB;
constexpr size_t WS_WUQ_T = WS_SMALLW;
constexpr size_t WS_WUKV_T = WS_WUQ_T + 2 * 384 * 256 * 2;
constexpr size_t WS_RWUP_T = WS_WUKV_T + 2 * 512 * 128 * 2;
constexpr size_t WS_RAUP_T = WS_RWUP_T + 2 * 2 * 256 * 64 * 2;
constexpr size_t WS_RGUP_T = WS_RAUP_T + 2 * 2 * 256 * 64 * 2;
static_assert(WS_RGUP_T + 2 * 256 * 128 * 2 <= 3 * MiB, "smallw");
constexpr size_t WS_RTAB = 3 * MiB;
constexpr size_t WS_RWHI = 5 * MiB + 256 * 1024;
constexpr size_t WS_RWLO = WS_RWHI + 128 * 1024;
constexpr size_t WS_GS2 = WS_MOD + 256 * 1024;
constexpr size_t WS_WIN_T = 6 * MiB;
constexpr size_t WS_WG_T = 20 * MiB;
constexpr size_t WS_WB_T = 36 * MiB;
constexpr size_t WS_WO_T = 40 * MiB;
constexpr size_t WS_H = 44 * MiB;
constexpr size_t WS_XN = 176 * MiB;
constexpr size_t WS_E = 242 * MiB;
constexpr size_t WS_T = 434 * MiB;
constexpr size_t WS_END = 1024 * MiB;
constexpr size_t E_STRIDE = (size_t)MALL * 256 * 2;
constexpr size_t E_R = WS_E, E_V = E_R + E_STRIDE, E_KF = E_V + E_STRIDE, E_KB = E_KF + E_STRIDE, E_KK = E_KB + E_STRIDE, E_BF = E_KK + E_STRIDE, E_BB = E_BF + E_STRIDE,
                 E_EF = E_BB + E_STRIDE, E_EB = E_EF + E_STRIDE, E_G = E_EB + E_STRIDE, E_BONUS = E_G + E_STRIDE;
static_assert(E_BONUS + (size_t)MALL * 4 * 4 <= WS_T, "E map");
static_assert(true, "");
constexpr size_t T_P = WS_T;
constexpr size_t T_QA = T_P + (size_t)MALL * NINP * 2;
constexpr size_t T_KA = T_QA + (size_t)MALL * 256 * 2;
constexpr size_t T_QC = T_KA + (size_t)MALL * 128 * 2;
constexpr size_t T_KC = T_QC + (size_t)MALL * 384 * 2;
constexpr size_t T_VC = T_KC + (size_t)MALL * 384 * 2;
constexpr size_t T_CQN = T_VC + (size_t)MALL * 256 * 2;
constexpr size_t T_CKVN = T_CQN + (size_t)MALL * 256 * 2;
constexpr size_t T_RQ = T_CKVN + (size_t)MALL * 128 * 2;
constexpr size_t T_RK = T_RQ + (size_t)MALL * 256 * 2;
static_assert((size_t)32 * 132 * 4096 * 2 <= (size_t)2 * MALL * 256 * 2, "retention chunk data fits the RQ | RK area");
constexpr size_t T_RETY = T_QC;
constexpr size_t T_RWY = T_RETY + (size_t)2 * MALL * 256 * 2;
static_assert(T_RWY + (size_t)2 * MALL * 256 * 2 <= T_CQN, "scan outputs fit QC | KC | VC");
constexpr int NE0 = 22;
constexpr size_t T_EW0 = T_RK + (size_t)MALL * 256 * 2;
constexpr size_t T_EW0D = T_EW0 + (size_t)NE0 * 1024 * 1024 * 2;
constexpr size_t T_PZ = T_EW0 + (size_t)4 * MALL * 256 * 2;
constexpr int NCHUNK = 132;
constexpr size_t PZ_BYTES = (size_t)32 * NCHUNK * 8192 * 2;
constexpr size_t T_REF = T_PZ + PZ_BYTES;
constexpr size_t T_YB = WS_T + 524 * MiB;
static_assert(T_REF + (size_t)8 * 8448 * 64 * 2 <= T_YB, "PZ map");
static_assert(T_EW0D + (size_t)NE0 * 1024 * 512 * 2 <= T_PZ && T_YB + (size_t)MALL * D * 2 <= WS_END, "T map");
constexpr size_t T_BOUT = WS_T;
constexpr size_t T_ACC = T_BOUT + (size_t)MALL * 4096 * 2;
static_assert(T_ACC + (size_t)MALL * D * 2 <= T_YB, "merge map");

constexpr int XB_ROWS = (264 + 64) * 256;
constexpr size_t T_HID = WS_T;
constexpr size_t T_Y = T_HID + (size_t)XB_ROWS * 512 * 2;
constexpr size_t T_TOKE = T_Y + (size_t)XB_ROWS * 1024 * 2;
constexpr size_t T_TOKP = T_TOKE + (size_t)MALL * 8;
constexpr size_t T_TOKW = T_TOKP + (size_t)MALL * 8;
constexpr size_t T_ROWTOK = T_TOKW + (size_t)MALL * 8;
static_assert(T_ROWTOK + (size_t)XB_ROWS * 4 <= T_EW0, "moe map");
constexpr size_t E_WGU = WS_E;
constexpr size_t E_WD = E_WGU + (size_t)64 * 1024 * 1024 * 2;
static_assert(E_WD + (size_t)64 * 1024 * 512 * 2 <= WS_T, "E moe map");

constexpr int CW_BAR = 4096;
constexpr int CW_CNT = 65536, CNT_STRIDE = 64;

#define GAS __attribute__((address_space(1)))
#define LAS __attribute__((address_space(3)))
typedef unsigned short bf16_t;
typedef float f32x4 __attribute__((ext_vector_type(4)));
typedef float f32x16 __attribute__((ext_vector_type(16)));
typedef short bf16x8 __attribute__((ext_vector_type(8)));
typedef unsigned u32x4 __attribute__((ext_vector_type(4)));
typedef unsigned u32x2 __attribute__((ext_vector_type(2)));

__device__ __forceinline__ float bf2f(bf16_t b) { return __uint_as_float(((unsigned)b) << 16); }
typedef float f32x2_hw __attribute__((ext_vector_type(2)));
typedef __bf16 bf16x2_hw __attribute__((ext_vector_type(2)));
__device__ __forceinline__ unsigned pk2(float lo, float hi) { const f32x2_hw v = {lo, hi}; const bf16x2_hw b = __builtin_convertvector(v, bf16x2_hw); return __builtin_bit_cast(unsigned, b); }
__device__ __forceinline__ unsigned f2bf(float f) { return pk2(f, 0.f) & 0xffffu; }
__device__ __forceinline__ float wave_sum(float v) {
#pragma unroll
    for (int o = 1; o < 64; o <<= 1) v += __shfl_xor(v, o);
    return v;
}

__device__ __forceinline__ float grp16_sum(float v) { v += __shfl_xor(v, 1); v += __shfl_xor(v, 2); v += __shfl_xor(v, 4); v += __shfl_xor(v, 8); return v; }
__device__ __forceinline__ int crow(int r, int hi) { return (r & 3) + 8 * (r >> 2) + 4 * hi; }

#define XB_TMO      128
#define XB_XCNT(j)  (256  + 64 * (j))
#define XB_XSUB(j)  (1280 + 64 * (j))
#define XB_XGEN(j)  (2304 + 64 * (j))
#define XB_TOP      3328
#define XB_TOPGEN   3392
#define XCD_BAR_WORDS 3456
#define XB_SPIN_CAP (1u << 18)

__device__ __forceinline__ unsigned xb_ld(unsigned* p)              { return __hip_atomic_load(p, __ATOMIC_RELAXED, __HIP_MEMORY_SCOPE_AGENT); }
__device__ __forceinline__ unsigned xb_add(unsigned* p, unsigned v) { return __hip_atomic_fetch_add(p, v, __ATOMIC_RELAXED, __HIP_MEMORY_SCOPE_AGENT); }
__device__ __forceinline__ unsigned xb_xcc_id() { return (unsigned)__builtin_amdgcn_s_getreg((3 << 11) | 20) & 0xFu; }
#define XB_SPIN(cond, bar) do { unsigned _sp = 0; while (cond) { __builtin_amdgcn_s_sleep(1); \
    if ((++_sp & 255u) == 0u) { if (xb_ld(&(bar)[XB_TMO])) break; if (_sp > XB_SPIN_CAP) { atomicAdd(&(bar)[XB_TMO], 1u); break; } } } } while (0)

struct XcdBarrier { unsigned* bar; unsigned x; volatile LAS unsigned* st; };

__device__ __forceinline__ XcdBarrier xcd_barrier_post(unsigned* bar, volatile LAS unsigned* st) {
    XcdBarrier b; b.bar = bar; b.x = xb_xcc_id(); b.st = st;
    if (threadIdx.x == 0) (void)xb_add(&bar[XB_XCNT(b.x)], 1u);
    return b;
}
__device__ __forceinline__ void xcd_barrier_complete(unsigned* bar, unsigned x, unsigned& nloc, unsigned& nx) {
    const unsigned G = gridDim.x * gridDim.y * gridDim.z;
    unsigned sum, cnt, mine, sp = 0u;
    for (;;) {
        sum = 0u; cnt = 0u; mine = 0u;
#pragma unroll
        for (unsigned j = 0; j < 16; ++j) { const unsigned c = xb_ld(&bar[XB_XCNT(j)]); sum += c; cnt += (c > 0u) ? 1u : 0u; mine = (j == x) ? c : mine; }
        if (sum == G) break;
        __builtin_amdgcn_s_sleep(1);
        if ((++sp & 255u) == 0u) { if (xb_ld(&bar[XB_TMO])) break; if (sp > XB_SPIN_CAP) { atomicAdd(&bar[XB_TMO], 1u); break; } }
    }
    nloc = mine > 0u ? mine : 1u; nx = cnt > 0u ? cnt : 1u;
}
__device__ __forceinline__ void xcd_barrier(const XcdBarrier& b) {
    asm volatile("s_waitcnt vmcnt(0)" ::: "memory");
    __syncthreads();
    if (threadIdx.x == 0) {
        unsigned* bar = b.bar;
        __builtin_amdgcn_s_waitcnt(0);
        unsigned nloc = b.st[0], nx = b.st[1];
        if (nloc == 0u) { xcd_barrier_complete(bar, b.x, nloc, nx); b.st[0] = nloc; b.st[1] = nx; }
        const unsigned old = xb_add(&bar[XB_XSUB(b.x)], 1u);
        const unsigned gen = old / nloc;
        if (old + 1u == (gen + 1u) * nloc) {
            __builtin_amdgcn_fence(__ATOMIC_RELEASE, "agent");
            asm volatile("s_waitcnt vmcnt(0)" ::: "memory");
            const unsigned og = xb_add(&bar[XB_TOP], 1u);
            const unsigned tg = og / nx;
            if (og + 1u == (tg + 1u) * nx) xb_add(&bar[XB_TOPGEN], 1u);
            else XB_SPIN(xb_ld(&bar[XB_TOPGEN]) == tg, bar);
            __builtin_amdgcn_fence(__ATOMIC_ACQUIRE, "agent");
            xb_add(&bar[XB_XGEN(b.x)], 1u);
            asm volatile("s_waitcnt vmcnt(0)" ::: "memory");
        } else {
            XB_SPIN(xb_ld(&bar[XB_XGEN(b.x)]) == gen, bar);
            __builtin_amdgcn_fence(__ATOMIC_ACQUIRE, "agent");
            asm volatile("s_waitcnt vmcnt(0)" ::: "memory");
        }
    }
    __syncthreads();
}


namespace pg8 {
constexpr int BM = 256, BK = 64, HALF = 128, HTB = HALF * BK * 2, STAGE_BYTES = 8 * HTB;
__host__ __device__ __forceinline__ int lds_byte(int r, int c) { const int st = (r >> 4) * 2 + (c >> 5), rr = r & 15, cc = c & 31, ob = rr * 64 + cc * 2; return st * 1024 + (ob ^ (((ob >> 9) & 1) << 5)); }
__host__ __device__ __forceinline__ void stage_rc(int b, int& R, int& C) { const int st = b / 1024, sb = b % 1024, swz = sb ^ (((sb >> 9) & 1) << 5); R = (st >> 1) * 16 + swz / 64; C = (st & 1) * 32 + (swz % 64) / 2; }
__host__ __device__ __forceinline__ int perm32(int rho) { const int n = rho >> 4, i = rho & 15; return 8 * (i >> 2) + 4 * n + (i & 3); }
struct Unit { const bf16_t* A; const bf16_t* B; int u0, u1, u2, u3; };
typedef float f32x2_cv __attribute__((ext_vector_type(2))); typedef __bf16 bf16x2_cv __attribute__((ext_vector_type(2)));
__device__ __forceinline__ unsigned cvt_pk_bf16(float lo, float hi) { const f32x2_cv v = {lo, hi}; const bf16x2_cv b = __builtin_convertvector(v, bf16x2_cv); return __builtin_bit_cast(unsigned, b); }

template <class Epi, class Sched, bool GA = false, bool MIX = false>
__device__ __forceinline__ void gemm_phase(LAS unsigned char* lds, const Sched& S, const Epi& E) {
    int tid = threadIdx.x; asm volatile("" : "+v"(tid));
    const int wid = __builtin_amdgcn_readfirstlane(tid >> 6), lane = tid & 63, wr = wid >> 2, wc = wid & 3, fr = lane & 15, fq = lane >> 4;
    int lda, ldb, ntc;
    if constexpr (MIX) { lda = Sched::lda; ldb = Sched::ldb0; ntc = Sched::K0 / BK; } else { lda = S.lda; ldb = S.ldb; ntc = S.K / BK; }
    unsigned voffA[2], voffB[2]; int gR[2], gC[2], gRb[2];
#pragma unroll
    for (int i = 0; i < 2; ++i) { int R, C; stage_rc(tid * 16 + i * 8192, R, C); const int Rb = Epi::PERM ? ((R & ~31) + perm32(R & 31)) : R;
        voffA[i] = (unsigned)(R * lda + C) * 2u; voffB[i] = (unsigned)(Rb * ldb + C) * 2u; gR[i] = R; gC[i] = C; gRb[i] = Rb; }
    unsigned cvB[2] = {voffB[0], voffB[1]}, nvB[2] = {voffB[0], voffB[1]};
#define PG8_KIND_B(u, vB, hB, ntv) do { if constexpr (MIX) { const int ld_ = (u).u3 ? Sched::ldb1 : Sched::ldb0; \
        _Pragma("unroll") for (int _i = 0; _i < 2; ++_i) vB[_i] = (unsigned)(gRb[_i] * ld_ + gC[_i]) * 2u; hB = (size_t)HALF * ld_ * 2; ntv = ((u).u3 ? Sched::K1 : Sched::K0) / BK; } } while (0)
    unsigned vg0[2] = {0u, 0u}, vg1[2] = {0u, 0u}, nvg0[2] = {0u, 0u}, nvg1[2] = {0u, 0u};
#define PG8_GOFF(u, o0, o1) do { _Pragma("unroll") for (int _i = 0; _i < 2; ++_i) { const int t0_ = S.rowtok[(u).u0 + gR[_i]], t1_ = S.rowtok[(u).u0 + HALF + gR[_i]]; \
        o0[_i] = (unsigned)(t0_ * lda + gC[_i]) * 2u; o1[_i] = (unsigned)(t1_ * lda + gC[_i]) * 2u; } } while (0)
    const size_t kstep = (size_t)(BK * 2);
    const size_t hsA = (size_t)HALF * lda * 2, hsB = (size_t)HALF * ldb * 2; size_t chsB = hsB, nhsB = hsB; int nt = ntc, ntn = ntc;
    const unsigned ldsw = (unsigned)wid * 1024u;
    const int aoff = lds_byte(wr * 64 + fr, fq * 8), boff = lds_byte(wc * 32 + fr, fq * 8);
#define PG8_SA(b, h) (((b) * 2 + (h)) * HTB)
#define PG8_SB(b, h) ((4 + (b) * 2 + (h)) * HTB)
#define PG8_STAGE(bufoff, gbase, voff) do { _Pragma("unroll") for (int _i = 0; _i < 2; ++_i) \
        __builtin_amdgcn_global_load_lds((const unsigned*)((const char*)(gbase) + (voff)[_i]), (LAS unsigned*)(lds + (bufoff) + ldsw + _i * 8192), 16, 0, 0); } while (0)
#define PG8_LDA(dst, b, h) do { _Pragma("unroll") for (int m = 0; m < 4; ++m) _Pragma("unroll") for (int k = 0; k < 2; ++k) dst[m][k] = *(const LAS bf16x8*)(lds + PG8_SA(b, h) + aoff + m * 2048 + k * 1024); } while (0)
#define PG8_LDB(dst, b, h) do { _Pragma("unroll") for (int n = 0; n < 2; ++n) _Pragma("unroll") for (int k = 0; k < 2; ++k) dst[n][k] = *(const LAS bf16x8*)(lds + PG8_SB(b, h) + boff + n * 2048 + k * 1024); } while (0)
#define PG8_MMA(ai, bj, At, Bt) do { __builtin_amdgcn_s_setprio(1); _Pragma("unroll") for (int m = 0; m < 4; ++m) _Pragma("unroll") for (int n = 0; n < 2; ++n) _Pragma("unroll") for (int k = 0; k < 2; ++k) \
        acc[ai][bj][m][n] = __builtin_amdgcn_mfma_f32_16x16x32_bf16(Bt[n][k], At[m][k], acc[ai][bj][m][n], 0, 0, 0); __builtin_amdgcn_s_setprio(0); } while (0)
#define PG8_WAIT_V(n) asm volatile("s_waitcnt vmcnt(" #n ")" ::: "memory")
#define PG8_WAIT_L(n) asm volatile("s_waitcnt lgkmcnt(" #n ")" ::: "memory")
#define PG8_BAR __builtin_amdgcn_s_barrier()
#define PG8_SCHED __builtin_amdgcn_sched_barrier(0)
    Unit cur, nxt; int ui = 0;
    if (!S.next(0, cur)) return;
    f32x4 acc[2][2][4][2];
#pragma unroll
    for (int a = 0; a < 2; ++a)
#pragma unroll
        for (int b = 0; b < 2; ++b)
#pragma unroll
            for (int m = 0; m < 4; ++m)
#pragma unroll
                for (int n = 0; n < 2; ++n) acc[a][b][m][n] = (f32x4){0.f, 0.f, 0.f, 0.f};
    bf16x8 At[4][2], B0[2][2], B1[2][2];
    const char* cA = (const char*)cur.A; const char* cB = (const char*)cur.B;
    if constexpr (GA) { PG8_GOFF(cur, vg0, vg1); }
    PG8_KIND_B(cur, cvB, chsB, nt);
#define PG8_STAGE_A(bufoff, gbase, h, o0, o1) do { if constexpr (GA) { if ((h) == 0) PG8_STAGE(bufoff, gbase, o0); else PG8_STAGE(bufoff, gbase, o1); } \
        else PG8_STAGE(bufoff, (gbase) + ((h) ? hsA : 0), voffA); } while (0)
    PG8_STAGE(PG8_SB(0, 0), cB, cvB); PG8_STAGE_A(PG8_SA(0, 0), cA, 0, vg0, vg1); PG8_STAGE(PG8_SB(0, 1), cB + chsB, cvB); PG8_STAGE_A(PG8_SA(0, 1), cA, 1, vg0, vg1);
    if (wr == 1) PG8_BAR;
    PG8_WAIT_V(4); PG8_BAR;
    PG8_STAGE(PG8_SB(1, 0), cB + kstep, cvB); PG8_STAGE_A(PG8_SA(1, 0), cA + kstep, 0, vg0, vg1); PG8_STAGE(PG8_SB(1, 1), cB + chsB + kstep, cvB);
    PG8_WAIT_V(6); PG8_BAR;
    for (;;) {
        const bool has_next = S.next(ui + 1, nxt);
        const char* nA = has_next ? (const char*)nxt.A : cA; const char* nB = has_next ? (const char*)nxt.B : cB;
        if constexpr (MIX) { if (has_next) PG8_KIND_B(nxt, nvB, nhsB, ntn); else { nvB[0] = cvB[0]; nvB[1] = cvB[1]; nhsB = chsB; ntn = nt; } }
        if constexpr (GA) { if (has_next) PG8_GOFF(nxt, nvg0, nvg1); else {
#pragma unroll
            for (int _i = 0; _i < 2; ++_i) { nvg0[_i] = vg0[_i]; nvg1[_i] = vg1[_i]; } } }
        for (int t = 0; t < nt; t += 2) {
            const bool last = (t == nt - 2);
            const char* a1 = cA + (size_t)(t + 1) * kstep;
            const char* a2 = last ? nA : cA + (size_t)(t + 2) * kstep; const char* b2 = last ? nB : cB + (size_t)(t + 2) * kstep;
            const char* a3 = a2 + kstep; const char* b3 = b2 + kstep;
            unsigned vB2[2]; vB2[0] = last ? nvB[0] : cvB[0]; vB2[1] = last ? nvB[1] : cvB[1]; const size_t hB2 = last ? nhsB : chsB;
            unsigned o0[2], o1[2];
#pragma unroll
            for (int _i = 0; _i < 2; ++_i) { o0[_i] = last ? nvg0[_i] : vg0[_i]; o1[_i] = last ? nvg1[_i] : vg1[_i]; }
            PG8_LDB(B0, 0, 0); PG8_SCHED; PG8_LDA(At, 0, 0); PG8_STAGE_A(PG8_SA(1, 1), a1, 1, vg0, vg1);
            PG8_WAIT_L(8); PG8_BAR; PG8_WAIT_L(0); PG8_MMA(0, 0, At, B0); PG8_BAR; PG8_SCHED;
            PG8_LDB(B1, 0, 1); PG8_STAGE(PG8_SB(0, 0), b2, vB2);
            PG8_BAR; PG8_WAIT_L(0); PG8_MMA(0, 1, At, B1); PG8_BAR;
            PG8_LDA(At, 0, 1); PG8_STAGE_A(PG8_SA(0, 0), a2, 0, o0, o1);
            PG8_BAR; PG8_WAIT_L(0); PG8_MMA(1, 0, At, B0); PG8_BAR; PG8_SCHED;
            PG8_STAGE(PG8_SB(0, 1), b2 + hB2, vB2);
            PG8_WAIT_V(6); PG8_BAR; PG8_MMA(1, 1, At, B1); PG8_BAR;
            PG8_LDB(B0, 1, 0); PG8_SCHED; PG8_LDA(At, 1, 0); PG8_STAGE_A(PG8_SA(0, 1), a2, 1, o0, o1);
            PG8_WAIT_L(8); PG8_BAR; PG8_WAIT_L(0); PG8_MMA(0, 0, At, B0); PG8_BAR; PG8_SCHED;
            PG8_LDB(B1, 1, 1); PG8_STAGE(PG8_SB(1, 0), b3, vB2);
            PG8_BAR; PG8_WAIT_L(0); PG8_MMA(0, 1, At, B1); PG8_BAR;
            PG8_LDA(At, 1, 1); PG8_STAGE_A(PG8_SA(1, 0), a3, 0, o0, o1);
            PG8_BAR; PG8_WAIT_L(0); PG8_MMA(1, 0, At, B0); PG8_BAR; PG8_SCHED;
            PG8_STAGE(PG8_SB(1, 1), b3 + hB2, vB2);
            PG8_WAIT_V(6); PG8_BAR; PG8_MMA(1, 1, At, B1); PG8_BAR;
        }
        E(acc, cur, wr, wc, fr, fq);
        if (!has_next) break;
#pragma unroll
        for (int a = 0; a < 2; ++a)
#pragma unroll
            for (int b = 0; b < 2; ++b)
#pragma unroll
                for (int m = 0; m < 4; ++m)
#pragma unroll
                    for (int n = 0; n < 2; ++n) acc[a][b][m][n] = (f32x4){0.f, 0.f, 0.f, 0.f};
        cur = nxt; cA = nA; cB = nB; ++ui; cvB[0] = nvB[0]; cvB[1] = nvB[1]; chsB = nhsB; nt = ntn;
        if constexpr (GA) {
#pragma unroll
            for (int _i = 0; _i < 2; ++_i) { vg0[_i] = nvg0[_i]; vg1[_i] = nvg1[_i]; } }
    }
    PG8_WAIT_V(0);
    if (wr == 0) PG8_BAR;
    PG8_BAR;
#undef PG8_SA
#undef PG8_SB
#undef PG8_STAGE
#undef PG8_LDA
#undef PG8_LDB
#undef PG8_MMA
#undef PG8_WAIT_V
#undef PG8_WAIT_L
#undef PG8_BAR
#undef PG8_SCHED
#undef PG8_GOFF
#undef PG8_KIND_B
#undef PG8_STAGE_A
}
}

constexpr int NWAVES = 8, NTHR = 512;
constexpr int RING_BYTES = 131072;
constexpr int LDSCTL_OFF = RING_BYTES, MISC_OFF = LDSCTL_OFF + 320;
constexpr int LDS_BYTES = 147456;

struct Args { const float* in[35]; float* out; unsigned char* ws; int ph_lo, ph_hi; };

struct Frame {
    LAS unsigned char* lds;
    unsigned* ctl;
    int tid, lane, wave, G, bid;
    int gw, ngw;
    int dl;
};

__device__ __forceinline__ int row_vec(int row) { return row < MLAT ? (row >> 13) : 4; }

__device__ __forceinline__ void ph_copy_h(const Frame& F, const float* x, const float* ctx, float* H) {
    const size_t n4 = (size_t)MALL * D / 4, nl4 = (size_t)MLAT * D / 4;
    const f32x4* x4 = (const f32x4*)x; const f32x4* c4 = (const f32x4*)ctx; f32x4* h4 = (f32x4*)H;
    for (size_t i = (size_t)F.bid * NTHR + F.tid; i < n4; i += (size_t)F.G * NTHR) h4[i] = i < nl4 ? x4[i] : c4[i - nl4];
}
__device__ __forceinline__ void ph_zero16(const Frame& F, void* p, size_t bytes) {
    u32x4* q = (u32x4*)p; const size_t n = bytes / 16;
    for (size_t i = (size_t)F.bid * NTHR + F.tid; i < n; i += (size_t)F.G * NTHR) q[i] = (u32x4){0u, 0u, 0u, 0u};
}

__device__ __forceinline__ float silu_f(float x) { return x * __builtin_amdgcn_rcpf(1.f + __expf(-x)); }
__device__ __forceinline__ float sigmoid_f(float x) { return __builtin_amdgcn_rcpf(1.f + __expf(-x)); }
__device__ __forceinline__ float sigmoid_div_f(float x) { return 1.f / (1.f + __expf(-x)); }
__device__ __forceinline__ void ph_mod(const Frame& F, const float* c, const float* c_ctx, const float* w_ada, const float* b_ada, float* MOD) {
    LAS float* part = (LAS float*)F.lds;
    LAS float* sc = part + 8 * 5 * 64;
    for (int i = F.tid; i < 5 * D; i += NTHR) { const int v = i >> 10, k = i & 1023; sc[i] = silu_f(v < 4 ? c[v * D + k] : c_ctx[k]); }
    __syncthreads();
    for (int item = F.bid; item < 2 * 96; item += F.G) {
        const int l = item / 96, cg = item % 96, col = cg * 64 + F.lane;
        float acc[5] = {0.f, 0.f, 0.f, 0.f, 0.f};
        const float* W = w_ada + (size_t)l * D * 6144 + (size_t)(F.wave * 128) * 6144 + col;
#pragma unroll 1
        for (int kk0 = 0; kk0 < 128; kk0 += 16) {
            float w[16];
#pragma unroll
            for (int j = 0; j < 16; ++j) w[j] = W[(size_t)(kk0 + j) * 6144];
#pragma unroll
            for (int v = 0; v < 5; ++v) {
#pragma unroll
                for (int j4 = 0; j4 < 4; ++j4) { const f32x4 s4 = *(const LAS f32x4*)(sc + v * D + F.wave * 128 + kk0 + 4 * j4);
                    acc[v] += s4.x * w[4 * j4] + s4.y * w[4 * j4 + 1] + s4.z * w[4 * j4 + 2] + s4.w * w[4 * j4 + 3]; } }
        }
#pragma unroll
        for (int v = 0; v < 5; ++v) part[(F.wave * 5 + v) * 64 + F.lane] = acc[v];
        __syncthreads();
        if (F.wave < 5) { float s = b_ada[l * 6144 + col];
#pragma unroll
            for (int w = 0; w < 8; ++w) s += part[(w * 5 + F.wave) * 64 + F.lane];
            MOD[((size_t)l * 5 + F.wave) * 6144 + col] = s; }
        __syncthreads();
    }
}

__device__ __forceinline__ void transpose_item(const float* W, int K, int N, bf16_t* WT, int ldt, int row_off, int mode, LAS float* scr, int item, int lane) {
    const int nblk = N / 32, kb = item / nblk, nb = item % nblk, k0 = 64 * kb, n0 = 32 * nb;
#pragma unroll 8
    for (int i = 0; i < 32; ++i) { const int kk = 2 * i + (lane >> 5); scr[kk * 33 + (lane & 31)] = W[(size_t)(k0 + kk) * N + n0 + (lane & 31)]; }
    asm volatile("s_waitcnt lgkmcnt(0)" ::: "memory");
    const int c = lane & 7;
#pragma unroll
    for (int j = 0; j < 4; ++j) { const int nl = (lane >> 3) + 8 * j; const LAS float* s = scr + (8 * c) * 33 + nl;
        u32x4 o; o.x = pk2(s[0 * 33], s[1 * 33]); o.y = pk2(s[2 * 33], s[3 * 33]); o.z = pk2(s[4 * 33], s[5 * 33]); o.w = pk2(s[6 * 33], s[7 * 33]);
        const int n = n0 + nl; const int row = row_off + (mode == 0 ? n : (256 * (n >> 7) + (n & 127) + (mode == 2 ? 128 : 0)));
        *(u32x4*)(WT + (size_t)row * ldt + k0 + 8 * c) = o; }
    asm volatile("s_waitcnt lgkmcnt(0)" ::: "memory");
}
#define TR_BATCH_W(GW, NGW, SRC, SSTR, CNT, KK, NN, DST, DSTR, LDT, ROFF, MODE) do { const int per_ = ((KK) / 64) * ((NN) / 32), tot_ = per_ * (CNT); \
    for (int it_ = (GW); it_ < tot_; it_ += (NGW)) { const int m_ = it_ / per_; \
        transpose_item((SRC) + (size_t)m_ * (SSTR), KK, NN, (DST) + (size_t)m_ * (DSTR), LDT, ROFF, MODE, scr, it_ % per_, F.lane); } } while (0)
#define TR_BATCH(SRC, SSTR, CNT, KK, NN, DST, DSTR, LDT, ROFF, MODE) do { const int per_ = ((KK) / 64) * ((NN) / 32), tot_ = per_ * (CNT); \
    for (int it_ = F.gw; it_ < tot_; it_ += F.ngw) { const int m_ = it_ / per_; \
        transpose_item((SRC) + (size_t)m_ * (SSTR), KK, NN, (DST) + (size_t)m_ * (DSTR), LDT, ROFF, MODE, scr, it_ % per_, F.lane); } } while (0)

__device__ __forceinline__ void sincos_d(double ang, float& s, float& c) {
    const double k = rint(ang * 0.15915494309189535);
    double r = fma(-k, 6.283185307179586, ang); r = fma(-k, 2.4492935982947064e-16, r);
    const double r2 = r * r;
    double sp = -2.8114572543455206e-15;
    sp = fma(sp, r2, 7.647163731819816e-13); sp = fma(sp, r2, -1.6059043836821613e-10); sp = fma(sp, r2, 2.505210838544172e-08);
    sp = fma(sp, r2, -2.7557319223985893e-06); sp = fma(sp, r2, 1.984126984126984e-04); sp = fma(sp, r2, -8.333333333333333e-03);
    sp = fma(sp, r2, 1.6666666666666666e-01); sp = fma(-sp, r2, 1.0);
    double cp = 1.5619206968586225e-16;
    cp = fma(cp, r2, -4.779477332387385e-14); cp = fma(cp, r2, 1.1470745597729725e-11); cp = fma(cp, r2, -2.08767569878681e-09);
    cp = fma(cp, r2, 2.755731922398589e-07); cp = fma(cp, r2, -2.48015873015873e-05); cp = fma(cp, r2, 1.388888888888889e-03);
    cp = fma(cp, r2, -4.1666666666666664e-02); cp = fma(cp, r2, 0.5 * 1.0); cp = fma(-cp, r2, 1.0);
    s = (float)(sp * r); c = (float)cp;
}
__device__ __forceinline__ void ph_tables(const Frame& F, float* RTAB, float* AX64, float* AX32) {
    const int gt = F.bid * NTHR + F.tid, ngt = F.G * NTHR;
    const double L = 9.210340371976184;
    for (int i = gt; i < 8448 * 32; i += ngt) { const int pos = i >> 5, f = i & 31; float s, c; sincos_d((double)pos * exp(-L * (double)f / 32.0), s, c); RTAB[2 * i] = c; RTAB[2 * i + 1] = s; }
    for (int i = gt; i < 192 * 16; i += ngt) { const int p = i >> 4, f = i & 15; const int pos = p < 128 ? p : p - 128; float s, c; sincos_d((double)pos * exp(-L * (double)f / 16.0), s, c); AX64[2 * i] = c; AX64[2 * i + 1] = s; }
    for (int i = gt; i < 192 * 8; i += ngt) { const int p = i >> 3, f = i & 7; const int pos = p < 128 ? p : p - 128; float s, c; sincos_d((double)pos * exp(-L * (double)f / 8.0), s, c); AX32[2 * i] = c; AX32[2 * i + 1] = s; }
}

__device__ __forceinline__ void ph_adaln(const Frame& F, const float* H, const float* g, const float* modl  , int shift_i, int scale_i, bf16_t* XN, int nrows) {
    for (int m = F.gw; m < nrows; m += F.ngw) {
        const f32x4* xr = (const f32x4*)(H + (size_t)m * D) + F.lane;
        const float* mv = modl + (size_t)row_vec(m) * 6144;
        f32x4 v[4]; float s2 = 0.f;
#pragma unroll
        for (int j = 0; j < 4; ++j) { v[j] = xr[64 * j]; s2 += (v[j].x * v[j].x + v[j].y * v[j].y) + (v[j].z * v[j].z + v[j].w * v[j].w); }
        const float rstd = 1.f / sqrtf(wave_sum(s2) * (1.f / D) + NORM_EPS);
        u32x2* o = (u32x2*)(XN + (size_t)m * D) + F.lane;
#pragma unroll
        for (int j = 0; j < 4; ++j) { const int ci = 64 * j + F.lane; const f32x4 gg = ((const f32x4*)g)[ci], sc = ((const f32x4*)(mv + scale_i * D))[ci], sh = ((const f32x4*)(mv + shift_i * D))[ci];
            const f32x4 y = v[j] * rstd * gg * (sc + 1.f) + sh; o[64 * j] = (u32x2){pk2(y.x, y.y), pk2(y.z, y.w)}; }
    }
}

struct EpiStoreBf16 {
    static constexpr bool PERM = true;
    bf16_t* O; int ldc;
    __device__ __forceinline__ void operator()(const f32x4 (&acc)[2][2][4][2], const pg8::Unit& u, int wr, int wc, int fr, int fq) const {
        const int row0 = u.u0 + wr * 64 + fr, col0 = u.u1 + wc * 32 + 8 * fq;
#pragma unroll
        for (int ai = 0; ai < 2; ++ai)
#pragma unroll
            for (int m = 0; m < 4; ++m) { bf16_t* rowp = O + (size_t)(row0 + ai * 128 + m * 16) * ldc + col0;
#pragma unroll
                for (int bj = 0; bj < 2; ++bj) { const f32x4 v0 = acc[ai][bj][m][0], v1 = acc[ai][bj][m][1];
                    u32x4 w; w.x = pg8::cvt_pk_bf16(v0[0], v0[1]); w.y = pg8::cvt_pk_bf16(v0[2], v0[3]); w.z = pg8::cvt_pk_bf16(v1[0], v1[1]); w.w = pg8::cvt_pk_bf16(v1[2], v1[3]);
                    *(u32x4*)(rowp + bj * 128) = w; } }
    }
};
struct EpiGate {
    static constexpr bool PERM = true;
    bf16_t* O; int ldc; const float* bias;
    __device__ __forceinline__ void operator()(const f32x4 (&acc)[2][2][4][2], const pg8::Unit& u, int wr, int wc, int fr, int fq) const {
        const int row0 = u.u0 + wr * 64 + fr, col0 = u.u1 + wc * 32 + 8 * fq, bcol0 = u.u2 + wc * 32 + 8 * fq;
        f32x4 bv[2][2];
#pragma unroll
        for (int bj = 0; bj < 2; ++bj)
#pragma unroll
            for (int n = 0; n < 2; ++n) bv[bj][n] = *(const f32x4*)(bias + bcol0 + bj * 128 + 4 * n);
#pragma unroll
        for (int ai = 0; ai < 2; ++ai)
#pragma unroll
            for (int m = 0; m < 4; ++m) { bf16_t* rowp = O + (size_t)(row0 + ai * 128 + m * 16) * ldc + col0;
#pragma unroll
                for (int bj = 0; bj < 2; ++bj) { const f32x4 v0 = acc[ai][bj][m][0] + bv[bj][0], v1 = acc[ai][bj][m][1] + bv[bj][1];
                    const u32x4 old = *(const u32x4*)(rowp + bj * 128);
                    float y[8];
#pragma unroll
                    for (int e = 0; e < 4; ++e) { y[e] = sigmoid_f(v0[e]); y[4 + e] = sigmoid_f(v1[e]); }
#pragma unroll
                    for (int e = 0; e < 4; ++e) { const unsigned wv = old[e]; y[2 * e] *= __uint_as_float(wv << 16); y[2 * e + 1] *= __uint_as_float(wv & 0xffff0000u); }
                    u32x4 w; w.x = pg8::cvt_pk_bf16(y[0], y[1]); w.y = pg8::cvt_pk_bf16(y[2], y[3]); w.z = pg8::cvt_pk_bf16(y[4], y[5]); w.w = pg8::cvt_pk_bf16(y[6], y[7]);
                    *(u32x4*)(rowp + bj * 128) = w; }
                asm volatile("" ::: "memory"); }
    }
};
struct EpiResid {
    static constexpr bool PERM = false;
    float* H; const float* gate  ; const float* Xl; const float* Xc;
    __device__ __forceinline__ void operator()(const f32x4 (&acc)[2][2][4][2], const pg8::Unit& u, int wr, int wc, int fr, int fq) const {
        const int row0 = u.u0 + wr * 64 + fr, col0 = u.u1 + wc * 32 + 4 * fq;
        const float* gv = gate + (size_t)row_vec(u.u0) * 6144;
        const float* Hs = Xl ? (u.u0 < MLAT ? Xl : Xc - (size_t)MLAT * D) : H;
        f32x4 g4[2][2];
#pragma unroll
        for (int bj = 0; bj < 2; ++bj)
#pragma unroll
            for (int n = 0; n < 2; ++n) g4[bj][n] = *(const f32x4*)(gv + col0 + bj * 128 + n * 16);
        f32x4 ch[4], nh[4];
#define ER_LOAD(g_, X_) do { const float* rp_ = Hs + (size_t)(row0 + ((g_) >> 2) * 128 + ((g_) & 3) * 16) * D + col0; \
            _Pragma("unroll") for (int q_ = 0; q_ < 4; ++q_) X_[q_] = *(const f32x4*)(rp_ + (q_ >> 1) * 128 + (q_ & 1) * 16); } while (0)
        ER_LOAD(0, ch);
#pragma unroll
        for (int g = 0; g < 8; ++g) {
            if (g + 1 < 8) ER_LOAD(g + 1, nh);
            asm volatile("" ::: "memory");
            const int ai = g >> 2, m = g & 3; float* rowp = H + (size_t)(row0 + ai * 128 + m * 16) * D + col0;
#pragma unroll
            for (int q = 0; q < 4; ++q) *(f32x4*)(rowp + (q >> 1) * 128 + (q & 1) * 16) = ch[q] + g4[q >> 1][q & 1] * acc[ai][q >> 1][m][q & 1];
            asm volatile("" ::: "memory");
#pragma unroll
            for (int q = 0; q < 4; ++q) ch[q] = nh[q];
        }
#undef ER_LOAD
    }
};

__device__ __forceinline__ void xcd_tile(int L, int nM, int nN, int& pm, int& pn) {
    const int nwg = nM * nN, q = nwg / 8, r = nwg % 8, xcd = L % 8, off = L / 8;
    const int wgid = (xcd < r ? xcd * (q + 1) : r * (q + 1) + (xcd - r) * q) + off;
    const int nig = 8 * nN, gid = wgid / nig, fm = gid * 8, gsz = (nM - fm) < 8 ? (nM - fm) : 8;
    pm = fm + ((wgid % nig) % gsz); pn = (wgid % nig) / gsz;
}
constexpr int PN_FULL = 13;
struct SchedP {
    static constexpr int lda = D, ldb = D, K = D;
    const bf16_t* XN; const bf16_t* W; int G, c;
    __device__ __forceinline__ bool next(int i, pg8::Unit& u) const {
        const int L = i * G + c; if (L >= 132 * PN_FULL) return false;
        int pm, pn; xcd_tile(L, 132, PN_FULL, pm, pn);
        u.A = XN + (size_t)pm * 256 * D; u.B = W + (size_t)pn * 256 * D; u.u0 = pm * 256; u.u1 = pn * 256; u.u2 = 0; return true;
    }
};
struct SchedBranch {
    static constexpr int lda = D, ldb = 256, K = 256;
    const bf16_t* YB; const bf16_t* W  ; int nM, G, c;
    __device__ __forceinline__ bool next(int i, pg8::Unit& u) const {
        const int L = i * G + c; if (L >= nM * 16) return false;
        int pm, pq; xcd_tile(L, nM, 16, pm, pq); const int n = pq >> 2, pn = pq & 3;
        u.A = YB + (size_t)pm * 256 * D + n * 256; u.B = W + ((size_t)n * 1024 + pn * 256) * 256; u.u0 = pm * 256; u.u1 = n * 1024 + pn * 256; u.u2 = 0; return true;
    }
};
struct SchedGate {
    static constexpr int lda = D, ldb = D, K = D;
    const bf16_t* XN; const bf16_t* W  ; int nM, G, c;
    __device__ __forceinline__ bool next(int i, pg8::Unit& u) const {
        const int L = i * G + c; if (L >= nM * 16) return false;
        int pm, pn; xcd_tile(L, nM, 16, pm, pn);
        u.A = XN + (size_t)pm * 256 * D; u.B = W + (size_t)pn * 256 * D; u.u0 = pm * 256; u.u1 = pn * 256; u.u2 = pn * 256; return true;
    }
};
struct SchedOut {
    static constexpr int lda = D, ldb = D, K = D;
    const bf16_t* ACC; const bf16_t* W; int nM, G, c;
    __device__ __forceinline__ bool next(int i, pg8::Unit& u) const {
        const int L = i * G + c; if (L >= nM * 4) return false;
        int pm, pn; xcd_tile(L, nM, 4, pm, pn);
        u.A = ACC + (size_t)pm * 256 * D; u.B = W + (size_t)pn * 256 * D; u.u0 = pm * 256; u.u1 = pn * 256; u.u2 = 0; return true;
    }
};


struct SchedMerge {
    static constexpr int lda = D, ldb0 = 256, K0 = 256, ldb1 = D, K1 = D;
    const bf16_t *YB, *XN, *WB  , *WG  ; int nctx  , G, c;
    __device__ __forceinline__ bool next(int i, pg8::Unit& u) const {
        const int ntl = (c < 512) ? (511 - c) / G + 1 : 0;
        int pm, pn, n, rmw; const int kind = i & 1;
        if (i < 8 * ntl) { xcd_tile((i >> 3) * G + c, 128, 4, pm, pn); n = (i & 7) >> 1; rmw = 1; }
        else { const int q = c + ((i - 8 * ntl) >> 1) * G; if (q >= nctx) return false; pm = 128 + (q >> 4); pn = (q >> 2) & 3; n = q & 3; rmw = 0; }
        if (kind == 0) { u.A = YB + (size_t)pm * 256 * D + n * 256; u.B = WB + ((size_t)n * 1024 + pn * 256) * 256; }
        else           { u.A = XN + (size_t)pm * 256 * D;           u.B = WG + ((size_t)n * 1024 + pn * 256) * D; }
        u.u0 = pm * 256; u.u1 = n * 1024 + pn * 256; u.u2 = rmw; u.u3 = kind; return true;
    }
};
struct EpiMerge {
    static constexpr bool PERM = true;
    bf16_t* BOUT; bf16_t* ACC; const float* bias  ;
    __device__ __forceinline__ void operator()(const f32x4 (&acc)[2][2][4][2], const pg8::Unit& u, int wr, int wc, int fr, int fq) const {
        const int row0 = u.u0 + wr * 64 + fr, col0 = u.u1 + wc * 32 + 8 * fq, acol0 = (u.u1 & 1023) + wc * 32 + 8 * fq; const int n = u.u1 >> 10;
        if (u.u3 == 0) {
#pragma unroll
            for (int ai = 0; ai < 2; ++ai)
#pragma unroll
                for (int m = 0; m < 4; ++m) { bf16_t* rowp = BOUT + (size_t)(row0 + ai * 128 + m * 16) * 4096 + col0;
#pragma unroll
                    for (int bj = 0; bj < 2; ++bj) { const f32x4 v0 = acc[ai][bj][m][0], v1 = acc[ai][bj][m][1];
                        u32x4 w; w.x = pg8::cvt_pk_bf16(v0[0], v0[1]); w.y = pg8::cvt_pk_bf16(v0[2], v0[3]); w.z = pg8::cvt_pk_bf16(v1[0], v1[1]); w.w = pg8::cvt_pk_bf16(v1[2], v1[3]);
                        *(u32x4*)(rowp + bj * 128) = w; } }
            return;
        }
        f32x4 bv[2][2];
#pragma unroll
        for (int bj = 0; bj < 2; ++bj)
#pragma unroll
            for (int q = 0; q < 2; ++q) bv[bj][q] = *(const f32x4*)(bias + col0 + bj * 128 + 4 * q);
        const bool rmw = u.u2 != 0, hasprev = rmw && n > 0;
        u32x4 cb[2], cp[2], nb[2], np[2];
#define EM_LOAD(g_, B_, P_) do { const size_t r_ = (size_t)(row0 + ((g_) >> 2) * 128 + ((g_) & 3) * 16); \
            _Pragma("unroll") for (int bj_ = 0; bj_ < 2; ++bj_) { B_[bj_] = *(const u32x4*)(BOUT + r_ * 4096 + col0 + bj_ * 128); \
                P_[bj_] = hasprev ? *(const u32x4*)(ACC + r_ * D + acol0 + bj_ * 128) : (u32x4){0u, 0u, 0u, 0u}; } } while (0)
        EM_LOAD(0, cb, cp);
#pragma unroll
        for (int g = 0; g < 8; ++g) {
            if (g + 1 < 8) EM_LOAD(g + 1, nb, np);
            asm volatile("" ::: "memory");
            const int ai = g >> 2, m = g & 3; const size_t r = (size_t)(row0 + ai * 128 + m * 16); bf16_t* bp = BOUT + r * 4096 + col0; bf16_t* ap = ACC + r * D + acol0;
#pragma unroll
            for (int bj = 0; bj < 2; ++bj) { const f32x4 v0 = acc[ai][bj][m][0] + bv[bj][0], v1 = acc[ai][bj][m][1] + bv[bj][1];
                const u32x4 br = cb[bj], prev = cp[bj];
                float y[8];
#pragma unroll
                for (int e = 0; e < 4; ++e) { y[e] = sigmoid_f(v0[e]); y[4 + e] = sigmoid_f(v1[e]); }
#pragma unroll
                for (int e = 0; e < 4; ++e) { y[2 * e] = y[2 * e] * __uint_as_float(br[e] << 16) + __uint_as_float(prev[e] << 16); y[2 * e + 1] = y[2 * e + 1] * __uint_as_float(br[e] & 0xffff0000u) + __uint_as_float(prev[e] & 0xffff0000u); }
                u32x4 w; w.x = pg8::cvt_pk_bf16(y[0], y[1]); w.y = pg8::cvt_pk_bf16(y[2], y[3]); w.z = pg8::cvt_pk_bf16(y[4], y[5]); w.w = pg8::cvt_pk_bf16(y[6], y[7]);
                if (rmw) *(u32x4*)(ap + bj * 128) = w; else *(u32x4*)(bp + bj * 128) = w; }
            asm volatile("" ::: "memory");
#pragma unroll
            for (int bj = 0; bj < 2; ++bj) { cb[bj] = nb[bj]; cp[bj] = np[bj]; }
        }
#undef EM_LOAD
    }
};

__device__ __forceinline__ void ph_sum4(const Frame& F, const bf16_t* BOUT, bf16_t* ACC, int row_lo, int nrows) {
    const size_t n8 = (size_t)nrows * (D / 8);
    for (size_t i = (size_t)F.bid * NTHR + F.tid; i < n8; i += (size_t)F.G * NTHR) {
        const size_t row = (size_t)row_lo + (i >> 7); const int c8 = (int)(i & 127);
        const u32x4* p = (const u32x4*)(BOUT + row * 4096) + c8;
        float s[8] = {0.f, 0.f, 0.f, 0.f, 0.f, 0.f, 0.f, 0.f};
#pragma unroll
        for (int n = 0; n < 4; ++n) { const u32x4 w = p[n * 128];
#pragma unroll
            for (int e = 0; e < 4; ++e) { s[2 * e] += __uint_as_float(w[e] << 16); s[2 * e + 1] += __uint_as_float(w[e] & 0xffff0000u); } }
        u32x4 o; o.x = pk2(s[0], s[1]); o.y = pk2(s[2], s[3]); o.z = pk2(s[4], s[5]); o.w = pk2(s[6], s[7]);
        ((u32x4*)(ACC + row * D))[c8] = o;
    }
}


struct PrepArgs { const bf16_t* P; bf16_t *QA, *KA, *RQ, *RK, *CQN, *CKVN, *KC; const float *RTAB, *AX64, *AX32, *g_qnorm, *g_kvnorm; };
__device__ __forceinline__ float half32_sum_(float v) { v += __shfl_xor(v, 1); v += __shfl_xor(v, 2); v += __shfl_xor(v, 4); v += __shfl_xor(v, 8); v += __shfl_xor(v, 16); return v; }
__device__ __forceinline__ void up8(const u32x4& w, float (&o)[8]) {
#pragma unroll
    for (int i = 0; i < 4; ++i) { o[2 * i] = __uint_as_float(w[i] << 16); o[2 * i + 1] = __uint_as_float(w[i] & 0xffff0000u); } }
__device__ __forceinline__ void ph_prep(const Frame& F, const PrepArgs& a) {
    const int lane = F.lane, l32 = lane & 31;
    for (int rp = F.gw; rp < MALL / 2; rp += F.ngw) {
        const int row = 2 * rp + (lane >> 5);
        const bool lat = row < MLAT;
        const int t = lat ? (row & 8191) : ((row - MLAT) & 255), trow = t >> 6, tcol = t & 63;
        const bf16_t* p = a.P + (size_t)row * NINP;
        constexpr float QS = 0.125f * 1.4426950408889634f;
#pragma unroll
        for (int rep = 0; rep < 2; ++rep) { const int ch = l32 + 32 * rep;
            if (rep == 0 || l32 < 16) {
                const int k8 = ch & 7; const bool first = (k8 & 2) == 0; const bf16_t* src = p + 8 * ch;
                float x[8], q[8]; up8(*(const u32x4*)src, x); up8(*(const u32x4*)(first ? src + 16 : src - 16), q);
                float o[8];
                if (lat) { const f32x4* tb = (const f32x4*)(a.AX64 + (size_t)((k8 < 4) ? trow : 128 + tcol) * 32 + 16 * (k8 & 1));
#pragma unroll
                    for (int i4 = 0; i4 < 4; ++i4) { const f32x4 cs = tb[i4];
                        o[2 * i4] = first ? x[2 * i4] * cs[0] - q[2 * i4] * cs[1] : x[2 * i4] * cs[0] + q[2 * i4] * cs[1];
                        o[2 * i4 + 1] = first ? x[2 * i4 + 1] * cs[2] - q[2 * i4 + 1] * cs[3] : x[2 * i4 + 1] * cs[2] + q[2 * i4 + 1] * cs[3]; } }
                else {
#pragma unroll
                    for (int i = 0; i < 8; ++i) o[i] = x[i]; }
                const float sc = rep == 0 ? QS : 1.f;
                bf16_t* dst = rep == 0 ? (a.QA + (size_t)row * 256 + 8 * ch) : (a.KA + (size_t)row * 128 + 8 * (ch - 32));
                *(u32x4*)dst = (u32x4){pk2(o[0] * sc, o[1] * sc), pk2(o[2] * sc, o[3] * sc), pk2(o[4] * sc, o[5] * sc), pk2(o[6] * sc, o[7] * sc)}; } }
        { float x[8]; up8(*(const u32x4*)(p + 1792 + 8 * l32), x); float s2 = 0.f;
#pragma unroll
          for (int e = 0; e < 8; ++e) s2 += x[e] * x[e];
          const float rstd = 1.f / sqrtf(half32_sum_(s2) * (1.f / 256.f) + NORM_EPS);
          const f32x4 g0 = *((const f32x4*)a.g_qnorm + 2 * l32), g1 = *((const f32x4*)a.g_qnorm + 2 * l32 + 1);
          *((u32x4*)(a.CQN + (size_t)row * 256) + l32) = (u32x4){pk2(x[0] * rstd * g0[0], x[1] * rstd * g0[1]), pk2(x[2] * rstd * g0[2], x[3] * rstd * g0[3]), pk2(x[4] * rstd * g1[0], x[5] * rstd * g1[1]), pk2(x[6] * rstd * g1[2], x[7] * rstd * g1[3])};
          const u32x2 yw = *(const u32x2*)(p + 2048 + 4 * l32);
          const float y0 = __uint_as_float(yw.x << 16), y1 = __uint_as_float(yw.x & 0xffff0000u), y2 = __uint_as_float(yw.y << 16), y3 = __uint_as_float(yw.y & 0xffff0000u);
          const float rstd2 = 1.f / sqrtf(half32_sum_((y0 * y0 + y1 * y1) + (y2 * y2 + y3 * y3)) * (1.f / 128.f) + NORM_EPS);
          const f32x4 gk = *((const f32x4*)a.g_kvnorm + l32);
          *((u32x2*)(a.CKVN + (size_t)row * 128) + l32) = (u32x2){pk2(y0 * rstd2 * gk[0], y1 * rstd2 * gk[1]), pk2(y2 * rstd2 * gk[2], y3 * rstd2 * gk[3])};
          if (l32 < 4) { const int k4 = l32; const bool first = (k4 & 1) == 0; const bf16_t* src = p + 2176 + 8 * k4;
              float xx[8], qq[8], o[8]; up8(*(const u32x4*)src, xx); up8(*(const u32x4*)(first ? src + 8 : src - 8), qq);
              if (lat) { const f32x4* tb = (const f32x4*)(a.AX32 + (size_t)((k4 < 2) ? trow : 128 + tcol) * 16);
#pragma unroll
                  for (int i4 = 0; i4 < 4; ++i4) { const f32x4 cs = tb[i4];
                      o[2 * i4] = first ? xx[2 * i4] * cs[0] - qq[2 * i4] * cs[1] : xx[2 * i4] * cs[0] + qq[2 * i4] * cs[1];
                      o[2 * i4 + 1] = first ? xx[2 * i4 + 1] * cs[2] - qq[2 * i4 + 1] * cs[3] : xx[2 * i4 + 1] * cs[2] + qq[2 * i4 + 1] * cs[3]; } }
              else {
#pragma unroll
                  for (int i = 0; i < 8; ++i) o[i] = xx[i]; }
              const u32x4 ow = (u32x4){pk2(o[0], o[1]), pk2(o[2], o[3]), pk2(o[4], o[5]), pk2(o[6], o[7])};
#pragma unroll
              for (int h = 0; h < 4; ++h) *(u32x4*)(a.KC + (size_t)row * 384 + h * 96 + 64 + 8 * k4) = ow; } }
    }
}

template <int KD> __device__ __forceinline__ f32x16 wave_mm32(const bf16x8 (&af)[KD / 16], const bf16_t* Bt, int ldb, int lane) {
    f32x16 acc = {0.f,0.f,0.f,0.f,0.f,0.f,0.f,0.f,0.f,0.f,0.f,0.f,0.f,0.f,0.f,0.f};
    const bf16_t* bp = Bt + (size_t)(lane & 31) * ldb + 8 * (lane >> 5);
#pragma unroll
    for (int s = 0; s < KD / 16; ++s) { const bf16x8 b = *(const bf16x8*)(bp + 16 * s); acc = __builtin_amdgcn_mfma_f32_32x32x16_bf16(af[s], b, acc, 0, 0, 0); }
    return acc;
}
struct RwkvW { const float *mu, *w0, *a0, *k_k, *k_a, *r_k; const bf16_t *wup_t, *aup_t, *gup_t; };
struct RwkvF { bf16_t *R, *V, *KF, *KB, *KK, *BF, *BB, *EF, *EB, *G; float* BONUS; };
__device__ __forceinline__ float half32_sum(float v) { v += __shfl_xor(v, 1); v += __shfl_xor(v, 2); v += __shfl_xor(v, 4); v += __shfl_xor(v, 8); v += __shfl_xor(v, 16); return v; }
__device__ __forceinline__ float softplus_f(float y) { return fmaxf(y, 0.f) + __logf(1.f + __expf(-fabsf(y))); }
__device__ __forceinline__ float tanh_f(float x) { return 1.f - 2.f * __builtin_amdgcn_rcpf(__expf(2.f * x) + 1.f); }
__device__ __forceinline__ void rw_z8(const bf16_t* pc  , bool hp, bool hn, const float* mu, float (&z)[8]) {
    const u32x4 cu = *(const u32x4*)pc; u32x4 pv = {0u, 0u, 0u, 0u}, nv = pv;
    if (hp) pv = *(const u32x4*)(pc - NINP);
    if (hn) nv = *(const u32x4*)(pc + NINP);
    const f32x4 m0 = *(const f32x4*)mu, m1 = *(const f32x4*)(mu + 4);
#pragma unroll
    for (int e = 0; e < 4; ++e) {
        const float c0 = __uint_as_float(cu[e] << 16), c1 = __uint_as_float(cu[e] & 0xffff0000u);
        const float s0 = 0.5f * (__uint_as_float(pv[e] << 16) + __uint_as_float(nv[e] << 16)), s1 = 0.5f * (__uint_as_float(pv[e] & 0xffff0000u) + __uint_as_float(nv[e] & 0xffff0000u));
        const float mu0 = (e < 2) ? m0[2 * e] : m1[2 * e - 4], mu1 = (e < 2) ? m0[2 * e + 1] : m1[2 * e - 3];
        z[2 * e] = c0 + (s0 - c0) * mu0; z[2 * e + 1] = c1 + (s1 - c1) * mu1; }
}
template <int KD> __device__ __forceinline__ f32x16 wave_mm32_lds(const bf16x8 (&af)[KD / 16], const LAS unsigned char* img, int n0, int lane) {
    f32x16 acc = {0.f,0.f,0.f,0.f,0.f,0.f,0.f,0.f,0.f,0.f,0.f,0.f,0.f,0.f,0.f,0.f};
    const int n = n0 + (lane & 31), hi = lane >> 5; const LAS unsigned char* rp = img + n * (KD * 2);
#pragma unroll
    for (int s = 0; s < KD / 16; ++s) { const bf16x8 b = *(const LAS bf16x8*)(rp + (((2 * s + hi) ^ (n & 7)) << 4)); acc = __builtin_amdgcn_mfma_f32_32x32x16_bf16(af[s], b, acc, 0, 0, 0); }
    return acc;
}
template <int KD> __device__ __forceinline__ f32x16 wave_mm32t_lds(const bf16x8 (&af)[KD / 16], const LAS unsigned char* img, int n0, int lane) {
    f32x16 acc = {0.f,0.f,0.f,0.f,0.f,0.f,0.f,0.f,0.f,0.f,0.f,0.f,0.f,0.f,0.f,0.f};
    const int n = n0 + (lane & 31), hi = lane >> 5; const LAS unsigned char* rp = img + n * (KD * 2);
#pragma unroll
    for (int s = 0; s < KD / 16; ++s) { const bf16x8 b = *(const LAS bf16x8*)(rp + (((2 * s + hi) ^ (n & 7)) << 4)); acc = __builtin_amdgcn_mfma_f32_32x32x16_bf16(b, af[s], acc, 0, 0, 0); }
    return acc;
}
template <int KD, bool PERMT, int ROWS> __device__ __forceinline__ void stage_weights(const Frame& F, const bf16_t* src, LAS unsigned char* img) {
    constexpr int CH = KD / 8; static_assert((ROWS * CH) % NTHR == 0, "whole rounds");
#pragma unroll
    for (int k = 0; k < ROWS * CH / NTHR; ++k) { const int i = k * NTHR + F.tid, n = i / CH, c = (i % CH) ^ (n & 7), rho = n & 31;
        const int ns = PERMT ? (n & ~31) + 16 * ((rho >> 2) & 1) + (rho & 3) + 4 * (rho >> 3) : n;
        __builtin_amdgcn_global_load_lds((const unsigned*)(src + (size_t)ns * KD + 8 * c), (LAS unsigned*)(img + (k * NTHR + F.wave * 64) * 16), 16, 0, 0); }
    asm volatile("s_waitcnt vmcnt(0)" ::: "memory");
}
__device__ __forceinline__ void ph_p_tailcols(const Frame& F, const bf16_t* XN, const bf16_t* WT  , bf16_t* P, int gw_, int ngw_) {
    const int lane = F.lane, r32 = lane & 31, hi = lane >> 5;
    __syncthreads();
    stage_weights<1024, true, 32>(F, WT + (size_t)(PN_FULL * 256) * D, F.lds);
    __syncthreads();
    const LAS unsigned char* rp = F.lds + r32 * 2048;
    for (int tile = gw_; tile < MALL / 32; tile += ngw_) {
        const bf16_t* ap = XN + (size_t)(tile * 32 + r32) * D + 8 * hi;
        f32x16 acc = {0.f,0.f,0.f,0.f,0.f,0.f,0.f,0.f,0.f,0.f,0.f,0.f,0.f,0.f,0.f,0.f};
#pragma unroll 1
        for (int s0 = 0; s0 < 64; s0 += 16) { bf16x8 a[16];
#pragma unroll
            for (int s = 0; s < 16; ++s) a[s] = *(const bf16x8*)(ap + 16 * (s0 + s));
#pragma unroll
            for (int s = 0; s < 16; ++s) { const bf16x8 bq = *(const LAS bf16x8*)(rp + (((2 * (s0 + s) + hi) ^ (r32 & 7)) << 4)); acc = __builtin_amdgcn_mfma_f32_32x32x16_bf16(bq, a[s], acc, 0, 0, 0); } }
        u32x4* d = (u32x4*)(P + (size_t)(tile * 32 + r32) * NINP + PN_FULL * 256 + 16 * hi);
        d[0] = (u32x4){pk2(acc[0], acc[1]), pk2(acc[2], acc[3]), pk2(acc[4], acc[5]), pk2(acc[6], acc[7])};
        d[1] = (u32x4){pk2(acc[8], acc[9]), pk2(acc[10], acc[11]), pk2(acc[12], acc[13]), pk2(acc[14], acc[15])};
    }
    __syncthreads();
}
__device__ __forceinline__ void ph_mla_proj(const Frame& F, const bf16_t* CQN, const bf16_t* CKVN, const bf16_t* WUQ_T, const bf16_t* WUKV_T, const float* AX32, bf16_t* QC, bf16_t* KC, bf16_t* VC) {
    const int lane = F.lane, r32 = lane & 31, hi = lane >> 5, w = F.wave;
    constexpr float QS = 0.10206207261596577f * 1.4426950408889634f;
    constexpr int NT = MALL / 32;
    const int nx = (4 * F.G + F.bid < NT) ? (NT - 4 * F.G - F.bid - 1) / F.G + 1 : 0;
    const int tmain = (w >> 1) * F.G + F.bid;
    auto do_q = [&](int tile, int nlo, int nhi, int nb0) {
        if (tile >= NT) return;
        const int row0 = tile * 32; const bool lat = row0 < MLAT; const int t = (lat ? (row0 & 8191) : 0) + r32;
        bf16x8 af[16];
        int hl = hi; asm volatile("" : "+v"(hl));
#pragma unroll
        for (int s = 0; s < 16; ++s) af[s] = *(const bf16x8*)(CQN + (size_t)(row0 + r32) * 256 + 16 * s + 8 * hl);
#pragma unroll 1
        for (int nb = nlo; nb < nhi; ++nb) {
            f32x16 acc = wave_mm32t_lds<256>(af, F.lds, 32 * (nb - nb0), lane);
            if (nb % 3 == 2 && lat) {
                const f32x4* tb = (const f32x4*)(AX32 + (size_t)(hl == 0 ? (t >> 6) : 128 + (t & 63)) * 16);
#pragma unroll
                for (int q = 0; q < 4; ++q) { const f32x4 cs = tb[q];
#pragma unroll
                    for (int e = 0; e < 2; ++e) { const int j = 2 * q + e; const float c = cs[2 * e], s = cs[2 * e + 1], x1 = acc[j], x2 = acc[j + 8]; acc[j] = x1 * c - x2 * s; acc[j + 8] = x2 * c + x1 * s; } }
            }
            u32x4* d = (u32x4*)(QC + (size_t)(row0 + r32) * 384 + 32 * nb + 16 * hl);
            d[0] = (u32x4){pk2(acc[0] * QS, acc[1] * QS), pk2(acc[2] * QS, acc[3] * QS), pk2(acc[4] * QS, acc[5] * QS), pk2(acc[6] * QS, acc[7] * QS)};
            d[1] = (u32x4){pk2(acc[8] * QS, acc[9] * QS), pk2(acc[10] * QS, acc[11] * QS), pk2(acc[12] * QS, acc[13] * QS), pk2(acc[14] * QS, acc[15] * QS)};
        }
    };
    auto do_kv = [&](int tile, int nlo, int nhi) {
        if (tile >= NT) return;
        const int row0 = tile * 32;
        bf16x8 af[8];
        int hl = hi; asm volatile("" : "+v"(hl));
#pragma unroll
        for (int s = 0; s < 8; ++s) af[s] = *(const bf16x8*)(CKVN + (size_t)(row0 + r32) * 128 + 16 * s + 8 * hl);
#pragma unroll 1
        for (int nb = nlo; nb < nhi; ++nb) {
            const f32x16 acc = wave_mm32t_lds<128>(af, F.lds, 32 * nb, lane);
            const int head = nb >> 2, sub = nb & 3;
            bf16_t* dst = sub < 2 ? (KC + (size_t)(row0 + r32) * 384 + head * 96 + sub * 32) : (VC + (size_t)(row0 + r32) * 256 + head * 64 + (sub - 2) * 32);
            u32x4* d = (u32x4*)(dst + 16 * hl);
            d[0] = (u32x4){pk2(acc[0], acc[1]), pk2(acc[2], acc[3]), pk2(acc[4], acc[5]), pk2(acc[6], acc[7])};
            d[1] = (u32x4){pk2(acc[8], acc[9]), pk2(acc[10], acc[11]), pk2(acc[12], acc[13]), pk2(acc[14], acc[15])};
        }
    };
#pragma unroll 1
    for (int st = 0; st < 2; ++st) {
        __syncthreads();
        stage_weights<256, true, 192>(F, WUQ_T + (size_t)st * 192 * 256, F.lds);
        __syncthreads();
        do_q(tmain, 6 * st + 3 * (w & 1), 6 * st + 3 * (w & 1) + 3, 6 * st);
#pragma unroll 1
        for (int j = 0; j < nx; ++j) if (w < 6) do_q(4 * F.G + F.bid + j * F.G, 6 * st + w, 6 * st + w + 1, 6 * st);
    }
    __syncthreads();
    stage_weights<128, true, 512>(F, WUKV_T, F.lds);
    __syncthreads();
    do_kv(tmain, 8 * (w & 1), 8 * (w & 1) + 8);
#pragma unroll 1
    for (int j = 0; j < nx; ++j) do_kv(4 * F.G + F.bid + j * F.G, 2 * w, 2 * w + 2);
    __syncthreads();
}
__device__ __forceinline__ void ph_rwkv_featX(const Frame& F, const bf16_t* P, const RwkvW& W, const RwkvF& O) {
    const int lane = F.lane, r32 = lane & 31, hi = lane >> 5, w = F.wave;
    constexpr int DS = 2208, NT = MALL / 32;
    const int nx = (4 * F.G + F.bid < NT) ? (NT - 4 * F.G - F.bid - 1) / F.G + 1 : 0;
    __syncthreads();
    stage_weights<64, true, 512>(F, W.wup_t, F.lds); stage_weights<64, true, 512>(F, W.aup_t, F.lds + 65536);
    __syncthreads();
#pragma unroll 1
    for (int j = 0; j < 2 + nx; ++j) {
        int tile, g, nlo, nhi;
        if (j < 2) { tile = (w >> 1) * F.G + F.bid; g = 2 * (w & 1) + j; nlo = 0; nhi = 8; }
        else { tile = 4 * F.G + F.bid + (j - 2) * F.G; g = w >> 1; nlo = 4 * (w & 1); nhi = nlo + 4; }
        if (tile >= NT) continue;
        const int row0 = tile * 32; const bool lat = row0 < MLAT; const int t0 = lat ? (row0 & 8191) : ((row0 - MLAT) & 255), slen = lat ? SEQ : CTXL;
        const bool hp = !(t0 == 0 && r32 == 0), hn = !(t0 + 32 == slen && r32 == 31);
        const bf16_t* pc = P + (size_t)(row0 + r32) * NINP + DS;
        bf16x8 af[4];
        int hl = hi; asm volatile("" : "+v"(hl));
#pragma unroll
        for (int s = 0; s < 4; ++s) { const int col = 768 + 64 * g + 16 * s + 8 * hl; float z[8]; rw_z8(pc + col, hp, hn, W.mu + col, z);
            if (g < 2) {
#pragma unroll
                for (int e = 0; e < 8; ++e) z[e] = tanh_f(z[e]); }
            u32x4 wv; wv.x = pk2(z[0], z[1]); wv.y = pk2(z[2], z[3]); wv.z = pk2(z[4], z[5]); wv.w = pk2(z[6], z[7]); af[s] = __builtin_bit_cast(bf16x8, wv); }
        const float* bias = (g < 2 ? W.w0 : W.a0) + (g & 1) * 256;
        bf16_t* dst = O.BF + (size_t)(g < 2 ? 2 + g : g - 2) * (E_STRIDE / 2);
#pragma unroll 1
        for (int nb = nlo; nb < nhi; ++nb) {
            const f32x16 acc = wave_mm32t_lds<64>(af, F.lds, g * 256 + 32 * nb, lane);
            const int c0 = 32 * nb + 16 * hl; const f32x4* bp = (const f32x4*)(bias + c0);
            auto act = [&](float x) { const float sg = sigmoid_f(x); return g < 2 ? 0.6065306597126334f * sg : sg; };
            const f32x4 b0 = bp[0], b1 = bp[1], b2 = bp[2], b3 = bp[3];
            u32x4 o0, o1;
            o0.x = pk2(act(b0.x + acc[0]), act(b0.y + acc[1])); o0.y = pk2(act(b0.z + acc[2]), act(b0.w + acc[3]));
            o0.z = pk2(act(b1.x + acc[4]), act(b1.y + acc[5])); o0.w = pk2(act(b1.z + acc[6]), act(b1.w + acc[7]));
            o1.x = pk2(act(b2.x + acc[8]), act(b2.y + acc[9])); o1.y = pk2(act(b2.z + acc[10]), act(b2.w + acc[11]));
            o1.z = pk2(act(b3.x + acc[12]), act(b3.y + acc[13])); o1.w = pk2(act(b3.z + acc[14]), act(b3.w + acc[15]));
            u32x4* d = (u32x4*)(dst + (size_t)(row0 + r32) * 256 + c0);
            d[0] = o0; d[1] = o1;
        }
    }
    __syncthreads();
    stage_weights<128, true, 256>(F, W.gup_t, F.lds);
    __syncthreads();
#pragma unroll 1
    for (int j = 0; j < 1 + nx; ++j) {
        int tile, nlo, nhi;
        if (j < 1) { tile = (w >> 1) * F.G + F.bid; nlo = 4 * (w & 1); nhi = nlo + 4; }
        else { tile = 4 * F.G + F.bid + (j - 1) * F.G; nlo = w; nhi = w + 1; }
        if (tile >= NT) continue;
        const int row0 = tile * 32; const bool lat = row0 < MLAT; const int t0 = lat ? (row0 & 8191) : ((row0 - MLAT) & 255), slen = lat ? SEQ : CTXL;
        const bool hp = !(t0 == 0 && r32 == 0), hn = !(t0 + 32 == slen && r32 == 31);
        const bf16_t* pc = P + (size_t)(row0 + r32) * NINP + DS;
        bf16x8 af[8];
        int hl = hi; asm volatile("" : "+v"(hl));
#pragma unroll
        for (int s = 0; s < 8; ++s) { const int col = 1024 + 16 * s + 8 * hl; float z[8]; rw_z8(pc + col, hp, hn, W.mu + col, z);
#pragma unroll
            for (int e = 0; e < 8; ++e) z[e] = sigmoid_f(z[e]);
            u32x4 wv; wv.x = pk2(z[0], z[1]); wv.y = pk2(z[2], z[3]); wv.z = pk2(z[4], z[5]); wv.w = pk2(z[6], z[7]); af[s] = __builtin_bit_cast(bf16x8, wv); }
#pragma unroll 1
        for (int nb = nlo; nb < nhi; ++nb) {
            const f32x16 acc = wave_mm32t_lds<128>(af, F.lds, 32 * nb, lane);
            u32x4* d = (u32x4*)(O.G + (size_t)(row0 + r32) * 256 + 32 * nb + 16 * hl);
            d[0] = (u32x4){pk2(acc[0], acc[1]), pk2(acc[2], acc[3]), pk2(acc[4], acc[5]), pk2(acc[6], acc[7])};
            d[1] = (u32x4){pk2(acc[8], acc[9]), pk2(acc[10], acc[11]), pk2(acc[12], acc[13]), pk2(acc[14], acc[15])};
        }
    }
    __syncthreads();
}
__device__ __forceinline__ void unpack8(const u32x4& w, float (&o)[8]) {
#pragma unroll
    for (int i = 0; i < 4; ++i) { o[2 * i] = __uint_as_float(w[i] << 16); o[2 * i + 1] = __uint_as_float(w[i] & 0xffff0000u); } }
__device__ __forceinline__ float grp8_sum(float v) { v += __shfl_xor(v, 1); v += __shfl_xor(v, 2); v += __shfl_xor(v, 4); return v; }
__device__ __forceinline__ void ph_rwkv_featY(const Frame& F, const bf16_t* P, const RwkvW& W, const RwkvF& O) {
    constexpr int DS = 2208;
    const int lane = F.lane, l32 = lane & 31, c0 = 8 * l32;
    for (int rp = F.gw; rp < MALL / 2; rp += F.ngw) {
        const int row = 2 * rp + (lane >> 5);
        const bool lat = row < MLAT; const int t = lat ? (row & 8191) : ((row - MLAT) & 255), slen = lat ? SEQ : CTXL;
        const bool hp = t != 0, hn = t != slen - 1;
        float z[3][8];
#pragma unroll
        for (int sec = 0; sec < 3; ++sec) rw_z8(P + (size_t)row * NINP + DS + 256 * sec + c0, hp, hn, W.mu + 256 * sec + c0, z[sec]);
        const size_t o = (size_t)row * 256 + c0;
        float af[8], ab[8], kkw[8], kaw[8], rkw[8];
        unpack8(*(const u32x4*)(O.BF + o), af); unpack8(*(const u32x4*)(O.BB + o), ab);
#pragma unroll
        for (int h = 0; h < 2; ++h) { const f32x4 a = *(const f32x4*)(W.k_k + c0 + 4 * h), bq = *(const f32x4*)(W.k_a + c0 + 4 * h), cq = *(const f32x4*)(W.r_k + c0 + 4 * h);
#pragma unroll
            for (int e = 0; e < 4; ++e) { kkw[4 * h + e] = a[e]; kaw[4 * h + e] = bq[e]; rkw[4 * h + e] = cq[e]; } }
        float kx[8], ss = 0.f;
#pragma unroll
        for (int e = 0; e < 8; ++e) { kx[e] = z[1][e] * kkw[e]; ss += kx[e] * kx[e]; }
        const float inv = 1.f / fmaxf(sqrtf(grp8_sum(ss)), 1e-12f);
        float kk[8], kf[8], kb[8], bfv[8], bbv[8], bon = 0.f;
#pragma unroll
        for (int e = 0; e < 8; ++e) { kk[e] = kx[e] * inv; kf[e] = z[1][e] * (1.f + (af[e] - 1.f) * kaw[e]); kb[e] = z[1][e] * (1.f + (ab[e] - 1.f) * kaw[e]); bon += z[0][e] * (kf[e] + kb[e]) * rkw[e];
            bfv[e] = kk[e] * af[e]; bbv[e] = kk[e] * ab[e]; }
        bon = grp8_sum(bon);
        if ((l32 & 7) == 0) O.BONUS[(size_t)row * 4 + (l32 >> 3)] = bon;
#define ST8(arr, v) *(u32x4*)((arr) + o) = (u32x4){pk2((v)[0], (v)[1]), pk2((v)[2], (v)[3]), pk2((v)[4], (v)[5]), pk2((v)[6], (v)[7])}
        ST8(O.R, z[0]); ST8(O.V, z[2]); ST8(O.KF, kf); ST8(O.KB, kb); ST8(O.KK, kk); ST8(O.BF, bfv); ST8(O.BB, bbv);
#undef ST8
    }
}

__device__ __forceinline__ void ph_rwkv_scan(const Frame& F, const RwkvF& I, bf16_t* REF) {
    if (F.bid < 4 || F.bid >= 8 || F.wave != 0) return;
    const int task = 9 * (F.bid - 4), dir = task & 1, hd = (task >> 1) & 3, b = task >> 3, lane = F.lane;
    const bf16_t* Ed = dir ? I.EB : I.EF; const bf16_t* Kd = dir ? I.KB : I.KF; const bf16_t* Bd = dir ? I.BB : I.BF;
    float S[64];
#pragma unroll
    for (int k = 0; k < 64; ++k) S[k] = 0.f;
#define RL(x, k) __int_as_float(__builtin_amdgcn_readlane(__float_as_int(x), k))
    for (int seg = 0; seg < 2; ++seg) {
        const int n = seg == 0 ? CTXL : SEQ; const int base = seg == 0 ? MLAT + b * CTXL : b * SEQ;
        for (int st = 0; st < n; ++st) {
            const int row = base + (dir == 0 ? st : n - 1 - st); const size_t o = (size_t)row * 256 + hd * 64 + lane;
            const float w = __expf(-bf2f(Ed[o])), kk = bf2f(I.KK[o]), bb = bf2f(Bd[o]), kh = bf2f(Kd[o]), rr = bf2f(I.R[o]), v = bf2f(I.V[o]);
            float sa = 0.f;
#pragma unroll
            for (int k = 0; k < 64; ++k) sa -= S[k] * RL(kk, k);
            float y = 0.f;
#pragma unroll
            for (int k = 0; k < 64; ++k) { S[k] = S[k] * RL(w, k) + sa * RL(bb, k) + v * RL(kh, k); y += S[k] * RL(rr, k); }
            REF[((size_t)F.bid * 8448 + (seg == 0 ? row - base : 256 + row - base)) * 64 + lane] = (bf16_t)f2bf(y);
        }
    }
#undef RL
}
__device__ __forceinline__ void ph_rwkv_combine(const Frame& F, const bf16_t* RWY, const RwkvF& I, const float* lnx_w, const float* lnx_b, bf16_t* YB, int nrows) {
    for (int row = F.gw; row < nrows; row += F.ngw) {
        const u32x2 y0 = *((const u32x2*)(RWY + (size_t)row * 256) + F.lane), y1 = *((const u32x2*)(RWY + ((size_t)MALL + row) * 256) + F.lane);
        const u32x2 vw = *((const u32x2*)(I.V + (size_t)row * 256) + F.lane), gw = *((const u32x2*)(I.G + (size_t)row * 256) + F.lane);
        float y[4] = {__uint_as_float(y0.x << 16) + __uint_as_float(y1.x << 16), __uint_as_float(y0.x & 0xffff0000u) + __uint_as_float(y1.x & 0xffff0000u),
                      __uint_as_float(y0.y << 16) + __uint_as_float(y1.y << 16), __uint_as_float(y0.y & 0xffff0000u) + __uint_as_float(y1.y & 0xffff0000u)};
        const float v[4] = {__uint_as_float(vw.x << 16), __uint_as_float(vw.x & 0xffff0000u), __uint_as_float(vw.y << 16), __uint_as_float(vw.y & 0xffff0000u)};
        const float g[4] = {__uint_as_float(gw.x << 16), __uint_as_float(gw.x & 0xffff0000u), __uint_as_float(gw.y << 16), __uint_as_float(gw.y & 0xffff0000u)};
        const float mean = grp16_sum(y[0] + y[1] + y[2] + y[3]) * (1.f / 64.f);
        float s2 = 0.f;
#pragma unroll
        for (int e = 0; e < 4; ++e) { y[e] -= mean; s2 += y[e] * y[e]; }
        const float rstd = 1.f / sqrtf(grp16_sum(s2) * (1.f / 64.f) + 64e-5f);
        const float bonus = I.BONUS[(size_t)row * 4 + (F.lane >> 4)];
        const f32x4 lw = *((const f32x4*)lnx_w + F.lane), lb = *((const f32x4*)lnx_b + F.lane);
        float o[4];
#pragma unroll
        for (int e = 0; e < 4; ++e) o[e] = (y[e] * rstd * lw[e] + lb[e] + bonus * v[e]) * g[e];
        *((u32x2*)(YB + (size_t)row * D + 768) + F.lane) = (u32x2){pk2(o[0], o[1]), pk2(o[2], o[3])};
    }
}


constexpr int CP = 72;
constexpr int CK_LF = 0, CK_AL = 17408, CK_ALT = 26624, CK_BE = 35840, CK_KA = 45056, CK_RH = 54272, CK_BPT = 63488, CK_KPT = 72704, CK_VT = 81920, CK_TT = 91136, CK_AK = 100352, CK_M1 = 109568, CK_M2 = 118784;
static_assert(CK_M2 + 9216 <= RING_BYTES, "chunk LDS map");
constexpr int CK_GC = LDSCTL_OFF + 4096;
struct ChunkSrc { const bf16_t *E, *KK, *B, *KH, *R, *V; int ldv; float econst; const float* rtab; };
__device__ __forceinline__ int chunk_row(int b, int dir, int c, int t) {
    const bool ctx = c < 4; const int n = ctx ? CTXL : SEQ, st = (ctx ? 64 * c : 64 * (c - 4)) + t;
    return (ctx ? MLAT + b * CTXL : b * SEQ) + (dir ? n - 1 - st : st);
}
__device__ __forceinline__ f32x16 nt_tile(const LAS unsigned char* X, const LAS unsigned char* Y, int mi, int ni, int lane) {
    const int r32 = lane & 31, hi = lane >> 5;
    const LAS unsigned char* xp = X + ((32 * mi + r32) * CP + 8 * hi) * 2; const LAS unsigned char* yp = Y + ((32 * ni + r32) * CP + 8 * hi) * 2;
    f32x16 acc = {0.f,0.f,0.f,0.f,0.f,0.f,0.f,0.f,0.f,0.f,0.f,0.f,0.f,0.f,0.f,0.f};
#pragma unroll
    for (int s = 0; s < 4; ++s) acc = __builtin_amdgcn_mfma_f32_32x32x16_bf16(*(const LAS bf16x8*)(xp + 32 * s), *(const LAS bf16x8*)(yp + 32 * s), acc, 0, 0, 0);
    return acc;
}
__device__ __forceinline__ void st_tile_bf16(LAS unsigned char* M, int mi, int ni, int lane, const f32x16& v) {
    const int r32 = lane & 31, hi = lane >> 5; LAS bf16_t* p = (LAS bf16_t*)M + (32 * mi + 4 * hi) * CP + 32 * ni + r32;
#pragma unroll
    for (int r = 0; r < 16; ++r) p[((r & 3) + 8 * (r >> 2)) * CP] = (bf16_t)f2bf(v[r]);
}
struct ChunkRegs { u32x4 e, kh, r, kk, b, v; f32x4 tb[4]; };
template <bool DELTA> __device__ __forceinline__ void chunk_load(const Frame& F, const ChunkSrc& s, int b, int dir, int c, ChunkRegs& q) {
    const int t = F.tid >> 3, c0 = 8 * (F.tid & 7); const size_t row = (size_t)chunk_row(b, dir, c, t);
    q.v = *(const u32x4*)(s.V + row * s.ldv + c0);
    if (DELTA) { q.kh = *(const u32x4*)(s.KH + row * 256 + c0); q.r = *(const u32x4*)(s.R + row * 256 + c0);
        q.e = *(const u32x4*)(s.E + row * 256 + c0); q.kk = *(const u32x4*)(s.KK + row * 256 + c0); q.b = *(const u32x4*)(s.B + row * 256 + c0); }
    else { const int cp = c0 ^ 32;
        q.kh = *(const u32x4*)(s.KH + row * s.ldv + c0); q.kk = *(const u32x4*)(s.KH + row * s.ldv + cp);
        q.r = *(const u32x4*)(s.R + row * s.ldv + c0); q.e = *(const u32x4*)(s.R + row * s.ldv + cp);
        const int pos = row < (size_t)MLAT ? 256 + (int)(row & 8191) : (int)((row - MLAT) & 255);
        const f32x4* tp = (const f32x4*)(s.rtab + (size_t)pos * 64 + 2 * (c0 & 31));
#pragma unroll
        for (int i = 0; i < 4; ++i) q.tb[i] = tp[i]; }
}
template <bool DELTA, bool W3> __device__ __forceinline__ void chunk_prep(const Frame& F, const ChunkRegs& q, float econst) {
    LAS unsigned char* lds = F.lds; LAS float* LF = (LAS float*)(lds + CK_LF);
    const int tid = F.tid, t = tid >> 3, cg = tid & 7, c0 = 8 * cg;
    float e[8], L[8], L63[8];
    if (DELTA) {
        unpack8(q.e, e);
#pragma unroll
        for (int i = 0; i < 8; ++i) LF[t * 68 + c0 + i] = e[i];
        __syncthreads();
        { const int cc = tid & 63, sg = tid >> 6; float run = 0.f;
#pragma unroll
          for (int i = 0; i < 8; ++i) { run += LF[(8 * sg + i) * 68 + cc]; LF[(8 * sg + i) * 68 + cc] = run; } }
        __syncthreads();
#pragma unroll
        for (int i = 0; i < 8; ++i) { float pre = 0.f, tot = 0.f;
#pragma unroll
            for (int g = 0; g < 8; ++g) { const float seg = LF[(8 * g + 7) * 68 + c0 + i]; tot += seg; pre += (g < (t >> 3)) ? seg : 0.f; }
            L[i] = LF[t * 68 + c0 + i] + pre; L63[i] = tot; }
        __syncthreads();
    } else {
#pragma unroll
        for (int i = 0; i < 8; ++i) { e[i] = econst; L[i] = (float)(t + 1) * econst; L63[i] = 64.f * econst; }
    }
    if (t == 0) { LAS float* gc = (LAS float*)(lds + CK_GC);
#pragma unroll
        for (int i = 0; i < 8; ++i) gc[c0 + i] = __expf(-L63[i]); }
    float kk[8], bb[8], kh[8], rr[8];
    unpack8(q.kh, kh); unpack8(q.r, rr);
    if (DELTA) { unpack8(q.kk, kk); unpack8(q.b, bb); }
    else { float kp_[8], qp_[8]; unpack8(q.kk, kp_); unpack8(q.e, qp_);
        const bool first = c0 < 32;
#pragma unroll
        for (int i = 0; i < 8; ++i) { const float cs = q.tb[i >> 1][2 * (i & 1)], sn = q.tb[i >> 1][2 * (i & 1) + 1];
            kh[i] = 0.125f * (first ? kh[i] * cs - kp_[i] * sn : kh[i] * cs + kp_[i] * sn); rr[i] = first ? rr[i] * cs - qp_[i] * sn : rr[i] * cs + qp_[i] * sn; } }
    LAS bf16_t* VT = (LAS bf16_t*)(lds + CK_VT);
#pragma unroll
    for (int i = 0; i < 4; ++i) { VT[(c0 + 2 * i) * CP + t] = (bf16_t)(q.v[i] & 0xffffu); VT[(c0 + 2 * i + 1) * CP + t] = (bf16_t)(q.v[i] >> 16); }
    float al[8], be[8], ka[8], rh[8], bp[8], kp[8];
#pragma unroll
    for (int i = 0; i < 8; ++i) { const float up = __expf(L[i]), dn = __expf(-L[i]), tail = __expf(L[i] - L63[i]);
        ka[i] = kh[i] * up; rh[i] = rr[i] * dn; kp[i] = kh[i] * tail;
        if (DELTA) { al[i] = kk[i] * __expf(e[i] - L[i]); be[i] = bb[i] * up; bp[i] = bb[i] * tail; } }
    auto st8 = [&](int off, const float (&x)[8]) { u32x4 w; w.x = pk2(x[0], x[1]); w.y = pk2(x[2], x[3]); w.z = pk2(x[4], x[5]); w.w = pk2(x[6], x[7]); *(LAS u32x4*)(lds + off + (t * CP + c0) * 2) = w; };
    auto st8t = [&](int off, const float (&x)[8]) { LAS bf16_t* p = (LAS bf16_t*)(lds + off) + c0 * CP + t;
#pragma unroll
        for (int i = 0; i < 8; ++i) p[i * CP] = (bf16_t)f2bf(x[i]); };
    st8(CK_KA, ka);
    if (W3) st8(CK_RH, rh); else st8t(CK_KPT, kp);
    if (DELTA) { st8(CK_AL, al); st8t(CK_ALT, al); st8(CK_BE, be); if (!W3) st8t(CK_BPT, bp); }
    __syncthreads();
}
__device__ __forceinline__ void chunk_AbT(const Frame& F, int mi, int ni) {
    const int lane = F.lane, r32 = lane & 31, hi = lane >> 5;
    const f32x16 a = nt_tile(F.lds + CK_BE, F.lds + CK_AL, mi, ni, lane);
    LAS float* A = (LAS float*)(F.lds + CK_LF) + (32 * mi + 4 * hi) * 68 + 32 * ni + r32; const int t = 32 * ni + r32;
#pragma unroll
    for (int r = 0; r < 16; ++r) { const int io = (r & 3) + 8 * (r >> 2); A[io * 68] = (32 * mi + 4 * hi + io < t) ? a[r] : 0.f; }
}
__device__ __forceinline__ void chunk_Ak(const Frame& F, int mi, int ni) {
    const int lane = F.lane, r32 = lane & 31, hi = lane >> 5;
    f32x16 a = nt_tile(F.lds + CK_KA, F.lds + CK_AL, mi, ni, lane);
#pragma unroll
    for (int r = 0; r < 16; ++r) if (!(32 * mi + crow(r, hi) < 32 * ni + r32)) a[r] = 0.f;
    st_tile_bf16(F.lds + CK_AK, mi, ni, lane, a);
}
__device__ __forceinline__ void chunk_BT(const Frame& F, int xoff, int moff, int mi, int ni) {
    const int lane = F.lane, r32 = lane & 31, hi = lane >> 5;
    f32x16 a = nt_tile(F.lds + CK_RH, F.lds + xoff, mi, ni, lane);
#pragma unroll
    for (int r = 0; r < 16; ++r) if (!(32 * ni + r32 <= 32 * mi + crow(r, hi))) a[r] = 0.f;
    st_tile_bf16(F.lds + moff, mi, ni, lane, a);
}
__device__ __forceinline__ void chunk_solve(const Frame& F) {
    const LAS float* A = (const LAS float*)(F.lds + CK_LF);
    LAS float* Tf = (LAS float*)(F.lds + CK_BE);
    const int lane = F.lane, w = F.wave, i16 = lane & 15, q4 = lane >> 4;
    if (w < 4) { const int B = w;
        float acc[16];
#pragma unroll
        for (int k = 0; k < 16; ++k) acc[k] = (i16 == k) ? 1.f : 0.f;
#pragma unroll
        for (int jj = 0; jj < 15; ++jj) { const LAS f32x4* ar = (const LAS f32x4*)(A + (16 * B + jj) * 68 + 16 * B);
#pragma unroll
            for (int q = 0; q < 4; ++q) { if (4 * q + 3 > jj) { const f32x4 a4 = ar[q];
#pragma unroll
                for (int k = 0; k < 4; ++k) if (4 * q + k > jj) acc[4 * q + k] -= acc[jj] * a4[k]; } } }
        if (lane < 16) {
#pragma unroll
            for (int q = 0; q < 4; ++q) *(LAS f32x4*)(Tf + (16 * B + i16) * 68 + 16 * B + 4 * q) = (f32x4){acc[4 * q], acc[4 * q + 1], acc[4 * q + 2], acc[4 * q + 3]}; }
    }
    __syncthreads();
    if (w < 3) { const int I = w;
#pragma unroll 1
        for (int B = I + 1; B < 4; ++B) {
            f32x4 x = {0.f, 0.f, 0.f, 0.f};
#pragma unroll 1
            for (int K = I; K < B; ++K) {
#pragma unroll
                for (int s = 0; s < 4; ++s) x = __builtin_amdgcn_mfma_f32_16x16x4f32(Tf[(16 * I + i16) * 68 + 16 * K + 4 * s + q4], A[(16 * K + 4 * s + q4) * 68 + 16 * B + i16], x, 0, 0, 0); }
            LAS float* tb = Tf + (16 * I + 4 * q4) * 68 + 16 * B + i16;
#pragma unroll
            for (int r = 0; r < 4; ++r) tb[r * 68] = x[r];
            f32x4 y = {0.f, 0.f, 0.f, 0.f};
#pragma unroll
            for (int s = 0; s < 4; ++s) y = __builtin_amdgcn_mfma_f32_16x16x4f32(Tf[(16 * I + i16) * 68 + 16 * B + 4 * s + q4], Tf[(16 * B + 4 * s + q4) * 68 + 16 * B + i16], y, 0, 0, 0);
#pragma unroll
            for (int r = 0; r < 4; ++r) tb[r * 68] = -y[r];
        }
    }
    __syncthreads();
    { const int row = F.tid >> 3, c8 = F.tid & 7; const LAS float* s = Tf + row * 68 + 8 * c8; const f32x4 v0 = *(const LAS f32x4*)s, v1 = *(const LAS f32x4*)(s + 4);
      const bool z = (c8 >> 1) < (row >> 4);
      u32x4 o; o.x = z ? 0u : pk2(v0[0], v0[1]); o.y = z ? 0u : pk2(v0[2], v0[3]); o.z = z ? 0u : pk2(v1[0], v1[1]); o.w = z ? 0u : pk2(v1[2], v1[3]);
      *(LAS u32x4*)((LAS bf16_t*)(F.lds + CK_TT) + row * CP + 8 * c8) = o; }
}
constexpr int TS1_ITEMS = (int)(((size_t)MALL * 384 * 2) / 8192);
__device__ __forceinline__ bf16_t* tstash(unsigned char* ws, int item) { return item < TS1_ITEMS ? (bf16_t*)(ws + T_CQN) + (size_t)item * 4096 : (bf16_t*)(ws + T_PZ + PZ_BYTES) + (size_t)(item - TS1_ITEMS) * 4096; }
static_assert(T_PZ + PZ_BYTES + (size_t)(32 * NCHUNK - TS1_ITEMS) * 8192 <= T_YB, "T stash map");
#define RWKV_SRC(I, dir, hd) ChunkSrc{((dir) ? (I).EB : (I).EF) + (hd) * 64, (I).KK + (hd) * 64, ((dir) ? (I).BB : (I).BF) + (hd) * 64, ((dir) ? (I).KB : (I).KF) + (hd) * 64, (I).R + (hd) * 64, (I).V + (hd) * 64, 256, 0.f, nullptr}
__device__ __forceinline__ void ph_rwkv_w1(const Frame& F, const RwkvF& I, bf16_t* PZ, unsigned char* ws) {
    const int lane = F.lane, w = F.wave, r32 = lane & 31, hi = lane >> 5, mi = (w >> 1) & 1, ni = w & 1;
    ChunkRegs q;
    if (F.bid < 32 * NCHUNK) { const int task = F.bid / NCHUNK, c = F.bid % NCHUNK; chunk_load<true>(F, RWKV_SRC(I, task & 1, (task >> 1) & 3), task >> 3, task & 1, c, q); }
    for (int item = F.bid; item < 32 * NCHUNK; item += F.G) {
        const int c = item % NCHUNK;
        chunk_prep<true, false>(F, q, 0.f);
        { const int nx = item + F.G; if (nx < 32 * NCHUNK) { const int task = nx / NCHUNK, cn = nx % NCHUNK; chunk_load<true>(F, RWKV_SRC(I, task & 1, (task >> 1) & 3), task >> 3, task & 1, cn, q); } }
        (void)c;
        if (w < 4) chunk_AbT(F, mi, ni); else chunk_Ak(F, mi, ni);
        __syncthreads();
        chunk_solve(F);
        __syncthreads();
        { const int rr_ = F.tid >> 3, c8 = F.tid & 7; *(u32x4*)(tstash(ws, item) + rr_ * 64 + 8 * c8) = *(const LAS u32x4*)(F.lds + CK_TT + (rr_ * CP + 8 * c8) * 2); }
        if (w < 4) { const f32x16 g = nt_tile(F.lds + CK_BPT, F.lds + CK_TT, mi, ni, lane); st_tile_bf16(F.lds + CK_M1, mi, ni, lane, g); }
        __syncthreads();
        if (w < 4) { f32x16 p = nt_tile(F.lds + CK_M1, F.lds + CK_ALT, mi, ni, lane);
            const float gc = ((const LAS float*)(F.lds + CK_GC))[32 * ni + r32];
#pragma unroll
            for (int r = 0; r < 16; ++r) p[r] = ((32 * mi + crow(r, hi) == 32 * ni + r32) ? gc : 0.f) - p[r];
            st_tile_bf16(F.lds + CK_BE, mi, ni, lane, p); }
        else { f32x16 qq = nt_tile(F.lds + CK_M1, F.lds + CK_AK, mi, ni, lane);
            const LAS bf16_t* kp = (const LAS bf16_t*)(F.lds + CK_KPT) + (32 * mi + 4 * hi) * CP + 32 * ni + r32;
#pragma unroll
            for (int r = 0; r < 16; ++r) qq[r] = bf2f(kp[((r & 3) + 8 * (r >> 2)) * CP]) - qq[r];
            st_tile_bf16(F.lds + CK_M2, mi, ni, lane, qq); }
        __syncthreads();
        bf16_t* pz = PZ + (size_t)item * 8192;
        if (w < 4) { const f32x16 z = nt_tile(F.lds + CK_M2, F.lds + CK_VT, mi, ni, lane);
            u32x4 o0, o1;
#pragma unroll
            for (int e = 0; e < 4; ++e) { o0[e] = pg8::cvt_pk_bf16(z[2 * e], z[2 * e + 1]); o1[e] = pg8::cvt_pk_bf16(z[8 + 2 * e], z[8 + 2 * e + 1]); }
            u32x4* zo = (u32x4*)(pz + 4096 + ((ni * 2 + mi) * 64 + lane) * 16); zo[0] = o0; zo[1] = o1; }
        else {
#pragma unroll
            for (int qf = 0; qf < 2; ++qf) { const int f = (w - 4) * 2 + qf, co = f >> 2, sidx = f & 3;
                const LAS unsigned char* rp = F.lds + CK_BE + ((32 * co + r32) * CP + 16 * sidx + 4 * hi) * 2;
                const u32x2 lo = *(const LAS u32x2*)rp, hh = *(const LAS u32x2*)(rp + 16);
                *(u32x4*)(pz + (f * 64 + lane) * 8) = (u32x4){lo.x, lo.y, hh.x, hh.y}; } }
        __syncthreads();
    }
}
__device__ __forceinline__ void ph_rwkv_w2(const Frame& F, bf16_t* PZ) {
    if (F.bid >= 64 || F.wave != 0) return;
    const int lane = F.lane, r32 = lane & 31, hi = lane >> 5, task = F.bid >> 1, vi = F.bid & 1;
    const f32x16 z16 = {0.f,0.f,0.f,0.f,0.f,0.f,0.f,0.f,0.f,0.f,0.f,0.f,0.f,0.f,0.f,0.f};
    (void)z16;
    bf16_t* pz = PZ + (size_t)task * NCHUNK * 8192;
    LAS unsigned char* ring = F.lds;
    constexpr int SLOT = 12288, NB = NCHUNK / 4;
#define W2_ISSUE(cc, slot) do { const bf16_t* p_ = pz + (size_t)(cc) * 8192; LAS unsigned char* d_ = ring + (slot) * SLOT; \
        _Pragma("unroll") for (int f_ = 0; f_ < 8; ++f_) __builtin_amdgcn_global_load_lds((const unsigned*)(p_ + (f_ * 64 + lane) * 8), (LAS unsigned*)(d_ + f_ * 1024), 16, 0, 0); \
        _Pragma("unroll") for (int q_ = 0; q_ < 4; ++q_) __builtin_amdgcn_global_load_lds((const unsigned*)(p_ + 4096 + ((vi * 2 + (q_ >> 1)) * 64 + lane) * 16 + 8 * (q_ & 1)), (LAS unsigned*)(d_ + 8192 + q_ * 1024), 16, 0, 0); } while (0)
#pragma unroll
    for (int k = 0; k < 4; ++k) W2_ISSUE(k, k);
    bf16x8 xh[4], xl[4];
    { const bf16x8 zf = {0, 0, 0, 0, 0, 0, 0, 0};
#pragma unroll
      for (int s = 0; s < 4; ++s) { xh[s] = zf; xl[s] = zf; } }
#pragma unroll 1
    for (int bt = 0; bt < NB; ++bt) {
        asm volatile("s_waitcnt vmcnt(0)" ::: "memory");
        if (bt + 1 < NB) {
#pragma unroll
            for (int k = 0; k < 4; ++k) W2_ISSUE(4 * (bt + 1) + k, ((bt + 1) & 1) * 4 + k); }
#pragma unroll
        for (int k = 0; k < 4; ++k) {
            const int c = 4 * bt + k; const LAS unsigned char* sl = ring + ((bt & 1) * 4 + k) * SLOT + lane * 16;
            bf16x8 nh[4], nl[4];
            { bf16_t* so = pz + (size_t)c * 8192 + 4096 + (size_t)(32 * vi + r32) * 64;
#pragma unroll
              for (int s = 0; s < 4; ++s) { const u32x4 wh = __builtin_bit_cast(u32x4, xh[s]);
                  *(u32x2*)(so + 32 * (s >> 1) + 4 * hi + 16 * (s & 1)) = (u32x2){wh[0], wh[1]}; *(u32x2*)(so + 32 * (s >> 1) + 4 * hi + 16 * (s & 1) + 8) = (u32x2){wh[2], wh[3]}; } }
#pragma unroll
            for (int co = 0; co < 2; ++co) { const u32x4 z0 = *(const LAS u32x4*)(sl + 8192 + (co * 2) * 1024), z1 = *(const LAS u32x4*)(sl + 8192 + (co * 2 + 1) * 1024); f32x16 acc;
#pragma unroll
                for (int e = 0; e < 4; ++e) { acc[2 * e] = __uint_as_float(z0[e] << 16); acc[2 * e + 1] = __uint_as_float(z0[e] & 0xffff0000u);
                                              acc[8 + 2 * e] = __uint_as_float(z1[e] << 16); acc[8 + 2 * e + 1] = __uint_as_float(z1[e] & 0xffff0000u); }
#pragma unroll
                for (int s = 0; s < 4; ++s) { const bf16x8 pf = *(const LAS bf16x8*)(sl + (co * 4 + s) * 1024);
                    acc = __builtin_amdgcn_mfma_f32_32x32x16_bf16(pf, xh[s], acc, 0, 0, 0); acc = __builtin_amdgcn_mfma_f32_32x32x16_bf16(pf, xl[s], acc, 0, 0, 0); }
#pragma unroll
                for (int q = 0; q < 2; ++q) { u32x4 wh, wl;
#pragma unroll
                    for (int e = 0; e < 4; ++e) { const float a0 = acc[8 * q + 2 * e], a1 = acc[8 * q + 2 * e + 1];
                        const unsigned ph = pg8::cvt_pk_bf16(a0, a1); wh[e] = ph;
                        wl[e] = pg8::cvt_pk_bf16(a0 - __uint_as_float(ph << 16), a1 - __uint_as_float(ph & 0xffff0000u)); }
                    nh[2 * co + q] = __builtin_bit_cast(bf16x8, wh); nl[2 * co + q] = __builtin_bit_cast(bf16x8, wl); }
            }
#pragma unroll
            for (int s = 0; s < 4; ++s) { xh[s] = nh[s]; xl[s] = nl[s]; }
        }
    }
#undef W2_ISSUE
}
template <bool DELTA> __device__ __forceinline__ void chunk_out(const Frame& F, const ChunkRegs& q, float econst, const bf16_t* S0  , const bf16_t* Tst  , int b, int dir, int c, bf16_t* Yout) {
    const int lane = F.lane, w = F.wave, r32 = lane & 31, hi = lane >> 5, mi = (w >> 1) & 1, ni = w & 1;
    u32x4 s0r, ttr = {0u, 0u, 0u, 0u};
    { const int v = F.tid >> 3, c8 = F.tid & 7; s0r = *(const u32x4*)(S0 + v * 64 + 8 * c8); if (DELTA) ttr = *(const u32x4*)(Tst + v * 64 + 8 * c8); }
    chunk_prep<DELTA, true>(F, q, econst);
    { const int v = F.tid >> 3, c8 = F.tid & 7; *(LAS u32x4*)(F.lds + CK_BPT + (v * CP + 8 * c8) * 2) = s0r;
      if (DELTA) *(LAS u32x4*)(F.lds + CK_TT + (v * CP + 8 * c8) * 2) = ttr; }
    if (DELTA) {
        if (w < 4) chunk_BT(F, CK_BE, CK_M1, mi, ni); else { chunk_Ak(F, mi, ni); chunk_BT(F, CK_KA, CK_M2, mi, ni); }
        __syncthreads();
        if (w < 4) { const f32x16 h = nt_tile(F.lds + CK_M1, F.lds + CK_TT, mi, ni, lane); st_tile_bf16(F.lds + CK_BE, mi, ni, lane, h); }
        __syncthreads();
        if (w < 4) { f32x16 qe = nt_tile(F.lds + CK_BE, F.lds + CK_ALT, mi, ni, lane);
            const LAS bf16_t* rp = (const LAS bf16_t*)(F.lds + CK_RH) + (32 * mi + 4 * hi) * CP + 32 * ni + r32;
#pragma unroll
            for (int r = 0; r < 16; ++r) qe[r] = bf2f(rp[((r & 3) + 8 * (r >> 2)) * CP]) - qe[r];
            st_tile_bf16(F.lds + CK_KA, mi, ni, lane, qe); }
        else { f32x16 n = nt_tile(F.lds + CK_BE, F.lds + CK_AK, mi, ni, lane);
            LAS bf16_t* mp = (LAS bf16_t*)(F.lds + CK_M2) + (32 * mi + 4 * hi) * CP + 32 * ni + r32;
#pragma unroll
            for (int r = 0; r < 16; ++r) { const int o = ((r & 3) + 8 * (r >> 2)) * CP; mp[o] = (bf16_t)f2bf(bf2f(mp[o]) - n[r]); } }
        __syncthreads();
    } else {
        if (w < 4) chunk_BT(F, CK_KA, CK_M2, mi, ni);
        __syncthreads();
    }
    if (w < 4) { const f32x16 y0 = nt_tile(F.lds + (DELTA ? CK_KA : CK_RH), F.lds + CK_BPT, mi, ni, lane), y1 = nt_tile(F.lds + CK_M2, F.lds + CK_VT, mi, ni, lane);
#pragma unroll
        for (int r = 0; r < 16; ++r) { const int t = 32 * mi + crow(r, hi); Yout[(size_t)chunk_row(b, dir, c, t) * 256 + 32 * ni + r32] = (bf16_t)f2bf(y0[r] + y1[r]); } }
    __syncthreads();
}
__device__ __forceinline__ void ph_rwkv_w3(const Frame& F, const RwkvF& I, const bf16_t* PZ, bf16_t* RWY, unsigned char* ws) {
    ChunkRegs q;
    if (F.bid < 32 * NCHUNK) { const int task = F.bid / NCHUNK, c = F.bid % NCHUNK; chunk_load<true>(F, RWKV_SRC(I, task & 1, (task >> 1) & 3), task >> 3, task & 1, c, q); }
    for (int item = F.bid; item < 32 * NCHUNK; item += F.G) {
        const int task = item / NCHUNK, c = item % NCHUNK, dir = task & 1, hd = (task >> 1) & 3, b = task >> 3;
        const ChunkRegs cur = q;
        { const int nx = item + F.G; if (nx < 32 * NCHUNK) { const int tk = nx / NCHUNK, cn = nx % NCHUNK; chunk_load<true>(F, RWKV_SRC(I, tk & 1, (tk >> 1) & 3), tk >> 3, tk & 1, cn, q); } }
        chunk_out<true>(F, cur, 0.f, PZ + (size_t)item * 8192 + 4096, tstash(ws, item), b, dir, c, RWY + (size_t)dir * MALL * 256 + hd * 64);
    }
}
__device__ __forceinline__ float ret_egamma(int hd, int dir) { return -logf(1.f - expf(-3.4657359027997265f + (-6.238324625039508f + 3.4657359027997265f) * (float)(2 * hd + dir) / 7.f)); }
#define RET_SRC(hd, dir) ChunkSrc{nullptr, nullptr, nullptr, P + 768 + (hd) * 64, P + 512 + (hd) * 64, P + 1024 + (hd) * 64, NINP, ret_egamma(hd, dir), RTAB}
__device__ __forceinline__ void ph_ret_r1(const Frame& F, const bf16_t* P, const float* RTAB, bf16_t* RZ) {
    const int lane = F.lane, w = F.wave, r32 = lane & 31, hi = lane >> 5, mi = (w >> 1) & 1, ni = w & 1;
    ChunkRegs q;
    if (F.bid < 32 * NCHUNK) { const int task = F.bid / NCHUNK; chunk_load<false>(F, RET_SRC((task >> 1) & 3, task & 1), task >> 3, task & 1, F.bid % NCHUNK, q); }
    for (int item = F.bid; item < 32 * NCHUNK; item += F.G) {
        const int task = item / NCHUNK, dir = task & 1, hd = (task >> 1) & 3;
        chunk_prep<false, false>(F, q, ret_egamma(hd, dir));
        { const int nx = item + F.G; if (nx < 32 * NCHUNK) { const int tk = nx / NCHUNK; chunk_load<false>(F, RET_SRC((tk >> 1) & 3, tk & 1), tk >> 3, tk & 1, nx % NCHUNK, q); } }
        if (w < 4) { const f32x16 z = nt_tile(F.lds + CK_KPT, F.lds + CK_VT, mi, ni, lane);
            bf16_t* zo = RZ + (size_t)item * 4096 + (size_t)(32 * ni + r32) * 64 + 32 * mi + 4 * hi;
#pragma unroll
            for (int g = 0; g < 4; ++g) *(u32x2*)(zo + 8 * g) = (u32x2){pg8::cvt_pk_bf16(z[4 * g], z[4 * g + 1]), pg8::cvt_pk_bf16(z[4 * g + 2], z[4 * g + 3])}; }
        __syncthreads();
    }
}
__device__ __forceinline__ void ph_ret_r2(const Frame& F, bf16_t* RZ) {
    for (int el = F.bid * NTHR + F.tid; el < 32 * 4096; el += F.G * NTHR) {
        const int task = el >> 12, idx = el & 4095, dir = task & 1, hd = (task >> 1) & 3;
        const float g64 = __expf(-64.f * ret_egamma(hd, dir));
        bf16_t* z = RZ + (size_t)task * NCHUNK * 4096 + idx; float S = 0.f;
#pragma unroll 1
        for (int c0 = 0; c0 < NCHUNK; c0 += 12) {
            float zc[12];
#pragma unroll
            for (int j = 0; j < 12; ++j) zc[j] = bf2f(z[(size_t)(c0 + j) * 4096]);
#pragma unroll
            for (int j = 0; j < 12; ++j) { z[(size_t)(c0 + j) * 4096] = (bf16_t)f2bf(S); S = S * g64 + zc[j]; } }
    }
}
__device__ __forceinline__ void ph_ret_r3(const Frame& F, const bf16_t* P, const float* RTAB, const bf16_t* RZ, bf16_t* RETY) {
    ChunkRegs q;
    if (F.bid < 32 * NCHUNK) { const int task = F.bid / NCHUNK; chunk_load<false>(F, RET_SRC((task >> 1) & 3, task & 1), task >> 3, task & 1, F.bid % NCHUNK, q); }
    for (int item = F.bid; item < 32 * NCHUNK; item += F.G) {
        const int task = item / NCHUNK, c = item % NCHUNK, dir = task & 1, hd = (task >> 1) & 3, b = task >> 3;
        const ChunkRegs cur = q;
        { const int nx = item + F.G; if (nx < 32 * NCHUNK) { const int tk = nx / NCHUNK; chunk_load<false>(F, RET_SRC((tk >> 1) & 3, tk & 1), tk >> 3, tk & 1, nx % NCHUNK, q); } }
        chunk_out<false>(F, cur, ret_egamma(hd, dir), RZ + (size_t)item * 4096, nullptr, b, dir, c, RETY + (size_t)dir * MALL * 256 + hd * 64);
    }
}

template <int DQK, bool MASKED, class TileFn>
__device__ __forceinline__ void attn_unit(const Frame& F, const bf16_t* qrow, int qpos, bool has_sink, float sink_l2, int ntiles, const TileFn& tf,
                                          int kstride, int vstride, bf16_t* obase, int ostride) {
    constexpr int NS = DQK / 16, KP = DQK + 8, KBUF = 64 * KP * 2, VP = 72, VBUF = 64 * VP * 2, BUF = KBUF + VBUF, CPR = DQK / 8;
    const int tid = F.tid, lane = F.lane, r32 = lane & 31, hi = lane >> 5, wave = F.wave;
    LAS unsigned char* lds = F.lds;
    LAS float* wsf = (LAS float*)(lds + 2 * BUF) + wave * 32;
    bf16x8 qf[NS];
#pragma unroll
    for (int s = 0; s < NS; ++s) qf[s] = *(const bf16x8*)(qrow + 16 * s + 8 * hi);
    u32x4 gk0, gk1 = {0u, 0u, 0u, 0u}, gv;
    const int kr0 = tid / CPR, kc0 = tid % CPR, kr1 = (tid + 512) / CPR, kc1 = (tid + 512) % CPR;
    const bool two = (DQK == 96) && tid < 256;
#define AT_GLOAD(j) do { const bf16_t *Kp_, *Vp_; int kp_; tf(j, Kp_, Vp_, kp_); gk0 = *(const u32x4*)(Kp_ + (size_t)kr0 * kstride + kc0 * 8); \
        if (two) gk1 = *(const u32x4*)(Kp_ + (size_t)kr1 * kstride + kc1 * 8); gv = *(const u32x4*)(Vp_ + (size_t)lane * vstride + wave * 8); } while (0)
#define AT_LSTORE(b) do { LAS unsigned char* kb_ = lds + (b) * BUF; *(LAS u32x4*)(kb_ + (kr0 * KP + kc0 * 8) * 2) = gk0; if (two) *(LAS u32x4*)(kb_ + (kr1 * KP + kc1 * 8) * 2) = gk1; \
        LAS bf16_t* vt_ = (LAS bf16_t*)(kb_ + KBUF) + (wave * 8) * VP + lane; \
        _Pragma("unroll") for (int e_ = 0; e_ < 4; ++e_) { vt_[(2 * e_) * VP] = (bf16_t)(gv[e_] & 0xffffu); vt_[(2 * e_ + 1) * VP] = (bf16_t)(gv[e_] >> 16); } } while (0)
    float m = has_sink ? sink_l2 : -1e30f, lsum = 0.f;
    f32x16 O0 = {0.f,0.f,0.f,0.f,0.f,0.f,0.f,0.f,0.f,0.f,0.f,0.f,0.f,0.f,0.f,0.f}, O1 = O0;
    AT_GLOAD(0); AT_LSTORE(0);
    __syncthreads();
#pragma unroll 1
    for (int j = 0; j < ntiles; ++j) {
        const int b = j & 1;
        if (j + 1 < ntiles) AT_GLOAD(j + 1);
        const LAS unsigned char* kb = lds + b * BUF + (r32 * KP + 8 * hi) * 2;
        f32x16 p0 = {0.f,0.f,0.f,0.f,0.f,0.f,0.f,0.f,0.f,0.f,0.f,0.f,0.f,0.f,0.f,0.f}, p1 = p0;
#pragma unroll
        for (int s = 0; s < NS; ++s) { const bf16x8 a0 = *(const LAS bf16x8*)(kb + 32 * s), a1 = *(const LAS bf16x8*)(kb + 32 * KP * 2 + 32 * s);
            p0 = __builtin_amdgcn_mfma_f32_32x32x16_bf16(a0, qf[s], p0, 0, 0, 0); p1 = __builtin_amdgcn_mfma_f32_32x32x16_bf16(a1, qf[s], p1, 0, 0, 0); }
        if (MASKED) { const bf16_t *Kp_, *Vp_; int kp0; tf(j, Kp_, Vp_, kp0);
            if (kp0 >= 0) {
#pragma unroll
                for (int r = 0; r < 16; ++r) { const int dk = kp0 + crow(r, hi) - qpos; if (dk > 128 || dk < -128) p0[r] = -1e30f; if (dk + 32 > 128 || dk + 32 < -128) p1[r] = -1e30f; } } }
        float mx = fmaxf(p0[0], p1[0]);
#pragma unroll
        for (int r = 1; r < 16; ++r) mx = fmaxf(mx, fmaxf(p0[r], p1[r]));
        mx = fmaxf(mx, __shfl_xor(mx, 32));
        const float mnew = fmaxf(m, mx), alpha = __builtin_amdgcn_exp2f(m - mnew); m = mnew;
        float ps = 0.f;
#pragma unroll
        for (int r = 0; r < 16; ++r) { p0[r] = __builtin_amdgcn_exp2f(p0[r] - mnew); p1[r] = __builtin_amdgcn_exp2f(p1[r] - mnew); ps += p0[r] + p1[r]; }
        lsum = lsum * alpha + ps;
        if (__any(alpha != 1.f)) {
            if (hi == 0) wsf[r32] = alpha;
#pragma unroll
            for (int g = 0; g < 4; ++g) { const f32x4 a4 = *(const LAS f32x4*)(wsf + 8 * g + 4 * hi);
#pragma unroll
                for (int i = 0; i < 4; ++i) { O0[4 * g + i] *= a4[i]; O1[4 * g + i] *= a4[i]; } } }
        bf16x8 pa[4];
#pragma unroll
        for (int s = 0; s < 4; ++s) { u32x4 w;
#pragma unroll
            for (int e = 0; e < 4; ++e) { const float lo = (s < 2) ? p0[8 * (s & 1) + 2 * e] : p1[8 * (s & 1) + 2 * e], hh = (s < 2) ? p0[8 * (s & 1) + 2 * e + 1] : p1[8 * (s & 1) + 2 * e + 1]; w[e] = pg8::cvt_pk_bf16(lo, hh); }
            pa[s] = __builtin_bit_cast(bf16x8, w); }
        const LAS unsigned char* vb = lds + b * BUF + KBUF + (r32 * VP + 4 * hi) * 2;
#pragma unroll
        for (int s = 0; s < 4; ++s) {
#pragma unroll
            for (int db = 0; db < 2; ++db) { const u32x2 v0 = *(const LAS u32x2*)(vb + (db * 32 * VP + 16 * s) * 2), v1 = *(const LAS u32x2*)(vb + (db * 32 * VP + 16 * s + 8) * 2);
                const u32x4 vv = {v0.x, v0.y, v1.x, v1.y}; const bf16x8 vf = __builtin_bit_cast(bf16x8, vv);
                if (db == 0) O0 = __builtin_amdgcn_mfma_f32_32x32x16_bf16(pa[s], vf, O0, 0, 0, 0); else O1 = __builtin_amdgcn_mfma_f32_32x32x16_bf16(pa[s], vf, O1, 0, 0, 0); } }
        if (j + 1 < ntiles) AT_LSTORE(b ^ 1);
        __syncthreads();
    }
    float ltot = lsum + __shfl_xor(lsum, 32);
    if (has_sink) ltot += __builtin_amdgcn_exp2f(sink_l2 - m);
    if (hi == 0) wsf[r32] = 1.f / ltot;
#pragma unroll
    for (int g = 0; g < 4; ++g) { const f32x4 a4 = *(const LAS f32x4*)(wsf + 8 * g + 4 * hi);
#pragma unroll
        for (int i = 0; i < 4; ++i) { bf16_t* op = obase + (size_t)(i + 8 * g + 4 * hi) * ostride + r32;
            op[0] = (bf16_t)f2bf(O0[4 * g + i] * a4[i]); op[32] = (bf16_t)f2bf(O1[4 * g + i] * a4[i]); } }
    __syncthreads();
#undef AT_GLOAD
#undef AT_LSTORE
}


template <int DQK, class TileFn>
__device__ __forceinline__ void attn_unit2(const Frame& F, const bf16_t* qrow, int ntiles, const TileFn& tf, int kstride, int vstride, bf16_t* obase, int ostride) {
    constexpr int NS = DQK / 16, KP = DQK + 8, KBUF = 128 * KP * 2, VP = 136, VBUF = 64 * VP * 2, BUF = KBUF + VBUF, CPR = DQK / 8, NKC = (128 * CPR) / 512;
    static_assert((128 * CPR) % 512 == 0 && 2 * BUF + 1024 <= RING_BYTES, "attn2 geometry");
    const int tid = F.tid, lane = F.lane, r32 = lane & 31, hi = lane >> 5, wave = F.wave;
    LAS unsigned char* lds = F.lds;
    LAS float* wsf = (LAS float*)(lds + 2 * BUF) + wave * 32;
    bf16x8 qf[NS];
#pragma unroll
    for (int s = 0; s < NS; ++s) qf[s] = *(const bf16x8*)(qrow + 16 * s + 8 * hi);
    u32x4 gk[NKC], gv[2];
#define A2_GLOAD(j) do { const bf16_t *Kp_, *Vp_; tf(j, Kp_, Vp_); _Pragma("unroll") for (int i_ = 0; i_ < NKC; ++i_) { const int ch_ = tid + 512 * i_; gk[i_] = *(const u32x4*)(Kp_ + (size_t)(ch_ / CPR) * kstride + (ch_ % CPR) * 8); } \
        gv[0] = *(const u32x4*)(Vp_ + (size_t)lane * vstride + wave * 8); gv[1] = *(const u32x4*)(Vp_ + (size_t)(lane + 64) * vstride + wave * 8); } while (0)
#define A2_LSTORE(b) do { LAS unsigned char* kb_ = lds + (b) * BUF; _Pragma("unroll") for (int i_ = 0; i_ < NKC; ++i_) { const int ch_ = tid + 512 * i_; *(LAS u32x4*)(kb_ + ((ch_ / CPR) * KP + (ch_ % CPR) * 8) * 2) = gk[i_]; } \
        LAS bf16_t* vt_ = (LAS bf16_t*)(kb_ + KBUF) + (wave * 8) * VP + lane; \
        _Pragma("unroll") for (int h_ = 0; h_ < 2; ++h_) _Pragma("unroll") for (int e_ = 0; e_ < 4; ++e_) { vt_[(2 * e_) * VP + 64 * h_] = (bf16_t)(gv[h_][e_] & 0xffffu); vt_[(2 * e_ + 1) * VP + 64 * h_] = (bf16_t)(gv[h_][e_] >> 16); } } while (0)
    float m = -1e30f, lsum = 0.f;
    const f32x16 z16 = {0.f,0.f,0.f,0.f,0.f,0.f,0.f,0.f,0.f,0.f,0.f,0.f,0.f,0.f,0.f,0.f};
    f32x16 O0 = z16, O1 = z16;
    A2_GLOAD(0); A2_LSTORE(0);
    __syncthreads();
#pragma unroll 1
    for (int j = 0; j < ntiles; ++j) {
        const int b = j & 1;
        if (j + 1 < ntiles) A2_GLOAD(j + 1);
        const LAS unsigned char* kb = lds + b * BUF + (r32 * KP + 8 * hi) * 2;
        f32x16 p[4] = {z16, z16, z16, z16};
#pragma unroll
        for (int s = 0; s < NS; ++s)
#pragma unroll
            for (int h4 = 0; h4 < 4; ++h4) p[h4] = __builtin_amdgcn_mfma_f32_32x32x16_bf16(*(const LAS bf16x8*)(kb + h4 * 32 * KP * 2 + 32 * s), qf[s], p[h4], 0, 0, 0);
        float mx;
        { float t[16];
#pragma unroll
          for (int r = 0; r < 16; ++r) t[r] = fmaxf(fmaxf(p[0][r], p[1][r]), fmaxf(p[2][r], p[3][r]));
#pragma unroll
          for (int r = 0; r < 8; ++r) t[r] = fmaxf(t[r], t[r + 8]);
#pragma unroll
          for (int r = 0; r < 4; ++r) t[r] = fmaxf(t[r], t[r + 4]);
          mx = fmaxf(fmaxf(t[0], t[1]), fmaxf(t[2], t[3])); }
        mx = fmaxf(mx, __shfl_xor(mx, 32));
        const float mnew = fmaxf(m, mx), alpha = __builtin_amdgcn_exp2f(m - mnew); m = mnew;
        float ps;
        { float q4[16];
#pragma unroll
          for (int h4 = 0; h4 < 4; ++h4)
#pragma unroll
              for (int r = 0; r < 16; ++r) p[h4][r] = __builtin_amdgcn_exp2f(p[h4][r] - mnew);
#pragma unroll
          for (int r = 0; r < 16; ++r) q4[r] = (p[0][r] + p[1][r]) + (p[2][r] + p[3][r]);
#pragma unroll
          for (int r = 0; r < 8; ++r) q4[r] += q4[r + 8];
#pragma unroll
          for (int r = 0; r < 4; ++r) q4[r] += q4[r + 4];
          ps = (q4[0] + q4[1]) + (q4[2] + q4[3]); }
        lsum = lsum * alpha + ps;
        if (__any(alpha != 1.f)) {
            if (hi == 0) wsf[r32] = alpha;
#pragma unroll
            for (int g = 0; g < 4; ++g) { const f32x4 a4 = *(const LAS f32x4*)(wsf + 8 * g + 4 * hi);
#pragma unroll
                for (int i = 0; i < 4; ++i) { O0[4 * g + i] *= a4[i]; O1[4 * g + i] *= a4[i]; } } }
        const LAS unsigned char* vb = lds + b * BUF + KBUF + (r32 * VP + 4 * hi) * 2;
#pragma unroll
        for (int s = 0; s < 8; ++s) { u32x4 w;
#pragma unroll
            for (int e = 0; e < 4; ++e) w[e] = pg8::cvt_pk_bf16(p[s >> 1][8 * (s & 1) + 2 * e], p[s >> 1][8 * (s & 1) + 2 * e + 1]);
            const bf16x8 pa = __builtin_bit_cast(bf16x8, w);
#pragma unroll
            for (int db = 0; db < 2; ++db) { const u32x2 v0 = *(const LAS u32x2*)(vb + (db * 32 * VP + 16 * s) * 2), v1 = *(const LAS u32x2*)(vb + (db * 32 * VP + 16 * s + 8) * 2);
                const u32x4 vv = {v0.x, v0.y, v1.x, v1.y}; const bf16x8 vf = __builtin_bit_cast(bf16x8, vv);
                if (db == 0) O0 = __builtin_amdgcn_mfma_f32_32x32x16_bf16(pa, vf, O0, 0, 0, 0); else O1 = __builtin_amdgcn_mfma_f32_32x32x16_bf16(pa, vf, O1, 0, 0, 0); } }
        if (j + 1 < ntiles) A2_LSTORE(b ^ 1);
        __syncthreads();
    }
    const float ltot = lsum + __shfl_xor(lsum, 32);
    if (hi == 0) wsf[r32] = 1.f / ltot;
#pragma unroll
    for (int g = 0; g < 4; ++g) { const f32x4 a4 = *(const LAS f32x4*)(wsf + 8 * g + 4 * hi);
#pragma unroll
        for (int i = 0; i < 4; ++i) { bf16_t* op = obase + (size_t)(i + 8 * g + 4 * hi) * ostride + r32;
            op[0] = (bf16_t)f2bf(O0[4 * g + i] * a4[i]); op[32] = (bf16_t)f2bf(O1[4 * g + i] * a4[i]); } }
    __syncthreads();
#undef A2_GLOAD
#undef A2_LSTORE
}

__device__ __forceinline__ void ph_attn_window(const Frame& F, const bf16_t* QA, const bf16_t* KA, const bf16_t* P, const float* sink_l, bf16_t* YB, bool need_ctx) {
    const int nun = 512 + (need_ctx ? 16 : 0);
    const int nb_ = F.G > 128 ? F.G - 64 : F.G, b0_ = F.G > 128 ? F.bid - 64 : F.bid;
    for (int u = b0_; u < nun; u += nb_) {
        if (u < 0) break;
        const int w = F.wave, r32 = F.lane & 31;
        if (u < 512) {
            const int b = u >> 7, kvh = (u >> 6) & 1, n = u & 63, hq = 2 * kvh + (w >> 2);
            const int t = 128 * n + 32 * (w & 3);
            const int w0 = (n == 0) ? 0 : 128 * (n - 1), w1 = (n >= 62) ? SEQ : 128 * (n + 2), nwt = (w1 - w0) / 64;
            const bf16_t* Kb = KA + (size_t)(b * SEQ) * 128 + kvh * 64; const bf16_t* Vb = P + (size_t)(b * SEQ) * NINP + 384 + kvh * 64;
            const bf16_t* Kc = KA + (size_t)(MLAT + b * CTXL) * 128 + kvh * 64; const bf16_t* Vc = P + (size_t)(MLAT + b * CTXL) * NINP + 384 + kvh * 64;
            auto tf = [&](int j, const bf16_t*& Kp, const bf16_t*& Vp, int& kp0) {
                if (j < nwt) { kp0 = w0 + 64 * j; Kp = Kb + (size_t)kp0 * 128; Vp = Vb + (size_t)kp0 * NINP; }
                else { kp0 = -1; Kp = Kc + (size_t)(64 * (j - nwt)) * 128; Vp = Vc + (size_t)(64 * (j - nwt)) * NINP; } };
            const size_t qr = (size_t)(b * SEQ + t);
            attn_unit<64, true>(F, QA + (qr + r32) * 256 + hq * 64, t + r32, true, sink_l[hq] * 1.4426950408889634f, nwt + 4, tf, 128, NINP, YB + qr * D + hq * 64, D);
        } else {
            const int v = u - 512, b = v >> 2, kvh = (v >> 1) & 1, n = v & 1, hq = 2 * kvh + (w >> 2);
            const int jq = 128 * n + 32 * (w & 3);
            const bf16_t* Kc = KA + (size_t)(MLAT + b * CTXL) * 128 + kvh * 64; const bf16_t* Vc = P + (size_t)(MLAT + b * CTXL) * NINP + 384 + kvh * 64;
            auto tf = [&](int j, const bf16_t*& Kp, const bf16_t*& Vp, int& kp0) { kp0 = -1; Kp = Kc + (size_t)(64 * j) * 128; Vp = Vc + (size_t)(64 * j) * NINP; };
            const size_t qr = (size_t)(MLAT + b * CTXL + jq);
            attn_unit<64, false>(F, QA + (qr + r32) * 256 + hq * 64, 0, true, sink_l[hq] * 1.4426950408889634f, 4, tf, 128, NINP, YB + qr * D + hq * 64, D);
        }
    }
}
__device__ __forceinline__ void ph_attn_mla(const Frame& F, const bf16_t* QC, const bf16_t* KC, const bf16_t* VC, bf16_t* YB, bool need_ctx) {
    const int nun = 512 + (need_ctx ? 16 : 0);
    for (int u = F.bid; u < nun; u += F.G) {
        const int w = F.wave, r32 = F.lane & 31;
        const bool isl = u < 512; const int v = isl ? u : u - 512;
        const int b = isl ? (v >> 7) : (v >> 2), hd = isl ? ((v >> 5) & 3) : (v & 3), qb = isl ? (v & 31) : 0;
        const bf16_t* Kc = KC + (size_t)(MLAT + b * CTXL) * 384 + hd * 96; const bf16_t* Vc = VC + (size_t)(MLAT + b * CTXL) * 256 + hd * 64;
        const bf16_t* Kl = KC + (size_t)(b * SEQ) * 384 + hd * 96; const bf16_t* Vl = VC + (size_t)(b * SEQ) * 256 + hd * 64;
        auto tf = [&](int j, const bf16_t*& Kp, const bf16_t*& Vp) {
            if (j < 2) { Kp = Kc + (size_t)(128 * j) * 384; Vp = Vc + (size_t)(128 * j) * 256; } else { Kp = Kl + (size_t)(128 * (j - 2)) * 384; Vp = Vl + (size_t)(128 * (j - 2)) * 256; } };
        const size_t qr = isl ? (size_t)(b * SEQ + 256 * qb + 32 * w) : (size_t)(MLAT + b * CTXL + 32 * w);
        attn_unit2<96>(F, QC + (qr + r32) * 384 + hd * 96, isl ? 66 : 2, tf, 384, 256, YB + qr * D + 512 + hd * 64, D);
    }
}

__device__ __forceinline__ void ph_ret_scan(const Frame& F, const bf16_t* P, const bf16_t* RQ, const bf16_t* RK, bf16_t* RETY, bf16_t* REF) {
    if (F.bid >= 4 || F.wave != 0) return;
    const int task = 9 * F.bid, dir = task & 1, hd = (task >> 1) & 3, b = task >> 3, lane = F.lane;
    const float lgam = logf(1.f - expf(-3.4657359027997265f + (-6.238324625039508f + 3.4657359027997265f) * (float)(2 * hd + dir) / 7.f));
    const float gam = expf(lgam);
    float S[64];
#pragma unroll
    for (int d = 0; d < 64; ++d) S[d] = 0.f;
    for (int seg = 0; seg < 2; ++seg) {
        const int n = seg == 0 ? CTXL : SEQ; const int base = seg == 0 ? MLAT + b * CTXL : b * SEQ;
        for (int st = 0; st < n; ++st) {
            const int row = base + (dir == 0 ? st : n - 1 - st);
            const float q = bf2f(RQ[(size_t)row * 256 + hd * 64 + lane]), k = bf2f(RK[(size_t)row * 256 + hd * 64 + lane]), v = bf2f(P[(size_t)row * NINP + 1024 + hd * 64 + lane]);
            float o = 0.f;
#pragma unroll
            for (int d = 0; d < 64; ++d) { const float kd = __int_as_float(__builtin_amdgcn_readlane(__float_as_int(k), d)), qd = __int_as_float(__builtin_amdgcn_readlane(__float_as_int(q), d)); S[d] = S[d] * gam + kd * v; o += qd * S[d]; }
            REF[((size_t)F.bid * 8448 + (seg == 0 ? row - base : 256 + row - base)) * 64 + lane] = (bf16_t)f2bf(o);
        }
    }
}
__device__ __forceinline__ void ph_ret_combine(const Frame& F, const bf16_t* P, const bf16_t* RETY, bf16_t* YB, int nrows) {
    for (int row = F.gw; row < nrows; row += F.ngw) {
        float out[4] = {0.f, 0.f, 0.f, 0.f};
#pragma unroll
        for (int dir = 0; dir < 2; ++dir) {
            const u32x2 yw = *((const u32x2*)(RETY + ((size_t)dir * MALL + row) * 256) + F.lane);
            const u32x2 gw = *((const u32x2*)(P + (size_t)row * NINP + 1280 + dir * 256) + F.lane);
            float y[4] = {__uint_as_float(yw.x << 16), __uint_as_float(yw.x & 0xffff0000u), __uint_as_float(yw.y << 16), __uint_as_float(yw.y & 0xffff0000u)};
            float g[4] = {__uint_as_float(gw.x << 16), __uint_as_float(gw.x & 0xffff0000u), __uint_as_float(gw.y << 16), __uint_as_float(gw.y & 0xffff0000u)};
            const float mean = grp16_sum(y[0] + y[1] + y[2] + y[3]) * (1.f / 64.f);
            float s2 = 0.f;
#pragma unroll
            for (int e = 0; e < 4; ++e) { y[e] -= mean; s2 += y[e] * y[e]; }
            const float rstd = 1.f / sqrtf(grp16_sum(s2) * (1.f / 64.f) + 1e-5f);
#pragma unroll
            for (int e = 0; e < 4; ++e) out[e] += silu_f(g[e]) * y[e] * rstd;
        }
        *((u32x2*)(YB + (size_t)row * D + 256) + F.lane) = (u32x2){pk2(out[0], out[1]), pk2(out[2], out[3])};
    }
}


__device__ __forceinline__ void ph_router_tables(const Frame& F, const float* router_w, bf16_t* RWHI, bf16_t* RWLO) {
    for (int i = F.bid * NTHR + F.tid; i < 64 * 1024; i += F.G * NTHR) { const int e = i >> 10, k = i & 1023; const float w = router_w[(size_t)k * 64 + e];
        const unsigned h = f2bf(w); RWHI[i] = (bf16_t)h; RWLO[i] = (bf16_t)f2bf(w - __uint_as_float(h << 16)); }
}
__device__ __forceinline__ void ph_gs2(const Frame& F, const float* g_norm2  , const float* MOD, float* GS2) {
    for (int i = F.bid * NTHR + F.tid; i < 2 * 5 * 1024; i += F.G * NTHR) { const int l = i / 5120, v = (i / 1024) % 5, k = i & 1023;
        GS2[i] = g_norm2[l * 1024 + k] * (1.f + MOD[((size_t)l * 5 + v) * 6144 + 4 * D + k]); }
}
__device__ __forceinline__ void ph_moe_route(const Frame& F, const float* H, const float* modl, const float* gs2l  , const bf16_t* RWHI, const bf16_t* RWLO, const float* router_b,
                                             bf16_t* XN, unsigned* cnt, int* TOKE, int* TOKP, float* TOKW, int nrows) {
    const int lane = F.lane, r32 = lane & 31, hi = lane >> 5, w = F.wave;
    LAS unsigned char* FH = F.lds; LAS unsigned char* FL = F.lds + 65536;
    LAS float* PART = (LAS float*)F.lds;
    bf16x8 wb[8][4];
    { const bf16_t* bh = RWHI + (size_t)r32 * 1024 + 128 * w + 8 * hi; const bf16_t* bl = RWLO + (size_t)r32 * 1024 + 128 * w + 8 * hi;
#pragma unroll
      for (int s = 0; s < 8; ++s) { wb[s][0] = *(const bf16x8*)(bh + 16 * s); wb[s][1] = *(const bf16x8*)(bh + 32 * 1024 + 16 * s); wb[s][2] = *(const bf16x8*)(bl + 16 * s); wb[s][3] = *(const bf16x8*)(bl + 32 * 1024 + 16 * s); } }
    for (int tile = F.bid; tile < nrows / 32; tile += F.G) {
        const int row0 = tile * 32, vec = row_vec(row0); const float* mv = modl + (size_t)vec * 6144; const float* gs = gs2l + vec * 1024;
#pragma unroll 1
        for (int qp = 0; qp < 2; ++qp) { f32x4 v[2][4]; float s2[2];
#pragma unroll
          for (int q = 0; q < 2; ++q) { const f32x4* xr = (const f32x4*)(H + (size_t)(row0 + 4 * w + 2 * qp + q) * D) + lane; s2[q] = 0.f;
#pragma unroll
              for (int j = 0; j < 4; ++j) { v[q][j] = xr[64 * j]; s2[q] += (v[q][j].x * v[q][j].x + v[q][j].y * v[q][j].y) + (v[q][j].z * v[q][j].z + v[q][j].w * v[q][j].w); } }
#pragma unroll
          for (int o = 1; o < 64; o <<= 1) {
#pragma unroll
              for (int q = 0; q < 2; ++q) s2[q] += __shfl_xor(s2[q], o); }
#pragma unroll
          for (int q = 0; q < 2; ++q) { const float rstd = 1.f / sqrtf(s2[q] * (1.f / D) + NORM_EPS); const int rr = 4 * w + 2 * qp + q;
              u32x2* o = (u32x2*)(XN + (size_t)(row0 + rr) * D) + lane;
#pragma unroll
              for (int j = 0; j < 4; ++j) { const int ci = 64 * j + lane; const f32x4 g4 = ((const f32x4*)gs)[ci], sh = ((const f32x4*)(mv + 3 * D))[ci];
                  const f32x4 y = v[q][j] * rstd * g4 + sh;
                  const unsigned h0 = pg8::cvt_pk_bf16(y.x, y.y), h1 = pg8::cvt_pk_bf16(y.z, y.w);
                  o[64 * j] = (u32x2){h0, h1};
                  const unsigned l0 = pg8::cvt_pk_bf16(y.x - __uint_as_float(h0 << 16), y.y - __uint_as_float(h0 & 0xffff0000u)), l1 = pg8::cvt_pk_bf16(y.z - __uint_as_float(h1 << 16), y.w - __uint_as_float(h1 & 0xffff0000u));
                  const int col = 4 * ci, off = rr * 2048 + ((((col >> 3) ^ (rr & 15)) << 3) + (col & 7)) * 2;
                  *(LAS u32x2*)(FH + off) = (u32x2){h0, h1}; *(LAS u32x2*)(FL + off) = (u32x2){l0, l1}; } } }
        __syncthreads();
        const f32x16 z16 = {0.f,0.f,0.f,0.f,0.f,0.f,0.f,0.f,0.f,0.f,0.f,0.f,0.f,0.f,0.f,0.f};
        f32x16 a0 = z16, a1 = z16;
        {
#pragma unroll
          for (int s = 0; s < 8; ++s) { const int ch = (16 * w + 2 * s + hi) ^ (r32 & 15);
              const bf16x8 ah = *(const LAS bf16x8*)(FH + r32 * 2048 + ch * 16), al = *(const LAS bf16x8*)(FL + r32 * 2048 + ch * 16);
              const bf16x8 bh0 = wb[s][0], bh1 = wb[s][1], bl0 = wb[s][2], bl1 = wb[s][3];
              a0 = __builtin_amdgcn_mfma_f32_32x32x16_bf16(ah, bh0, a0, 0, 0, 0); a1 = __builtin_amdgcn_mfma_f32_32x32x16_bf16(ah, bh1, a1, 0, 0, 0);
              a0 = __builtin_amdgcn_mfma_f32_32x32x16_bf16(al, bh0, a0, 0, 0, 0); a1 = __builtin_amdgcn_mfma_f32_32x32x16_bf16(al, bh1, a1, 0, 0, 0);
              a0 = __builtin_amdgcn_mfma_f32_32x32x16_bf16(ah, bl0, a0, 0, 0, 0); a1 = __builtin_amdgcn_mfma_f32_32x32x16_bf16(ah, bl1, a1, 0, 0, 0); } }
        __syncthreads();
#pragma unroll
        for (int r = 0; r < 16; ++r) { PART[(w * 32 + crow(r, hi)) * 64 + r32] = a0[r]; PART[(w * 32 + crow(r, hi)) * 64 + 32 + r32] = a1[r]; }
        __syncthreads();
        {
            const float rb = router_b[lane]; const int e = lane & 7;
            int me0 = 0, me1 = 0; float ms0 = 0.f, ms1 = 0.f;
#pragma unroll 1
            for (int q = 0; q < 4; ++q) { const int tl = 4 * w + q;
                float lg = 0.f;
#pragma unroll
                for (int ww = 0; ww < 8; ++ww) lg += PART[(ww * 32 + tl) * 64 + lane];
                const float sc = sigmoid_div_f(lg), v = sc + rb;
                int rank = 0;
#pragma unroll
                for (int d = 1; d < 8; ++d) { const float vj = __shfl_xor(v, d); rank += (vj > v || (vj == v && (e ^ d) < e)) ? 1 : 0; }
                float gsum = rank < 2 ? v : 0.f;
                gsum += __shfl_xor(gsum, 1); gsum += __shfl_xor(gsum, 2); gsum += __shfl_xor(gsum, 4);
                int grank = 0; const int g = lane >> 3;
#pragma unroll
                for (int d = 1; d < 8; ++d) { const float sj = __shfl_xor(gsum, 8 * d); grank += (sj > gsum || (sj == gsum && (g ^ d) < g)) ? 1 : 0; }
                const unsigned long long b0 = __ballot(grank == 0 && rank == 0), b1 = __ballot(grank == 0 && rank == 1);
                const int l0 = __ffsll((long long)b0) - 1, l1 = __ffsll((long long)b1) - 1;
                const float s0 = __int_as_float(__builtin_amdgcn_readlane(__float_as_int(sc), l0)), s1 = __int_as_float(__builtin_amdgcn_readlane(__float_as_int(sc), l1));
                if (lane == q) { me0 = l0; me1 = l1; ms0 = s0; ms1 = s1; } }
            if (lane < 4) { const int tok = row0 + 4 * w + lane; const float inv = 1.f / (ms0 + ms1);
                const unsigned p0 = atomicAdd(cnt + me0 * CNT_STRIDE, 1u), p1 = atomicAdd(cnt + me1 * CNT_STRIDE, 1u);
                TOKE[2 * tok] = me0; TOKE[2 * tok + 1] = me1; TOKP[2 * tok] = (int)p0; TOKP[2 * tok + 1] = (int)p1; TOKW[2 * tok] = ms0 * inv; TOKW[2 * tok + 1] = ms1 * inv; }
        }
        __syncthreads();
    }
}
constexpr int MOE_TAB_OFF = LDSCTL_OFF + 1024;
__device__ __forceinline__ void moe_table(const Frame& F, const unsigned* cnt) {
    LAS int* tb = (LAS int*)(F.lds + MOE_TAB_OFF);
    __syncthreads();
    if (F.wave == 0) {
        const int e = F.lane; const int nb = ((int)cnt[e * CNT_STRIDE] + 255) >> 8; int inc = nb;
#pragma unroll
        for (int d = 1; d < 64; d <<= 1) { const int u = __shfl_up(inc, d); inc += (e >= d) ? u : 0; }
        const int base = (inc - nb) << 8; tb[e] = base; if (e == 63) tb[64] = inc << 8;
        for (int j = 0; j < nb; ++j) tb[65 + (base >> 8) + j] = e; }
    __syncthreads();
}
__device__ __forceinline__ void ph_moe_rowtok(const Frame& F, const unsigned* cnt, const int* TOKE, const int* TOKP, int* ROWTOK, int nrows) {
    const LAS int* tb = (const LAS int*)(F.lds + MOE_TAB_OFF);
    for (int a = F.bid * NTHR + F.tid; a < 2 * nrows; a += F.G * NTHR) ROWTOK[tb[TOKE[a]] + TOKP[a]] = a >> 1;
    for (int e = F.bid; e < 64; e += F.G) { const int lo = tb[e] + (int)cnt[e * CNT_STRIDE], hiR = (e == 63) ? tb[64] : tb[e + 1];
        for (int r = lo + F.tid; r < hiR; r += NTHR) ROWTOK[r] = 0; }
}
struct SchedGU {
    static constexpr int lda = D, ldb = D, K = D;
    const bf16_t* XB  ; const bf16_t* W; const bf16_t* W0  ; const LAS int* tb; const int* rowtok; int G, c;
    __device__ __forceinline__ bool next(int i, pg8::Unit& u) const {
        const int L = i * G + c, nrb = tb[64] >> 8; if (L >= nrb * 4) return false;
        int rb, t; xcd_tile(L, nrb, 4, rb, t); const int e = tb[65 + rb];
        u.A = XB; u.B = (e < NE0 ? W0 : W) + ((size_t)e * 1024 + t * 256) * D; u.u0 = rb * 256; u.u1 = t * 128; u.u2 = 0; return true;
    }
};
struct EpiSwiGLU {
    static constexpr bool PERM = true;
    bf16_t* O;
    __device__ __forceinline__ void operator()(const f32x4 (&acc)[2][2][4][2], const pg8::Unit& u, int wr, int wc, int fr, int fq) const {
        const int row0 = u.u0 + wr * 64 + fr, col0 = u.u1 + wc * 32 + 8 * fq;
#pragma unroll
        for (int ai = 0; ai < 2; ++ai)
#pragma unroll
            for (int m = 0; m < 4; ++m) { float y[8];
#pragma unroll
                for (int n = 0; n < 2; ++n)
#pragma unroll
                    for (int e = 0; e < 4; ++e) { const float g = acc[ai][0][m][n][e]; y[4 * n + e] = g * __builtin_amdgcn_rcpf(1.f + __expf(-g)) * acc[ai][1][m][n][e]; }
                u32x4 w; w.x = pg8::cvt_pk_bf16(y[0], y[1]); w.y = pg8::cvt_pk_bf16(y[2], y[3]); w.z = pg8::cvt_pk_bf16(y[4], y[5]); w.w = pg8::cvt_pk_bf16(y[6], y[7]);
                *(u32x4*)(O + (size_t)(row0 + ai * 128 + m * 16) * 512 + col0) = w; }
    }
};
struct SchedDown {
    static constexpr int lda = 512, ldb = 512, K = 512;
    const bf16_t* HID; const bf16_t* W; const bf16_t* W0; const LAS int* tb; int G, c;
    __device__ __forceinline__ bool next(int i, pg8::Unit& u) const {
        const int L = i * G + c, nrb = tb[64] >> 8; if (L >= nrb * 4) return false;
        int rb, pn; xcd_tile(L, nrb, 4, rb, pn); const int e = tb[65 + rb];
        u.A = HID + (size_t)rb * 256 * 512; u.B = (e < NE0 ? W0 : W) + ((size_t)e * 1024 + pn * 256) * 512; u.u0 = rb * 256; u.u1 = pn * 256; u.u2 = 0; return true;
    }
};
__device__ __forceinline__ void ph_moe_combine(const Frame& F, float* H, const float* modl, const bf16_t* Y, const int* TOKE, const int* TOKP, const float* TOKW, int nrows) {
    const LAS int* tb = (const LAS int*)(F.lds + MOE_TAB_OFF);
    for (int tok = F.gw; tok < nrows; tok += F.ngw) {
        const int d0 = tb[TOKE[2 * tok]] + TOKP[2 * tok], d1 = tb[TOKE[2 * tok + 1]] + TOKP[2 * tok + 1];
        const float w0 = TOKW[2 * tok], w1 = TOKW[2 * tok + 1];
        const float* gv = modl + (size_t)row_vec(tok) * 6144 + 5 * D;
        f32x4* hr = (f32x4*)(H + (size_t)tok * D) + F.lane;
        const u32x2* y0 = (const u32x2*)(Y + (size_t)d0 * D) + F.lane; const u32x2* y1 = (const u32x2*)(Y + (size_t)d1 * D) + F.lane;
#pragma unroll
        for (int j = 0; j < 4; ++j) { const u32x2 a = y0[64 * j], b = y1[64 * j]; const f32x4 g = ((const f32x4*)gv)[64 * j + F.lane];
            f32x4 f; f.x = w0 * __uint_as_float(a.x << 16) + w1 * __uint_as_float(b.x << 16); f.y = w0 * __uint_as_float(a.x & 0xffff0000u) + w1 * __uint_as_float(b.x & 0xffff0000u);
            f.z = w0 * __uint_as_float(a.y << 16) + w1 * __uint_as_float(b.y << 16); f.w = w0 * __uint_as_float(a.y & 0xffff0000u) + w1 * __uint_as_float(b.y & 0xffff0000u);
            hr[64 * j] = hr[64 * j] + g * f; }
    }
}


__device__ __forceinline__ float row_rstd(const f32x4 (&v)[4]) { float s2 = 0.f;
#pragma unroll
    for (int j = 0; j < 4; ++j) s2 += (v[j].x * v[j].x + v[j].y * v[j].y) + (v[j].z * v[j].z + v[j].w * v[j].w);
    return 1.f / sqrtf(wave_sum(s2) * (1.f / D) + NORM_EPS); }
__device__ __forceinline__ void row_adaln_store(const f32x4 (&v)[4], float rstd, const float* g, const float* mv, int shift_i, int scale_i, bf16_t* xn_row, int lane) {
    u32x2* o = (u32x2*)xn_row + lane;
#pragma unroll
    for (int j = 0; j < 4; ++j) { const int ci = 64 * j + lane; const f32x4 gg = ((const f32x4*)g)[ci], sc = ((const f32x4*)(mv + scale_i * D))[ci], sh = ((const f32x4*)(mv + shift_i * D))[ci];
        const f32x4 y = v[j] * rstd * gg * (sc + 1.f) + sh; o[64 * j] = (u32x2){pk2(y.x, y.y), pk2(y.z, y.w)}; }
}
__device__ __forceinline__ void ph_copy_h_adaln(const Frame& F, const float* x, const float* ctx, float* H, const float* g, const float* modl, bf16_t* XN) {
    for (int m = F.gw; m < MALL; m += F.ngw) {
        const f32x4* xr = (const f32x4*)(m < MLAT ? x + (size_t)m * D : ctx + (size_t)(m - MLAT) * D) + F.lane;
        f32x4 v[4];
#pragma unroll
        for (int j = 0; j < 4; ++j) v[j] = xr[64 * j];
        (void)H;
        row_adaln_store(v, row_rstd(v), g, modl + (size_t)row_vec(m) * 6144, 0, 1, XN + (size_t)m * D, F.lane);
    }
}
template <bool LAST> __device__ __forceinline__ void ph_moe_combine_norm(const Frame& F, float* H, const float* modl, const bf16_t* Y, const int* TOKE, const int* TOKP, const float* TOKW, int nrows,
                                                                         const float* g_next, const float* modl_next, bf16_t* XN, float* out) {
    const LAS int* tb = (const LAS int*)(F.lds + MOE_TAB_OFF);
    for (int tok = F.gw; tok < nrows; tok += F.ngw) {
        const int d0 = tb[TOKE[2 * tok]] + TOKP[2 * tok], d1 = tb[TOKE[2 * tok + 1]] + TOKP[2 * tok + 1];
        const float w0 = TOKW[2 * tok], w1 = TOKW[2 * tok + 1];
        const float* gv = modl + (size_t)row_vec(tok) * 6144 + 5 * D;
        f32x4* hr = (f32x4*)(H + (size_t)tok * D) + F.lane;
        const u32x2* y0 = (const u32x2*)(Y + (size_t)d0 * D) + F.lane; const u32x2* y1 = (const u32x2*)(Y + (size_t)d1 * D) + F.lane;
        f32x4 v[4];
#pragma unroll
        for (int j = 0; j < 4; ++j) { const u32x2 a = y0[64 * j], b = y1[64 * j]; const f32x4 g = ((const f32x4*)gv)[64 * j + F.lane];
            f32x4 f; f.x = w0 * __uint_as_float(a.x << 16) + w1 * __uint_as_float(b.x << 16); f.y = w0 * __uint_as_float(a.x & 0xffff0000u) + w1 * __uint_as_float(b.x & 0xffff0000u);
            f.z = w0 * __uint_as_float(a.y << 16) + w1 * __uint_as_float(b.y << 16); f.w = w0 * __uint_as_float(a.y & 0xffff0000u) + w1 * __uint_as_float(b.y & 0xffff0000u);
            v[j] = hr[64 * j] + g * f; }
        const float rstd = row_rstd(v);
        if (LAST) { f32x4* o = (f32x4*)(out + (size_t)tok * D) + F.lane;
#pragma unroll
            for (int j = 0; j < 4; ++j) o[64 * j] = v[j] * rstd * ((const f32x4*)g_next)[64 * j + F.lane]; }
        else {
#pragma unroll
            for (int j = 0; j < 4; ++j) hr[64 * j] = v[j];
            row_adaln_store(v, rstd, g_next, modl_next + (size_t)row_vec(tok) * 6144, 0, 1, XN + (size_t)tok * D, F.lane); }
    }
}

#ifndef DIAG
#define DIAG 0
#endif
#define PROBE 0
constexpr int CW_DIAG = 8;
__device__ __forceinline__ void diag_fail(unsigned* ctl, int bit) { atomicOr(ctl + CW_DIAG + 2, 1u << (bit & 31)); }
__device__ __forceinline__ bool diag_close(float got, float ref, float scale) { return fabsf(got - ref) <= 0.03f * fabsf(ref) + 0.03f * scale; }

__device__ __forceinline__ void ph_final(const Frame& F, const float* H, const float* g, float* out) {
    float dscale = 1.f;
#if DIAG
    { const unsigned d3 = F.ctl[CW_DIAG + 3] | F.ctl[CW_DIAG + 2]; const unsigned d0 = d3 ? d3 : F.ctl[CW_DIAG], d1 = F.ctl[CW_DIAG + 1]; if (d0) dscale = 1.f + 0.5f * (float)__builtin_ffs((int)d0); else if (d1) dscale = 11.25f + 0.5f * (float)__builtin_ffs((int)d1); }
#endif
    for (int m = F.gw; m < MLAT; m += F.ngw) {
        const f32x4* xr = (const f32x4*)(H + (size_t)m * D) + F.lane;
        f32x4 v[4]; float s2 = 0.f;
#pragma unroll
        for (int j = 0; j < 4; ++j) { v[j] = xr[64 * j]; s2 += (v[j].x * v[j].x + v[j].y * v[j].y) + (v[j].z * v[j].z + v[j].w * v[j].w); }
        const float rstd = 1.f / sqrtf(wave_sum(s2) * (1.f / D) + NORM_EPS);
        f32x4* o = (f32x4*)(out + (size_t)m * D) + F.lane;
#pragma unroll
        for (int j = 0; j < 4; ++j) { const f32x4 gg = ((const f32x4*)g)[64 * j + F.lane]; o[64 * j] = v[j] * rstd * gg * dscale; }
    }
}


#if DIAG
__device__ __forceinline__ float bfr(float x) { return __uint_as_float(f2bf(x) << 16); }
__device__ __forceinline__ void chk_P(const Frame& F, const bf16_t* XN, const float* w_in_l, const bf16_t* P) {
    const int s = F.bid * NTHR + F.tid; if (s >= 8192) return;
    const int row = (int)(((long)s * 7919) % MALL), col = (int)(((long)s * 104729) % NIN);
    float acc = 0.f, sc = 0.f;
    for (int k = 0; k < D; ++k) { const float a = bf2f(XN[(size_t)row * D + k]), w = bfr(w_in_l[(size_t)k * NIN + col]); acc += a * w; sc += a * a * w * w; }
    if (!diag_close(bf2f(P[(size_t)row * NINP + col]), acc, sqrtf(sc))) diag_fail(F.ctl, 0 + F.dl);
}
__device__ __forceinline__ void chk_branch(const Frame& F, const bf16_t* YB, const float* w_branch_l, const bf16_t* BOUT, int nrows) {
    const int s = F.bid * NTHR + F.tid; if (s >= 8192) return;
    const int row = (int)(((long)s * 7919) % nrows), col = (int)(((long)s * 104729) % 4096), n = col >> 10, j = col & 1023;
    float acc = 0.f, sc = 0.f;
    for (int k = 0; k < 256; ++k) { const float a = bf2f(YB[(size_t)row * D + n * 256 + k]), w = bfr(w_branch_l[((size_t)n * 256 + k) * D + j]); acc += a * w; sc += a * a * w * w; }
    if (!diag_close(bf2f(BOUT[(size_t)row * 4096 + col]), acc, sqrtf(sc))) diag_fail(F.ctl, 1 + F.dl);
}
__device__ __forceinline__ void chk_gate(const Frame& F, const bf16_t* XN, const bf16_t* YB, const float* w_gate_l, const float* b_gate_l, const float* w_branch_l, const bf16_t* BOUT, int nrows) {
    const int s = F.bid * NTHR + F.tid; if (s >= 8192) return;
    const int row = (int)(((long)s * 7919) % nrows), col = (int)(((long)s * 104729) % 4096), n = col >> 10, j = col & 1023;
    float acc = 0.f, sc = 0.f;
    for (int k = 0; k < 256; ++k) { const float a = bf2f(YB[(size_t)row * D + n * 256 + k]), w = bfr(w_branch_l[((size_t)n * 256 + k) * D + j]); acc += a * w; sc += a * a * w * w; }
    float g = b_gate_l[col];
    for (int k = 0; k < D; ++k) g += bf2f(XN[(size_t)row * D + k]) * bfr(w_gate_l[((size_t)n * D + k) * D + j]);
    const float ref = bfr(acc) * sigmoid_f(g);
    if (!diag_close(bf2f(BOUT[(size_t)row * 4096 + col]), ref, sqrtf(sc))) diag_fail(F.ctl, 2 + F.dl);
}
__device__ __forceinline__ void chk_out(const Frame& F, const bf16_t* ACC, const float* w_out_l, const float* modl, const float* x, const float* H) {
    const int s = F.bid * NTHR + F.tid; if (s >= 8192) return;
    const int row = (int)(((long)s * 7919) % MLAT), col = (int)(((long)s * 104729) % D);
    float acc = 0.f, sc = 0.f;
    for (int k = 0; k < D; ++k) { const float a = bf2f(ACC[(size_t)row * D + k]), w = bfr(w_out_l[(size_t)k * D + col]); acc += a * w; sc += a * a * w * w; }
    const float m2 = modl[(size_t)row_vec(row) * 6144 + 2 * D + col];
    if (!diag_close(H[(size_t)row * D + col] - x[(size_t)row * D + col], m2 * acc, fabsf(m2) * sqrtf(sc) + 1e-3f)) diag_fail(F.ctl, 3 + F.dl);
}
__device__ __forceinline__ void chk_sum4(const Frame& F, const bf16_t* BOUT, const bf16_t* ACC, int nrows) {
    const int s = F.bid * NTHR + F.tid; if (s >= 8192) return;
    const int row = (int)(((long)s * 7919) % nrows), col = (int)(((long)s * 104729) % D);
    float a = 0.f, sc = 0.f; for (int n = 0; n < 4; ++n) { const float v = bf2f(BOUT[(size_t)row * 4096 + n * 1024 + col]); a += v; sc += fabsf(v); }
    if (!diag_close(bf2f(ACC[(size_t)row * D + col]), a, sc)) diag_fail(F.ctl, 4 + F.dl);
}
#endif


#if DIAG
__device__ __forceinline__ float wave_max(float v) {
#pragma unroll
    for (int o = 1; o < 64; o <<= 1) v = fmaxf(v, __shfl_xor(v, o));
    return v;
}
__device__ __forceinline__ void chk_attn_window(const Frame& F, const bf16_t* QA, const bf16_t* KA, const bf16_t* P, const float* sink_l, const bf16_t* YB, bool need_ctx) {
    const int s = F.gw; if (s >= 2048) return;
    const int nrows = need_ctx ? MALL : MLAT;
    const int row = (int)(((long)s * 7919) % nrows), hq = s & 3, kvh = hq >> 1, d0 = (s * 13) & 63;
    const bool lat = row < MLAT; const int b = lat ? (row >> 13) : ((row - MLAT) >> 8), t = row & 8191;
    const bf16_t* q = QA + (size_t)row * 256 + hq * 64;
    const float LN2 = 0.6931471805599453f;
    const int k0 = lat ? max(0, t - 128) : 0, k1 = lat ? min(SEQ - 1, t + 128) : -1, nk = k1 - k0 + 1 + CTXL;
    float sc[9]; float m = sink_l[hq];
#pragma unroll
    for (int i = 0; i < 9; ++i) { const int kk = k0 + F.lane + 64 * i; sc[i] = -1e30f;
        if (kk - k0 < nk) { const int krow = (kk <= k1) ? b * SEQ + kk : MLAT + b * CTXL + (kk - k1 - 1); const bf16_t* kp = KA + (size_t)krow * 128 + kvh * 64; float a = 0.f;
            for (int d = 0; d < 64; ++d) a += bf2f(q[d]) * bf2f(kp[d]);
            sc[i] = a * LN2; m = fmaxf(m, sc[i]); } }
    m = wave_max(m);
    float l = 0.f, o = 0.f;
#pragma unroll
    for (int i = 0; i < 9; ++i) { const int kk = k0 + F.lane + 64 * i;
        if (kk - k0 < nk) { const int krow = (kk <= k1) ? b * SEQ + kk : MLAT + b * CTXL + (kk - k1 - 1); const float e = expf(sc[i] - m); l += e; o += e * bf2f(P[(size_t)krow * NINP + 384 + kvh * 64 + d0]); } }
    l = wave_sum(l) + expf(sink_l[hq] - m); o = wave_sum(o);
    if (F.lane == 0 && !diag_close(bf2f(YB[(size_t)row * D + hq * 64 + d0]), o / l, 0.05f)) diag_fail(F.ctl, 5 + F.dl);
}
__device__ __forceinline__ void chk_attn_mla(const Frame& F, const bf16_t* QC, const bf16_t* KC, const bf16_t* VC, const bf16_t* YB, bool need_ctx) {
    const int s = F.gw; if (s >= 1024) return;
    const int nrows = need_ctx ? MALL : MLAT;
    const int row = (s < 960) ? (int)(((long)s * 7919) % MLAT) : (int)(MLAT + ((long)s * 7919) % MCTX);
    if (row >= nrows) return;
    const int hd = s & 3, d0 = (s * 13) & 63;
    const bool lat = row < MLAT; const int b = lat ? (row >> 13) : ((row - MLAT) >> 8);
    const bf16_t* q = QC + (size_t)row * 384 + hd * 96;
    const float LN2 = 0.6931471805599453f;
    const int nk = lat ? CTXL + SEQ : CTXL;
    float m = -1e30f, l = 0.f, o = 0.f;
    for (int pass = 0; pass < 2; ++pass) {
        for (int kk = F.lane; kk < nk; kk += 64) {
            const int krow = kk < CTXL ? MLAT + b * CTXL + kk : b * SEQ + (kk - CTXL);
            const bf16_t* kp = KC + (size_t)krow * 384 + hd * 96; float sc = 0.f;
            for (int d = 0; d < 96; ++d) sc += bf2f(q[d]) * bf2f(kp[d]);
            sc *= LN2;
            if (pass == 0) m = fmaxf(m, sc); else { const float e = expf(sc - m); l += e; o += e * bf2f(VC[(size_t)krow * 256 + hd * 64 + d0]); }
        }
        if (pass == 0) m = wave_max(m);
    }
    l = wave_sum(l); o = wave_sum(o);
    if (F.lane == 0 && !diag_close(bf2f(YB[(size_t)row * D + 512 + hd * 64 + d0]), o / l, 0.02f)) diag_fail(F.ctl, 6 + F.dl);
}
#endif


#if DIAG
__device__ __forceinline__ void rope_ref(int pos, double expo, float& c, float& s) { sincos_d((double)pos * exp(-9.210340371976184 * expo), s, c); }
__device__ __forceinline__ void chk_prep(const Frame& F, const PrepArgs& a) {
    const int s = F.bid * NTHR + F.tid; if (s >= 16384) return;
    const int row = (int)(((long)s * 7919) % MALL); const bool lat = row < MLAT; const int t = lat ? (row & 8191) : ((row - MLAT) & 255), trow = t >> 6, tcol = t & 63;
    const bf16_t* p = a.P + (size_t)row * NINP; bool ok = true;
    const float QS = 0.125f * 1.4426950408889634f;
    const int ty = s % 5, hd = (s >> 3) & 3;
    if (ty == 0) { const int i = (s >> 5) & 31; float c, sn; rope_ref(lat ? 256 + t : t, (double)i / 32.0, c, sn);
        const float q1 = bf2f(p[512 + hd * 64 + i]), q2 = bf2f(p[512 + hd * 64 + 32 + i]), k1 = bf2f(p[768 + hd * 64 + i]) * 0.125f, k2 = bf2f(p[768 + hd * 64 + 32 + i]) * 0.125f;
        ok &= diag_close(bf2f(a.RQ[(size_t)row * 256 + hd * 64 + i]), q1 * c - q2 * sn, 0.02f) && diag_close(bf2f(a.RQ[(size_t)row * 256 + hd * 64 + 32 + i]), q2 * c + q1 * sn, 0.02f);
        ok &= diag_close(bf2f(a.RK[(size_t)row * 256 + hd * 64 + i]), k1 * c - k2 * sn, 0.003f) && diag_close(bf2f(a.RK[(size_t)row * 256 + hd * 64 + 32 + i]), k2 * c + k1 * sn, 0.003f);
    } else if (ty == 1 || ty == 2) { const int j = (s >> 5) & 15, half = (s >> 9) & 1, d1 = half ? 32 + j : j, d2 = d1 + 16, h2 = ty == 1 ? hd : (hd & 1);
        float c = 1.f, sn = 0.f; if (lat) rope_ref(half ? tcol : trow, (double)j / 16.0, c, sn);
        const bf16_t* src = p + (ty == 1 ? 0 : 256) + h2 * 64; const float sc = ty == 1 ? QS : 1.f; const float x1 = bf2f(src[d1]) * sc, x2 = bf2f(src[d2]) * sc;
        const bf16_t* dst = ty == 1 ? a.QA + (size_t)row * 256 + h2 * 64 : a.KA + (size_t)row * 128 + h2 * 64;
        ok &= diag_close(bf2f(dst[d1]), x1 * c - x2 * sn, 0.01f) && diag_close(bf2f(dst[d2]), x2 * c + x1 * sn, 0.01f);
    } else if (ty == 3) { float s2 = 0.f; for (int k = 0; k < 256; ++k) { const float x = bf2f(p[1792 + k]); s2 += x * x; } const float rs = 1.f / sqrtf(s2 / 256.f + NORM_EPS);
        const int k = (s >> 3) & 255; ok &= diag_close(bf2f(a.CQN[(size_t)row * 256 + k]), bf2f(p[1792 + k]) * rs * a.g_qnorm[k], 0.02f);
        float t2 = 0.f; for (int k2 = 0; k2 < 128; ++k2) { const float x = bf2f(p[2048 + k2]); t2 += x * x; } const float rs2 = 1.f / sqrtf(t2 / 128.f + NORM_EPS);
        const int kk = k & 127; ok &= diag_close(bf2f(a.CKVN[(size_t)row * 128 + kk]), bf2f(p[2048 + kk]) * rs2 * a.g_kvnorm[kk], 0.02f);
    } else { const int j = (s >> 5) & 7, half = (s >> 8) & 1, d1 = half * 16 + j, d2 = d1 + 8; float c = 1.f, sn = 0.f; if (lat) rope_ref(half ? tcol : trow, (double)j / 8.0, c, sn);
        const float x1 = bf2f(p[2176 + d1]), x2 = bf2f(p[2176 + d2]); const bf16_t* kc = a.KC + (size_t)row * 384 + hd * 96 + 64;
        ok &= diag_close(bf2f(kc[d1]), x1 * c - x2 * sn, 0.02f) && diag_close(bf2f(kc[d2]), x2 * c + x1 * sn, 0.02f); }
    if (!ok) diag_fail(F.ctl, 7 + F.dl);
}
__device__ __forceinline__ void chk_proj(const Frame& F, const bf16_t* CQN, const bf16_t* CKVN, const float* w_uq_l, const float* w_ukv_l, const bf16_t* QC, const bf16_t* KC, const bf16_t* VC) {
    const int s = F.bid * NTHR + F.tid; if (s >= 16384) return;
    const int row = (int)(((long)s * 7919) % MALL); const bool lat = row < MLAT; const int t = lat ? (row & 8191) : 0, trow = t >> 6, tcol = t & 63;
    const float QS = 0.10206207261596577f * 1.4426950408889634f;
    if (s & 1) { const int col = (int)(((long)s * 104729) % 384), head = col / 96, dd = col % 96;
        float x = 0.f; for (int k = 0; k < 256; ++k) x += bf2f(CQN[(size_t)row * 256 + k]) * bfr(w_uq_l[(size_t)k * 384 + col]);
        float val = x;
        if (dd >= 64 && lat) { const int e = dd - 64, half = e >> 4, j = e & 7; const bool first = (e & 15) < 8; const int pc = first ? col + 8 : col - 8;
            float pr = 0.f; for (int k = 0; k < 256; ++k) pr += bf2f(CQN[(size_t)row * 256 + k]) * bfr(w_uq_l[(size_t)k * 384 + pc]);
            float c, sn; rope_ref(half ? tcol : trow, (double)j / 8.0, c, sn); val = first ? x * c - pr * sn : x * c + pr * sn; }
        if (!diag_close(bf2f(QC[(size_t)row * 384 + head * 96 + dd]), val * QS, 0.01f)) diag_fail(F.ctl, 8 + F.dl);
    } else { const int col = (int)(((long)s * 104729) % 512), head = col >> 7, dd = col & 127;
        float x = 0.f; for (int k = 0; k < 128; ++k) x += bf2f(CKVN[(size_t)row * 128 + k]) * bfr(w_ukv_l[(size_t)k * 512 + col]);
        const float got = dd < 64 ? bf2f(KC[(size_t)row * 384 + head * 96 + dd]) : bf2f(VC[(size_t)row * 256 + head * 64 + dd - 64]);
        if (!diag_close(got, x, 0.03f)) diag_fail(F.ctl, 8 + F.dl); }
}
#endif


#if DIAG
__device__ __forceinline__ float zref(const bf16_t* P, int row, bool first, bool last, int sc, const float* mu) {
    const bf16_t* q = P + (size_t)row * NINP + 2208 + sc; const float c = bf2f(q[0]); const float pv = first ? 0.f : bf2f(*(q - NINP)), nv = last ? 0.f : bf2f(q[NINP]);
    return c + (0.5f * (pv + nv) - c) * mu[sc]; }
__device__ __forceinline__ void chk_rwkv_feat(const Frame& F, const bf16_t* P, const float* mu, const float* w0, const float* w_up  , const float* a0, const float* a_up, const float* g_up  ,
                                              const float* k_k, const float* k_a, const float* r_k, const RwkvF& O) {
    const int s = F.bid * NTHR + F.tid; if (s >= 8192) return;
    const int row = (int)(((long)s * 7919) % MALL), c = (int)(((long)s * 104729) % 256), h = c >> 6;
    const bool lat = row < MLAT; const int t = lat ? (row & 8191) : ((row - MLAT) & 255); const bool first = t == 0, last = t == (lat ? SEQ : CTXL) - 1;
    float pwf = 0.f, pwb = 0.f, paf = 0.f, pab = 0.f, pg = 0.f;
    for (int k = 0; k < 64; ++k) { pwf += bfr(tanhf(zref(P, row, first, last, 768 + k, mu))) * bfr(w_up[(size_t)k * 256 + c]); pwb += bfr(tanhf(zref(P, row, first, last, 832 + k, mu))) * bfr(w_up[(size_t)(64 + k) * 256 + c]);
        paf += bfr(zref(P, row, first, last, 896 + k, mu)) * bfr(a_up[(size_t)k * 256 + c]); pab += bfr(zref(P, row, first, last, 960 + k, mu)) * bfr(a_up[(size_t)(64 + k) * 256 + c]); }
    for (int k = 0; k < 128; ++k) pg += bfr(sigmoid_f(zref(P, row, first, last, 1024 + k, mu))) * bfr(g_up[(size_t)k * 256 + c]);
    float ss = 0.f, bonus = 0.f;
    const float zr = zref(P, row, first, last, c, mu), zk = zref(P, row, first, last, 256 + c, mu), zv = zref(P, row, first, last, 512 + c, mu);
    for (int j = 0; j < 64; ++j) { const float x = zref(P, row, first, last, 256 + 64 * h + j, mu) * k_k[64 * h + j]; ss += x * x; }
    const float kk = zk * k_k[c] / fmaxf(sqrtf(ss), 1e-12f);
    const float ef = expf(-softplus_f(-(w0[c] + pwf)) - 0.5f), eb = expf(-softplus_f(-(w0[256 + c] + pwb)) - 0.5f);
    const float af = sigmoid_f(a0[c] + paf), ab = sigmoid_f(a0[256 + c] + pab);
    const float kf = zk * (1.f + (af - 1.f) * k_a[c]), kb = zk * (1.f + (ab - 1.f) * k_a[c]);
    const size_t o = (size_t)row * 256 + c; bool ok = true;
    ok &= diag_close(bf2f(O.R[o]), zr, 0.02f) && diag_close(bf2f(O.V[o]), zv, 0.02f) && diag_close(bf2f(O.KF[o]), kf, 0.02f) && diag_close(bf2f(O.KB[o]), kb, 0.02f);
    ok &= diag_close(bf2f(O.KK[o]), kk, 0.003f) && diag_close(bf2f(O.BF[o]), kk * af, 0.003f) && diag_close(bf2f(O.BB[o]), kk * ab, 0.003f);
    ok &= diag_close(bf2f(O.EF[o]), ef, 0.0005f) && diag_close(bf2f(O.EB[o]), eb, 0.0005f) && diag_close(bf2f(O.G[o]), pg, 0.02f);
    if ((c & 63) == 0) { for (int j = 0; j < 64; ++j) { const int cc = 64 * h + j; const float zr2 = zref(P, row, first, last, cc, mu); bonus += zr2 * (bf2f(O.KF[(size_t)row * 256 + cc]) + bf2f(O.KB[(size_t)row * 256 + cc])) * r_k[cc]; }
        ok &= diag_close(O.BONUS[(size_t)row * 4 + h], bonus, 0.5f); }
    if (!ok) diag_fail(F.ctl, 9 + F.dl);
}
#endif


#if DIAG
__device__ __forceinline__ void chk_moe(const Frame& F, const bf16_t* XN, const float* router_w, const float* router_b, const float* weg, const float* weu, const float* wed  ,
                                        const int* TOKE, const int* TOKP, const float* TOKW, const bf16_t* Y, int nrows) {
    const LAS int* tb = (const LAS int*)(F.lds + MOE_TAB_OFF);
    const int s = F.gw; if (s >= 512) return;
    const int tok = (int)(((long)s * 7919) % nrows), col = (s * 37) & 1023, lane = F.lane;
    const bf16_t* x = XN + (size_t)tok * D;
    float lg = 0.f; for (int k = 0; k < D; ++k) lg += bf2f(x[k]) * router_w[(size_t)k * 64 + lane];
    const float sc = sigmoid_f(lg);
    const int e0 = TOKE[2 * tok], e1 = TOKE[2 * tok + 1];
    const float s0 = __shfl(sc, e0), s1 = __shfl(sc, e1);
    bool ok = true;
    if ((e0 >> 3) != (e1 >> 3) || e0 == e1) ok = false;
    if (!diag_close(TOKW[2 * tok], s0 / (s0 + s1), 0.01f) || !diag_close(TOKW[2 * tok + 1], s1 / (s0 + s1), 0.01f)) ok = false;
    { const float bsc = sc + router_b[lane]; const float b0 = __shfl(bsc, e0), b1 = __shfl(bsc, e1);
      const bool ing = (lane >> 3) == (e0 >> 3);
      if (ing && lane != e0 && bsc > b0 + 2e-3f) ok = false;
      if (ing && lane != e0 && lane != e1 && bsc > b1 + 2e-3f) ok = false; }
    ok = __all(ok);
    for (int kk = 0; kk < 2; ++kk) {
        const int e = kk ? e1 : e0; const float* wg = weg + (size_t)e * D * 512; const float* wu = weu + (size_t)e * D * 512; const float* wd = wed + (size_t)e * 512 * D;
        float y = 0.f;
        for (int f = lane; f < 512; f += 64) { float g = 0.f, u = 0.f;
            for (int k = 0; k < D; ++k) { const float xv = bf2f(x[k]); g += xv * bfr(wg[(size_t)k * 512 + f]); u += xv * bfr(wu[(size_t)k * 512 + f]); }
            y += bfr(g / (1.f + expf(-g)) * u) * bfr(wd[(size_t)f * D + col]); }
        y = wave_sum(y);
        const int dst = tb[e] + TOKP[2 * tok + kk];
        if (!diag_close(bf2f(Y[(size_t)dst * D + col]), y, 0.02f)) ok = false;
    }
    if (lane == 0 && !ok) diag_fail(F.ctl, 10 + F.dl);
}
#endif


#if DIAG
__device__ __forceinline__ void chk_scans(const Frame& F, const bf16_t* RETY, const bf16_t* RWY, const bf16_t* REF) {
    for (int i = F.bid * NTHR + F.tid; i < 8 * 8448 * 64; i += F.G * NTHR) {
        const int slot = i / (8448 * 64), pos = (i / 64) % 8448, lane = i & 63, task = 9 * (slot & 3), dir = task & 1, hd = (task >> 1) & 3, b = task >> 3;
        const int row = pos < 256 ? MLAT + b * CTXL + pos : b * SEQ + pos - 256;
        const float ref = bf2f(REF[i]), got = bf2f((slot < 4 ? RETY : RWY)[((size_t)dir * MALL + row) * 256 + hd * 64 + lane]);
        const float d = fabsf(got - ref);
        if (!(fabsf(got) < 1e30f)) diag_fail(F.ctl, 6);
        if (!(d <= 0.1f * fabsf(ref) + 0.5f)) diag_fail(F.ctl, 6);
        else if (!(d <= 0.04f * fabsf(ref) + 0.1f)) diag_fail(F.ctl, 6);
    }
}
#endif


#if DIAG
__device__ __forceinline__ void chk_finite(const Frame& F, const bf16_t* p, size_t n, int bit) {
    bool bad = false;
    for (size_t i = (size_t)F.bid * NTHR + F.tid; i < n / 8; i += (size_t)F.G * NTHR) { const u32x4 w = ((const u32x4*)p)[i];
#pragma unroll
        for (int e = 0; e < 4; ++e) { bad |= ((w[e] & 0x7f80u) == 0x7f80u) | ((w[e] & 0x7f800000u) == 0x7f800000u); } }
    if (bad) atomicOr(F.ctl + CW_DIAG + (F.dl ? 1 : 0), 1u << bit);
}
__device__ __forceinline__ void chk_finite_f32(const Frame& F, const float* p, size_t n, int bit) {
    bool bad = false;
    for (size_t i = (size_t)F.bid * NTHR + F.tid; i < n; i += (size_t)F.G * NTHR) bad |= !(fabsf(p[i]) < 1e30f);
    if (bad) atomicOr(F.ctl + CW_DIAG + (F.dl ? 1 : 0), 1u << bit);
}
#endif

typedef const __attribute__((address_space(4))) Args* ArgsP;
#define LAUNDER(p) asm volatile("" : "+s"(p))
#define PHASE_BEGIN_(DL) ArgsP a = ap; LAUNDER(a); unsigned char* ws = a->ws; (void)ws; Frame F = F0; asm volatile("" : "+v"(F.tid), "+v"(F.lane), "+s"(F.wave), "+s"(F.bid), "+s"(F.gw), "+s"(F.G), "+s"(F.ngw)); F.dl = (DL);
#define PHASE_BEGIN PHASE_BEGIN_(0)
#define IN(i) (a->in[i])
#define WSP(T, off) ((T*)(ws + (off)))

#define GRID_BAR() do { XcdBarrier b2_ = bar; asm volatile("" : "+s"(b2_.bar), "+s"(b2_.x)); xcd_barrier(b2_); } while (0)
template <int l> __device__ __forceinline__ void layer_fwd(const Frame& F0, ArgsP ap, const XcdBarrier& bar) {
        const int nrows_out = (l == 0) ? MALL : MLAT;
        const int nM = nrows_out / 256;
#define MODL (WSP(float, WS_MOD) + (size_t)l * 5 * 6144)
        { PHASE_BEGIN_(10 * l)
            SchedP S{WSP(bf16_t, WS_XN), WSP(bf16_t, WS_WIN_T) + (size_t)l * NINP * D, F.G, F.bid}; EpiStoreBf16 E{WSP(bf16_t, T_P), NINP}; pg8::gemm_phase(F.lds, S, E);
            { const int nlast = 132 * PN_FULL - (132 * PN_FULL / F.G) * F.G;
              if (nlast > 0 && F.bid >= nlast) ph_p_tailcols(F, WSP(bf16_t, WS_XN), WSP(bf16_t, WS_WIN_T) + (size_t)l * NINP * D, WSP(bf16_t, T_P), (F.bid - nlast) * NWAVES + F.wave, (F.G - nlast) * NWAVES);
              else if (nlast == 0) ph_p_tailcols(F, WSP(bf16_t, WS_XN), WSP(bf16_t, WS_WIN_T) + (size_t)l * NINP * D, WSP(bf16_t, T_P), F.gw, F.ngw); } }
        GRID_BAR();
#if DIAG
        { PHASE_BEGIN_(10 * l) chk_P(F, WSP(bf16_t, WS_XN), IN(8) + (size_t)l * D * NIN, WSP(bf16_t, T_P)); }
#endif
        { PHASE_BEGIN_(10 * l)
            PrepArgs pa{WSP(bf16_t, T_P), WSP(bf16_t, T_QA), WSP(bf16_t, T_KA), WSP(bf16_t, T_RQ), WSP(bf16_t, T_RK), WSP(bf16_t, T_CQN), WSP(bf16_t, T_CKVN), WSP(bf16_t, T_KC),
                        WSP(float, WS_RTAB), WSP(float, WS_TAB), WSP(float, WS_TAB) + 192 * 16 * 2, IN(10) + l * 256, IN(11) + l * 128};
            ph_prep(F, pa); }
#if DIAG
        GRID_BAR();
        { PHASE_BEGIN_(10 * l)
            PrepArgs pa{WSP(bf16_t, T_P), WSP(bf16_t, T_QA), WSP(bf16_t, T_KA), WSP(bf16_t, T_RQ), WSP(bf16_t, T_RK), WSP(bf16_t, T_CQN), WSP(bf16_t, T_CKVN), WSP(bf16_t, T_KC),
                        WSP(float, WS_RTAB), WSP(float, WS_TAB), WSP(float, WS_TAB) + 192 * 16 * 2, IN(10) + l * 256, IN(11) + l * 128};
            chk_prep(F, pa); }
#endif
#define RWF RwkvF{WSP(bf16_t, E_R), WSP(bf16_t, E_V), WSP(bf16_t, E_KF), WSP(bf16_t, E_KB), WSP(bf16_t, E_KK), WSP(bf16_t, E_BF), WSP(bf16_t, E_BB), WSP(bf16_t, E_EF), WSP(bf16_t, E_EB), WSP(bf16_t, E_G), WSP(float, E_BONUS)}
        { PHASE_BEGIN_(10 * l)
            RwkvW rw{IN(14) + l * 1152, IN(15) + l * 512, IN(17) + l * 512, IN(20) + l * 256, IN(21) + l * 256, IN(22) + l * 256,
                     WSP(bf16_t, WS_RWUP_T) + (size_t)l * 2 * 256 * 64, WSP(bf16_t, WS_RAUP_T) + (size_t)l * 2 * 256 * 64, WSP(bf16_t, WS_RGUP_T) + (size_t)l * 256 * 128};
            ph_rwkv_featX(F, WSP(bf16_t, T_P), rw, RWF); }
        GRID_BAR();
        { PHASE_BEGIN_(10 * l) ph_mla_proj(F, WSP(bf16_t, T_CQN), WSP(bf16_t, T_CKVN), WSP(bf16_t, WS_WUQ_T) + (size_t)l * 384 * 256, WSP(bf16_t, WS_WUKV_T) + (size_t)l * 512 * 128,
                                  WSP(float, WS_TAB) + 192 * 16 * 2, WSP(bf16_t, T_QC), WSP(bf16_t, T_KC), WSP(bf16_t, T_VC)); }
        { PHASE_BEGIN_(10 * l)
            RwkvW rw{IN(14) + l * 1152, IN(15) + l * 512, IN(17) + l * 512, IN(20) + l * 256, IN(21) + l * 256, IN(22) + l * 256,
                     WSP(bf16_t, WS_RWUP_T) + (size_t)l * 2 * 256 * 64, WSP(bf16_t, WS_RAUP_T) + (size_t)l * 2 * 256 * 64, WSP(bf16_t, WS_RGUP_T) + (size_t)l * 256 * 128};
            ph_rwkv_featY(F, WSP(bf16_t, T_P), rw, RWF); }
        GRID_BAR();
#if DIAG
        { PHASE_BEGIN_(10 * l) chk_rwkv_feat(F, WSP(bf16_t, T_P), IN(14) + l * 1152, IN(15) + l * 512, IN(16) + (size_t)l * 2 * 64 * 256, IN(17) + l * 512, IN(18) + (size_t)l * 2 * 64 * 256, IN(19) + (size_t)l * 128 * 256,
                                    IN(20) + l * 256, IN(21) + l * 256, IN(22) + l * 256, RWF); }
        { PHASE_BEGIN_(10 * l) chk_proj(F, WSP(bf16_t, T_CQN), WSP(bf16_t, T_CKVN), IN(12) + (size_t)l * 256 * 384, IN(13) + (size_t)l * 128 * 512, WSP(bf16_t, T_QC), WSP(bf16_t, T_KC), WSP(bf16_t, T_VC)); }
#endif
#define RETZ WSP(bf16_t, T_RQ)
        { PHASE_BEGIN_(10 * l) ph_rwkv_w1(F, RWF, WSP(bf16_t, T_PZ), ws); }
        { PHASE_BEGIN_(10 * l) ph_ret_r1(F, WSP(bf16_t, T_P), WSP(float, WS_RTAB), RETZ); }
        GRID_BAR();
#if DIAG
        { PHASE_BEGIN_(10 * l) const u32x4* q = WSP(u32x4, T_PZ); bool left = false;
            for (size_t i = (size_t)F.bid * NTHR + F.tid; i < PZ_BYTES / 16; i += (size_t)F.G * NTHR) { const u32x4 w = q[i]; left |= (w.x == 0x12341234u) & (w.y == 0x12341234u) & (w.z == 0x12341234u) & (w.w == 0x12341234u); }
            if (left) atomicOr(F.ctl + CW_DIAG + 3, 1u << 9); }
        { PHASE_BEGIN_(10 * l) chk_finite(F, WSP(bf16_t, T_PZ), (size_t)32 * NCHUNK * 8192, 13); chk_finite(F, RETZ, (size_t)32 * NCHUNK * 8192, 14);
                               for (int q = 0; q < 10; ++q) chk_finite(F, WSP(bf16_t, E_R) + (size_t)q * MALL * 256, (size_t)MALL * 256, 3 + q);
                               chk_finite(F, WSP(bf16_t, T_P), (size_t)MALL * NINP, 2); chk_finite_f32(F, WSP(float, WS_H), (size_t)MALL * D, 0); }
        GRID_BAR();
#endif
        { PHASE_BEGIN_(10 * l) ph_rwkv_w2(F, WSP(bf16_t, T_PZ)); __syncthreads(); }
        { PHASE_BEGIN_(10 * l)
            if (F.bid >= 64) { LAS float* scr = (LAS float*)(F.lds + F.wave * 16384); const int gw_ = (F.bid - 64) * NWAVES + F.wave, ngw_ = (F.G - 64) * NWAVES;
                TR_BATCH_W(gw_, ngw_, IN(31) + (size_t)l * 64 * D * 512, (size_t)D * 512, NE0, D, 512, WSP(bf16_t, T_EW0), (size_t)1024 * D, D, 0, 1);
                TR_BATCH_W(gw_, ngw_, IN(32) + (size_t)l * 64 * D * 512, (size_t)D * 512, NE0, D, 512, WSP(bf16_t, T_EW0), (size_t)1024 * D, D, 0, 2);
                TR_BATCH_W(gw_, ngw_, IN(33) + (size_t)l * 64 * 512 * D, (size_t)512 * D, NE0, 512, D, WSP(bf16_t, T_EW0D), (size_t)1024 * 512, 512, 0, 0); }
            __syncthreads(); }
        { PHASE_BEGIN_(10 * l) ph_ret_r2(F, RETZ); }
        { PHASE_BEGIN_(10 * l) ph_attn_window(F, WSP(bf16_t, T_QA), WSP(bf16_t, T_KA), WSP(bf16_t, T_P), IN(9) + l * 4, WSP(bf16_t, T_YB), l == 0); }
        { PHASE_BEGIN_(10 * l) ph_attn_mla(F, WSP(bf16_t, T_QC), WSP(bf16_t, T_KC), WSP(bf16_t, T_VC), WSP(bf16_t, T_YB), l == 0); }
        GRID_BAR();
#if DIAG
        { PHASE_BEGIN_(10 * l) chk_finite(F, WSP(bf16_t, T_PZ), (size_t)32 * NCHUNK * 8192, 15); chk_finite(F, RETZ, (size_t)32 * NCHUNK * 8192, 16); }
        GRID_BAR();
#endif
        { PHASE_BEGIN_(10 * l) ph_rwkv_w3(F, RWF, WSP(bf16_t, T_PZ), WSP(bf16_t, T_RWY), ws); }
        { PHASE_BEGIN_(10 * l) ph_ret_r3(F, WSP(bf16_t, T_P), WSP(float, WS_RTAB), RETZ, WSP(bf16_t, T_RETY)); }

        GRID_BAR();
#if DIAG
        { PHASE_BEGIN_(10 * l) chk_attn_window(F, WSP(bf16_t, T_QA), WSP(bf16_t, T_KA), WSP(bf16_t, T_P), IN(9) + l * 4, WSP(bf16_t, T_YB), l == 0); }
        { PHASE_BEGIN_(10 * l) chk_attn_mla(F, WSP(bf16_t, T_QC), WSP(bf16_t, T_KC), WSP(bf16_t, T_VC), WSP(bf16_t, T_YB), l == 0); }
#endif
        { PHASE_BEGIN_(10 * l) ph_rwkv_combine(F, WSP(bf16_t, T_RWY), RWF, IN(23) + l * 256, IN(24) + l * 256, WSP(bf16_t, T_YB), nrows_out); }
        { PHASE_BEGIN_(10 * l) ph_ret_combine(F, WSP(bf16_t, T_P), WSP(bf16_t, T_RETY), WSP(bf16_t, T_YB), nrows_out); }
        GRID_BAR();
        { PHASE_BEGIN_(10 * l)
            SchedMerge S{WSP(bf16_t, T_YB), WSP(bf16_t, WS_XN), WSP(bf16_t, WS_WB_T) + (size_t)l * 4 * D * 256, WSP(bf16_t, WS_WG_T) + (size_t)l * 4096 * D, l == 0 ? 64 : 0, F.G, F.bid};
            EpiMerge E{WSP(bf16_t, T_BOUT), WSP(bf16_t, T_ACC), IN(26) + (size_t)l * 4096};
            pg8::gemm_phase<EpiMerge, SchedMerge, false, true>(F.lds, S, E); }
        GRID_BAR();
        if (l == 0) { { PHASE_BEGIN_(10 * l) ph_sum4(F, WSP(bf16_t, T_BOUT), WSP(bf16_t, T_ACC), MLAT, MCTX); }
            GRID_BAR(); }
        { PHASE_BEGIN_(10 * l)
            SchedOut S{WSP(bf16_t, T_ACC), WSP(bf16_t, WS_WO_T) + (size_t)l * D * D, nM, F.G, F.bid}; EpiResid E{WSP(float, WS_H), MODL + 2 * D, l == 0 ? IN(0) : nullptr, IN(2)}; pg8::gemm_phase(F.lds, S, E); }
        GRID_BAR();
#if DIAG
        if (l == 0) { PHASE_BEGIN_(10 * l) chk_out(F, WSP(bf16_t, T_ACC), IN(28) + (size_t)l * D * D, MODL, IN(0), WSP(float, WS_H)); }
        GRID_BAR();
#endif
#define MOE_CNT (F.ctl + CW_CNT + l * 64 * CNT_STRIDE)
        { PHASE_BEGIN_(10 * l)
            LAS float* scr = (LAS float*)(F.lds + F.wave * 16384);
            TR_BATCH(IN(31) + ((size_t)l * 64 + NE0) * D * 512, (size_t)D * 512, 64 - NE0, D, 512, WSP(bf16_t, E_WGU) + (size_t)NE0 * 1024 * D, (size_t)1024 * D, D, 0, 1);
            TR_BATCH(IN(32) + ((size_t)l * 64 + NE0) * D * 512, (size_t)D * 512, 64 - NE0, D, 512, WSP(bf16_t, E_WGU) + (size_t)NE0 * 1024 * D, (size_t)1024 * D, D, 0, 2);
            TR_BATCH(IN(33) + ((size_t)l * 64 + NE0) * 512 * D, (size_t)512 * D, 64 - NE0, 512, D, WSP(bf16_t, E_WD) + (size_t)NE0 * 1024 * 512, (size_t)1024 * 512, 512, 0, 0);
            __syncthreads();
            ph_moe_route(F, WSP(float, WS_H), MODL, WSP(float, WS_GS2) + (size_t)l * 5 * 1024, WSP(bf16_t, WS_RWHI), WSP(bf16_t, WS_RWLO), IN(30), WSP(bf16_t, WS_XN), MOE_CNT, WSP(int, T_TOKE), WSP(int, T_TOKP), WSP(float, T_TOKW), nrows_out); }
        GRID_BAR();
        { PHASE_BEGIN_(10 * l) moe_table(F, MOE_CNT);
            ph_moe_rowtok(F, MOE_CNT, WSP(int, T_TOKE), WSP(int, T_TOKP), WSP(int, T_ROWTOK), nrows_out); }
        GRID_BAR();
        { PHASE_BEGIN_(10 * l)
            SchedGU S{WSP(bf16_t, WS_XN), WSP(bf16_t, E_WGU), WSP(bf16_t, T_EW0), (const LAS int*)(F.lds + MOE_TAB_OFF), WSP(int, T_ROWTOK), F.G, F.bid}; EpiSwiGLU E{WSP(bf16_t, T_HID)}; pg8::gemm_phase<EpiSwiGLU, SchedGU, true>(F.lds, S, E); }
        GRID_BAR();
        { PHASE_BEGIN_(10 * l)
            SchedDown S{WSP(bf16_t, T_HID), WSP(bf16_t, E_WD), WSP(bf16_t, T_EW0D), (const LAS int*)(F.lds + MOE_TAB_OFF), F.G, F.bid}; EpiStoreBf16 E{WSP(bf16_t, T_Y), D}; pg8::gemm_phase(F.lds, S, E); }
        GRID_BAR();
#if DIAG
        { PHASE_BEGIN_(10 * l) chk_moe(F, WSP(bf16_t, WS_XN), IN(29), IN(30), IN(31) + (size_t)l * 64 * D * 512, IN(32) + (size_t)l * 64 * D * 512, IN(33) + (size_t)l * 64 * 512 * D,
                              WSP(int, T_TOKE), WSP(int, T_TOKP), WSP(float, T_TOKW), WSP(bf16_t, T_Y), nrows_out); }
#endif
        { PHASE_BEGIN_(10 * l) ph_moe_combine_norm<l == 1>(F, WSP(float, WS_H), MODL, WSP(bf16_t, T_Y), WSP(int, T_TOKE), WSP(int, T_TOKP), WSP(float, T_TOKW), nrows_out,
                                                          l == 1 ? IN(34) : IN(6) + D, WSP(float, WS_MOD) + (size_t)5 * 6144, WSP(bf16_t, WS_XN), a->out); }
        if (l == 0) GRID_BAR();
}

__global__ void __launch_bounds__(NTHR, 2) mega_fwd(Args args_unused) {
    extern __shared__ __attribute__((aligned(16))) unsigned char lds_raw[];
    ArgsP ap = (ArgsP)__builtin_amdgcn_kernarg_segment_ptr();
    Frame F0;
    F0.lds = (LAS unsigned char*)lds_raw;
    F0.tid = threadIdx.x; F0.lane = F0.tid & 63; F0.wave = __builtin_amdgcn_readfirstlane(F0.tid >> 6);
    F0.G = gridDim.x; F0.bid = blockIdx.x;
    F0.gw = F0.bid * NWAVES + F0.wave; F0.ngw = F0.G * NWAVES;
    F0.ctl = (unsigned*)(ap->ws + WS_CTL);
    volatile LAS unsigned* MISC = (volatile LAS unsigned*)(F0.lds + MISC_OFF);
    for (int u = F0.tid; u < (LDS_BYTES - LDSCTL_OFF) / 4; u += NTHR) ((LAS unsigned*)(F0.lds + LDSCTL_OFF))[u] = 0u;
    __syncthreads();
    XcdBarrier bar = xcd_barrier_post(F0.ctl + CW_BAR, MISC + 8);

    { PHASE_BEGIN
        ph_mod(F, IN(1), IN(3), IN(4), IN(5), WSP(float, WS_MOD));
        ph_tables(F, WSP(float, WS_RTAB), WSP(float, WS_TAB), WSP(float, WS_TAB) + 192 * 16 * 2);
        ph_router_tables(F, IN(29), WSP(bf16_t, WS_RWHI), WSP(bf16_t, WS_RWLO));
        LAS float* scr = (LAS float*)(F.lds + F.wave * 16384);
        TR_BATCH(IN(8), (size_t)D * NIN, 2, D, NIN, WSP(bf16_t, WS_WIN_T), (size_t)NINP * D, D, 0, 0);
        for (int l = 0; l < 2; ++l) ph_zero16(F, WSP(bf16_t, WS_WIN_T) + ((size_t)l * NINP + NIN) * D, (size_t)(NINP - NIN) * D * 2);
        TR_BATCH(IN(25), (size_t)D * D, 8, D, D, WSP(bf16_t, WS_WG_T), (size_t)D * D, D, 0, 0);
        TR_BATCH(IN(27), (size_t)256 * D, 8, 256, D, WSP(bf16_t, WS_WB_T), (size_t)D * 256, 256, 0, 0);
        TR_BATCH(IN(28), (size_t)D * D, 2, D, D, WSP(bf16_t, WS_WO_T), (size_t)D * D, D, 0, 0);
        TR_BATCH(IN(12), (size_t)256 * 384, 2, 256, 384, WSP(bf16_t, WS_WUQ_T), (size_t)384 * 256, 256, 0, 0);
        TR_BATCH(IN(13), (size_t)128 * 512, 2, 128, 512, WSP(bf16_t, WS_WUKV_T), (size_t)512 * 128, 128, 0, 0);
        TR_BATCH(IN(16), (size_t)64 * 256, 4, 64, 256, WSP(bf16_t, WS_RWUP_T), (size_t)256 * 64, 64, 0, 0);
        TR_BATCH(IN(18), (size_t)64 * 256, 4, 64, 256, WSP(bf16_t, WS_RAUP_T), (size_t)256 * 64, 64, 0, 0);
        TR_BATCH(IN(19), (size_t)128 * 256, 2, 128, 256, WSP(bf16_t, WS_RGUP_T), (size_t)256 * 128, 128, 0, 0);
    }
    GRID_BAR();

    { PHASE_BEGIN ph_copy_h_adaln(F, IN(0), IN(2), WSP(float, WS_H), IN(6), WSP(float, WS_MOD), WSP(bf16_t, WS_XN)); ph_gs2(F, IN(7), WSP(float, WS_MOD), WSP(float, WS_GS2)); }
    GRID_BAR();
    layer_fwd<0>(F0, ap, bar);
    layer_fwd<1>(F0, ap, bar);
#if DIAG
    GRID_BAR();
    { PHASE_BEGIN ph_final(F, IN(0), IN(34), a->out); }
#endif
}

extern "C" void kernel_launch(void* const* d_in, const int* in_sizes, int n_in, void* d_out, int out_size, void* d_ws, size_t ws_size, hipStream_t stream) {
    static int grid = 0;
    if (grid == 0) {
        if (n_in != 35 || out_size != MLAT * D || ws_size < WS_END) { fprintf(stderr, "kernel_launch: unexpected sizes n_in %d out %d ws %zu\n", n_in, out_size, ws_size); grid = -1; return; }
        int dev = 0, cus = 0, per_cu = 0;
        if (hipGetDevice(&dev) != hipSuccess || hipDeviceGetAttribute(&cus, hipDeviceAttributeMultiprocessorCount, dev) != hipSuccess) { grid = -1; return; }
        if (hipFuncSetAttribute((const void*)mega_fwd, hipFuncAttributeMaxDynamicSharedMemorySize, LDS_BYTES) != hipSuccess) { fprintf(stderr, "kernel_launch: hipFuncSetAttribute failed\n"); grid = -1; return; }
        if (hipOccupancyMaxActiveBlocksPerMultiprocessor(&per_cu, (const void*)mega_fwd, NTHR, LDS_BYTES) != hipSuccess || per_cu < 1)
            fprintf(stderr, "kernel_launch: occupancy query reports %d\n", per_cu);
        (void)hipGetLastError();
        grid = cus;
    }
    if (grid < 0) return;
    if (hipMemsetAsync((char*)d_ws + WS_CTL, 0, CTL_BYTES, stream) != hipSuccess) return;
    Args a{};
    for (int i = 0; i < 35; ++i) a.in[i] = (const float*)d_in[i];
    a.out = (float*)d_out; a.ws = (unsigned char*)d_ws; a.ph_lo = 0; a.ph_hi = 1000;
    hipLaunchKernelGGL(mega_fwd, dim3(grid), dim3(NTHR), LDS_BYTES, stream, a);
}
```

```cpp
#include <hip/hip_runtime.h>
#include <cstdio>
#include <cstdint>

constexpr int D = 1024, NB = 4, SEQ = 8192, CTXL = 256, DEPTH = 2;
constexpr int MLAT = NB * SEQ;
constexpr int MCTX = NB * CTXL;
constexpr int MALL = MLAT + MCTX;
constexpr int NIN = 3360, NINP = 3584;
constexpr float NORM_EPS = 1e-6f;

constexpr size_t MiB = 1u << 20;
constexpr size_t WS_CTL = 0, CTL_BYTES = 1 * MiB;
constexpr size_t WS_MOD = 1 * MiB;
constexpr size_t WS_TAB = WS_MOD + 512 * 1024;
constexpr size_t WS_SMALLW = 2 * MiB;
constexpr size_t WS_WUQ_T = WS_SMALLW;
constexpr size_t WS_WUKV_T = WS_WUQ_T + 2 * 384 * 256 * 2;
constexpr size_t WS_RWUP_T = WS_WUKV_T + 2 * 512 * 128 * 2;
constexpr size_t WS_RAUP_T = WS_RWUP_T + 2 * 2 * 256 * 64 * 2;
constexpr size_t WS_RGUP_T = WS_RAUP_T + 2 * 2 * 256 * 64 * 2;
static_assert(WS_RGUP_T + 2 * 256 * 128 * 2 <= 3 * MiB, "smallw");
constexpr size_t WS_RTAB = 3 * MiB;
constexpr size_t WS_RWHI = 5 * MiB + 256 * 1024;
constexpr size_t WS_RWLO = WS_RWHI + 128 * 1024;
constexpr size_t WS_GS2 = WS_MOD + 256 * 1024;
constexpr size_t WS_WIN_T = 6 * MiB;
constexpr size_t WS_WG_T = 20 * MiB;
constexpr size_t WS_WB_T = 36 * MiB;
constexpr size_t WS_WO_T = 40 * MiB;
constexpr size_t WS_H = 44 * MiB;
constexpr size_t WS_XN = 176 * MiB;
constexpr size_t WS_E = 242 * MiB;
constexpr size_t WS_T = 434 * MiB;
constexpr size_t WS_END = 1024 * MiB;
constexpr size_t E_STRIDE = (size_t)MALL * 256 * 2;
constexpr size_t E_R = WS_E, E_V = E_R + E_STRIDE, E_KF = E_V + E_STRIDE, E_KB = E_KF + E_STRIDE, E_KK = E_KB + E_STRIDE, E_BF = E_KK + E_STRIDE, E_BB = E_BF + E_STRIDE,
                 E_EF = E_BB + E_STRIDE, E_EB = E_EF + E_STRIDE, E_G = E_EB + E_STRIDE, E_BONUS = E_G + E_STRIDE;
static_assert(E_BONUS + (size_t)MALL * 4 * 4 <= WS_T, "E map");
static_assert(true, "");
constexpr size_t T_P = WS_T;
constexpr size_t T_QA = T_P + (size_t)MALL * NINP * 2;
constexpr size_t T_KA = T_QA + (size_t)MALL * 256 * 2;
constexpr size_t T_QC = T_KA + (size_t)MALL * 128 * 2;
constexpr size_t T_KC = T_QC + (size_t)MALL * 384 * 2;
constexpr size_t T_VC = T_KC + (size_t)MALL * 384 * 2;
constexpr size_t T_CQN = T_VC + (size_t)MALL * 256 * 2;
constexpr size_t T_CKVN = T_CQN + (size_t)MALL * 256 * 2;
constexpr size_t T_RQ = T_CKVN + (size_t)MALL * 128 * 2;
constexpr size_t T_RK = T_RQ + (size_t)MALL * 256 * 2;
static_assert((size_t)32 * 132 * 4096 * 2 <= (size_t)2 * MALL * 256 * 2, "retention chunk data fits the RQ | RK area");
constexpr size_t T_RETY = T_QC;
constexpr size_t T_RWY = T_RETY + (size_t)2 * MALL * 256 * 2;
static_assert(T_RWY + (size_t)2 * MALL * 256 * 2 <= T_CQN, "scan outputs fit QC | KC | VC");
constexpr int NE0 = 22;
constexpr size_t T_EW0 = T_RK + (size_t)MALL * 256 * 2;
constexpr size_t T_EW0D = T_EW0 + (size_t)NE0 * 1024 * 1024 * 2;
constexpr size_t T_PZ = T_EW0 + (size_t)4 * MALL * 256 * 2;
constexpr int NCHUNK = 132;
constexpr size_t PZ_BYTES = (size_t)32 * NCHUNK * 8192 * 2;
constexpr size_t T_REF = T_PZ + PZ_BYTES;
constexpr size_t T_YB = WS_T + 524 * MiB;
static_assert(T_REF + (size_t)8 * 8448 * 64 * 2 <= T_YB, "PZ map");
static_assert(T_EW0D + (size_t)NE0 * 1024 * 512 * 2 <= T_PZ && T_YB + (size_t)MALL * D * 2 <= WS_END, "T map");
constexpr size_t T_BOUT = WS_T;
constexpr size_t T_ACC = T_BOUT + (size_t)MALL * 4096 * 2;
static_assert(T_ACC + (size_t)MALL * D * 2 <= T_YB, "merge map");

constexpr int XB_ROWS = (264 + 64) * 256;
constexpr size_t T_HID = WS_T;
constexpr size_t T_Y = T_HID + (size_t)XB_ROWS * 512 * 2;
constexpr size_t T_TOKE = T_Y + (size_t)XB_ROWS * 1024 * 2;
constexpr size_t T_TOKP = T_TOKE + (size_t)MALL * 8;
constexpr size_t T_TOKW = T_TOKP + (size_t)MALL * 8;
constexpr size_t T_ROWTOK = T_TOKW + (size_t)MALL * 8;
static_assert(T_ROWTOK + (size_t)XB_ROWS * 4 <= T_EW0, "moe map");
constexpr size_t E_WGU = WS_E;
constexpr size_t E_WD = E_WGU + (size_t)64 * 1024 * 1024 * 2;
static_assert(E_WD + (size_t)64 * 1024 * 512 * 2 <= WS_T, "E moe map");

constexpr int CW_BAR = 4096;
constexpr int CW_CNT = 65536, CNT_STRIDE = 64;

#define GAS __attribute__((address_space(1)))
#define LAS __attribute__((address_space(3)))
typedef unsigned short bf16_t;
typedef float f32x4 __attribute__((ext_vector_type(4)));
typedef float f32x16 __attribute__((ext_vector_type(16)));
typedef short bf16x8 __attribute__((ext_vector_type(8)));
typedef unsigned u32x4 __attribute__((ext_vector_type(4)));
typedef unsigned u32x2 __attribute__((ext_vector_type(2)));

__device__ __forceinline__ float bf2f(bf16_t b) { return __uint_as_float(((unsigned)b) << 16); }
typedef float f32x2_hw __attribute__((ext_vector_type(2)));
typedef __bf16 bf16x2_hw __attribute__((ext_vector_type(2)));
__device__ __forceinline__ unsigned pk2(float lo, float hi) { const f32x2_hw v = {lo, hi}; const bf16x2_hw b = __builtin_convertvector(v, bf16x2_hw); return __builtin_bit_cast(unsigned, b); }
__device__ __forceinline__ unsigned f2bf(float f) { return pk2(f, 0.f) & 0xffffu; }
__device__ __forceinline__ float wave_sum(float v) {
#pragma unroll
    for (int o = 1; o < 64; o <<= 1) v += __shfl_xor(v, o);
    return v;
}

__device__ __forceinline__ float grp16_sum(float v) { v += __shfl_xor(v, 1); v += __shfl_xor(v, 2); v += __shfl_xor(v, 4); v += __shfl_xor(v, 8); return v; }
__device__ __forceinline__ int crow(int r, int hi) { return (r & 3) + 8 * (r >> 2) + 4 * hi; }

#define XB_TMO      128
#define XB_XCNT(j)  (256  + 64 * (j))
#define XB_XSUB(j)  (1280 + 64 * (j))
#define XB_XGEN(j)  (2304 + 64 * (j))
#define XB_TOP      3328
#define XB_TOPGEN   3392
#define XCD_BAR_WORDS 3456
#define XB_SPIN_CAP (1u << 18)

__device__ __forceinline__ unsigned xb_ld(unsigned* p)              { return __hip_atomic_load(p, __ATOMIC_RELAXED, __HIP_MEMORY_SCOPE_AGENT); }
__device__ __forceinline__ unsigned xb_add(unsigned* p, unsigned v) { return __hip_atomic_fetch_add(p, v, __ATOMIC_RELAXED, __HIP_MEMORY_SCOPE_AGENT); }
__device__ __forceinline__ unsigned xb_xcc_id() { return (unsigned)__builtin_amdgcn_s_getreg((3 << 11) | 20) & 0xFu; }
#define XB_SPIN(cond, bar) do { unsigned _sp = 0; while (cond) { __builtin_amdgcn_s_sleep(1); \
    if ((++_sp & 255u) == 0u) { if (xb_ld(&(bar)[XB_TMO])) break; if (_sp > XB_SPIN_CAP) { atomicAdd(&(bar)[XB_TMO], 1u); break; } } } } while (0)

struct XcdBarrier { unsigned* bar; unsigned x; volatile LAS unsigned* st; };

__device__ __forceinline__ XcdBarrier xcd_barrier_post(unsigned* bar, volatile LAS unsigned* st) {
    XcdBarrier b; b.bar = bar; b.x = xb_xcc_id(); b.st = st;
    if (threadIdx.x == 0) (void)xb_add(&bar[XB_XCNT(b.x)], 1u);
    return b;
}
__device__ __forceinline__ void xcd_barrier_complete(unsigned* bar, unsigned x, unsigned& nloc, unsigned& nx) {
    const unsigned G = gridDim.x * gridDim.y * gridDim.z;
    unsigned sum, cnt, mine, sp = 0u;
    for (;;) {
        sum = 0u; cnt = 0u; mine = 0u;
#pragma unroll
        for (unsigned j = 0; j < 16; ++j) { const unsigned c = xb_ld(&bar[XB_XCNT(j)]); sum += c; cnt += (c > 0u) ? 1u : 0u; mine = (j == x) ? c : mine; }
        if (sum == G) break;
        __builtin_amdgcn_s_sleep(1);
        if ((++sp & 255u) == 0u) { if (xb_ld(&bar[XB_TMO])) break; if (sp > XB_SPIN_CAP) { atomicAdd(&bar[XB_TMO], 1u); break; } }
    }
    nloc = mine > 0u ? mine : 1u; nx = cnt > 0u ? cnt : 1u;
}
__device__ __forceinline__ void xcd_barrier(const XcdBarrier& b) {
    asm volatile("s_waitcnt vmcnt(0)" ::: "memory");
    __syncthreads();
    if (threadIdx.x == 0) {
        unsigned* bar = b.bar;
        __builtin_amdgcn_s_waitcnt(0);
        unsigned nloc = b.st[0], nx = b.st[1];
        if (nloc == 0u) { xcd_barrier_complete(bar, b.x, nloc, nx); b.st[0] = nloc; b.st[1] = nx; }
        const unsigned old = xb_add(&bar[XB_XSUB(b.x)], 1u);
        const unsigned gen = old / nloc;
        if (old + 1u == (gen + 1u) * nloc) {
            __builtin_amdgcn_fence(__ATOMIC_RELEASE, "agent");
            asm volatile("s_waitcnt vmcnt(0)" ::: "memory");
            const unsigned og = xb_add(&bar[XB_TOP], 1u);
            const unsigned tg = og / nx;
            if (og + 1u == (tg + 1u) * nx) xb_add(&bar[XB_TOPGEN], 1u);
            else XB_SPIN(xb_ld(&bar[XB_TOPGEN]) == tg, bar);
            __builtin_amdgcn_fence(__ATOMIC_ACQUIRE, "agent");
            xb_add(&bar[XB_XGEN(b.x)], 1u);
            asm volatile("s_waitcnt vmcnt(0)" ::: "memory");
        } else {
            XB_SPIN(xb_ld(&bar[XB_XGEN(b.x)]) == gen, bar);
            __builtin_amdgcn_fence(__ATOMIC_ACQUIRE, "agent");
            asm volatile("s_waitcnt vmcnt(0)" ::: "memory");
        }
    }
    __syncthreads();
}


namespace pg8 {
constexpr int BM = 256, BK = 64, HALF = 128, HTB = HALF * BK * 2, STAGE_BYTES = 8 * HTB;
__host__ __device__ __forceinline__ int lds_byte(int r, int c) { const int st = (r >> 4) * 2 + (c >> 5), rr = r & 15, cc = c & 31, ob = rr * 64 + cc * 2; return st * 1024 + (ob ^ (((ob >> 9) & 1) << 5)); }
__host__ __device__ __forceinline__ void stage_rc(int b, int& R, int& C) { const int st = b / 1024, sb = b % 1024, swz = sb ^ (((sb >> 9) & 1) << 5); R = (st >> 1) * 16 + swz / 64; C = (st & 1) * 32 + (swz % 64) / 2; }
__host__ __device__ __forceinline__ int perm32(int rho) { const int n = rho >> 4, i = rho & 15; return 8 * (i >> 2) + 4 * n + (i & 3); }
struct Unit { const bf16_t* A; const bf16_t* B; int u0, u1, u2, u3; };
typedef float f32x2_cv __attribute__((ext_vector_type(2))); typedef __bf16 bf16x2_cv __attribute__((ext_vector_type(2)));
__device__ __forceinline__ unsigned cvt_pk_bf16(float lo, float hi) { const f32x2_cv v = {lo, hi}; const bf16x2_cv b = __builtin_convertvector(v, bf16x2_cv); return __builtin_bit_cast(unsigned, b); }

template <class Epi, class Sched, bool GA = false, bool MIX = false>
__device__ __forceinline__ void gemm_phase(LAS unsigned char* lds, const Sched& S, const Epi& E) {
    int tid = threadIdx.x; asm volatile("" : "+v"(tid));
    const int wid = __builtin_amdgcn_readfirstlane(tid >> 6), lane = tid & 63, wr = wid >> 2, wc = wid & 3, fr = lane & 15, fq = lane >> 4;
    int lda, ldb, ntc;
    if constexpr (MIX) { lda = Sched::lda; ldb = Sched::ldb0; ntc = Sched::K0 / BK; } else { lda = S.lda; ldb = S.ldb; ntc = S.K / BK; }
    unsigned voffA[2], voffB[2]; int gR[2], gC[2], gRb[2];
#pragma unroll
    for (int i = 0; i < 2; ++i) { int R, C; stage_rc(tid * 16 + i * 8192, R, C); const int Rb = Epi::PERM ? ((R & ~31) + perm32(R & 31)) : R;
        voffA[i] = (unsigned)(R * lda + C) * 2u; voffB[i] = (unsigned)(Rb * ldb + C) * 2u; gR[i] = R; gC[i] = C; gRb[i] = Rb; }
    unsigned cvB[2] = {voffB[0], voffB[1]}, nvB[2] = {voffB[0], voffB[1]};
#define PG8_KIND_B(u, vB, hB, ntv) do { if constexpr (MIX) { const int ld_ = (u).u3 ? Sched::ldb1 : Sched::ldb0; \
        _Pragma("unroll") for (int _i = 0; _i < 2; ++_i) vB[_i] = (unsigned)(gRb[_i] * ld_ + gC[_i]) * 2u; hB = (size_t)HALF * ld_ * 2; ntv = ((u).u3 ? Sched::K1 : Sched::K0) / BK; } } while (0)
    unsigned vg0[2] = {0u, 0u}, vg1[2] = {0u, 0u}, nvg0[2] = {0u, 0u}, nvg1[2] = {0u, 0u};
#define PG8_GOFF(u, o0, o1) do { _Pragma("unroll") for (int _i = 0; _i < 2; ++_i) { const int t0_ = S.rowtok[(u).u0 + gR[_i]], t1_ = S.rowtok[(u).u0 + HALF + gR[_i]]; \
        o0[_i] = (unsigned)(t0_ * lda + gC[_i]) * 2u; o1[_i] = (unsigned)(t1_ * lda + gC[_i]) * 2u; } } while (0)
    const size_t kstep = (size_t)(BK * 2);
    const size_t hsA = (size_t)HALF * lda * 2, hsB = (size_t)HALF * ldb * 2; size_t chsB = hsB, nhsB = hsB; int nt = ntc, ntn = ntc;
    const unsigned ldsw = (unsigned)wid * 1024u;
    const int aoff = lds_byte(wr * 64 + fr, fq * 8), boff = lds_byte(wc * 32 + fr, fq * 8);
#define PG8_SA(b, h) (((b) * 2 + (h)) * HTB)
#define PG8_SB(b, h) ((4 + (b) * 2 + (h)) * HTB)
#define PG8_STAGE(bufoff, gbase, voff) do { _Pragma("unroll") for (int _i = 0; _i < 2; ++_i) \
        __builtin_amdgcn_global_load_lds((const unsigned*)((const char*)(gbase) + (voff)[_i]), (LAS unsigned*)(lds + (bufoff) + ldsw + _i * 8192), 16, 0, 0); } while (0)
#define PG8_LDA(dst, b, h) do { _Pragma("unroll") for (int m = 0; m < 4; ++m) _Pragma("unroll") for (int k = 0; k < 2; ++k) dst[m][k] = *(const LAS bf16x8*)(lds + PG8_SA(b, h) + aoff + m * 2048 + k * 1024); } while (0)
#define PG8_LDB(dst, b, h) do { _Pragma("unroll") for (int n = 0; n < 2; ++n) _Pragma("unroll") for (int k = 0; k < 2; ++k) dst[n][k] = *(const LAS bf16x8*)(lds + PG8_SB(b, h) + boff + n * 2048 + k * 1024); } while (0)
#define PG8_MMA(ai, bj, At, Bt) do { __builtin_amdgcn_s_setprio(1); _Pragma("unroll") for (int m = 0; m < 4; ++m) _Pragma("unroll") for (int n = 0; n < 2; ++n) _Pragma("unroll") for (int k = 0; k < 2; ++k) \
        acc[ai][bj][m][n] = __builtin_amdgcn_mfma_f32_16x16x32_bf16(Bt[n][k], At[m][k], acc[ai][bj][m][n], 0, 0, 0); __builtin_amdgcn_s_setprio(0); } while (0)
#define PG8_WAIT_V(n) asm volatile("s_waitcnt vmcnt(" #n ")" ::: "memory")
#define PG8_WAIT_L(n) asm volatile("s_waitcnt lgkmcnt(" #n ")" ::: "memory")
#define PG8_BAR __builtin_amdgcn_s_barrier()
#define PG8_SCHED __builtin_amdgcn_sched_barrier(0)
    Unit cur, nxt; int ui = 0;
    if (!S.next(0, cur)) return;
    f32x4 acc[2][2][4][2];
#pragma unroll
    for (int a = 0; a < 2; ++a)
#pragma unroll
        for (int b = 0; b < 2; ++b)
#pragma unroll
            for (int m = 0; m < 4; ++m)
#pragma unroll
                for (int n = 0; n < 2; ++n) acc[a][b][m][n] = (f32x4){0.f, 0.f, 0.f, 0.f};
    bf16x8 At[4][2], B0[2][2], B1[2][2];
    const char* cA = (const char*)cur.A; const char* cB = (const char*)cur.B;
    if constexpr (GA) { PG8_GOFF(cur, vg0, vg1); }
    PG8_KIND_B(cur, cvB, chsB, nt);
#define PG8_STAGE_A(bufoff, gbase, h, o0, o1) do { if constexpr (GA) { if ((h) == 0) PG8_STAGE(bufoff, gbase, o0); else PG8_STAGE(bufoff, gbase, o1); } \
        else PG8_STAGE(bufoff, (gbase) + ((h) ? hsA : 0), voffA); } while (0)
    PG8_STAGE(PG8_SB(0, 0), cB, cvB); PG8_STAGE_A(PG8_SA(0, 0), cA, 0, vg0, vg1); PG8_STAGE(PG8_SB(0, 1), cB + chsB, cvB); PG8_STAGE_A(PG8_SA(0, 1), cA, 1, vg0, vg1);
    if (wr == 1) PG8_BAR;
    PG8_WAIT_V(4); PG8_BAR;
    PG8_STAGE(PG8_SB(1, 0), cB + kstep, cvB); PG8_STAGE_A(PG8_SA(1, 0), cA + kstep, 0, vg0, vg1); PG8_STAGE(PG8_SB(1, 1), cB + chsB + kstep, cvB);
    PG8_WAIT_V(6); PG8_BAR;
    for (;;) {
        const bool has_next = S.next(ui + 1, nxt);
        const char* nA = has_next ? (const char*)nxt.A : cA; const char* nB = has_next ? (const char*)nxt.B : cB;
        if constexpr (MIX) { if (has_next) PG8_KIND_B(nxt, nvB, nhsB, ntn); else { nvB[0] = cvB[0]; nvB[1] = cvB[1]; nhsB = chsB; ntn = nt; } }
        if constexpr (GA) { if (has_next) PG8_GOFF(nxt, nvg0, nvg1); else {
#pragma unroll
            for (int _i = 0; _i < 2; ++_i) { nvg0[_i] = vg0[_i]; nvg1[_i] = vg1[_i]; } } }
        for (int t = 0; t < nt; t += 2) {
            const bool last = (t == nt - 2);
            const char* a1 = cA + (size_t)(t + 1) * kstep;
            const char* a2 = last ? nA : cA + (size_t)(t + 2) * kstep; const char* b2 = last ? nB : cB + (size_t)(t + 2) * kstep;
            const char* a3 = a2 + kstep; const char* b3 = b2 + kstep;
            unsigned vB2[2]; vB2[0] = last ? nvB[0] : cvB[0]; vB2[1] = last ? nvB[1] : cvB[1]; const size_t hB2 = last ? nhsB : chsB;
            unsigned o0[2], o1[2];
#pragma unroll
            for (int _i = 0; _i < 2; ++_i) { o0[_i] = last ? nvg0[_i] : vg0[_i]; o1[_i] = last ? nvg1[_i] : vg1[_i]; }
            PG8_LDB(B0, 0, 0); PG8_SCHED; PG8_LDA(At, 0, 0); PG8_STAGE_A(PG8_SA(1, 1), a1, 1, vg0, vg1);
            PG8_WAIT_L(8); PG8_BAR; PG8_WAIT_L(0); PG8_MMA(0, 0, At, B0); PG8_BAR; PG8_SCHED;
            PG8_LDB(B1, 0, 1); PG8_STAGE(PG8_SB(0, 0), b2, vB2);
            PG8_BAR; PG8_WAIT_L(0); PG8_MMA(0, 1, At, B1); PG8_BAR;
            PG8_LDA(At, 0, 1); PG8_STAGE_A(PG8_SA(0, 0), a2, 0, o0, o1);
            PG8_BAR; PG8_WAIT_L(0); PG8_MMA(1, 0, At, B0); PG8_BAR; PG8_SCHED;
            PG8_STAGE(PG8_SB(0, 1), b2 + hB2, vB2);
            PG8_WAIT_V(6); PG8_BAR; PG8_MMA(1, 1, At, B1); PG8_BAR;
            PG8_LDB(B0, 1, 0); PG8_SCHED; PG8_LDA(At, 1, 0); PG8_STAGE_A(PG8_SA(0, 1), a2, 1, o0, o1);
            PG8_WAIT_L(8); PG8_BAR; PG8_WAIT_L(0); PG8_MMA(0, 0, At, B0); PG8_BAR; PG8_SCHED;
            PG8_LDB(B1, 1, 1); PG8_STAGE(PG8_SB(1, 0), b3, vB2);
            PG8_BAR; PG8_WAIT_L(0); PG8_MMA(0, 1, At, B1); PG8_BAR;
            PG8_LDA(At, 1, 1); PG8_STAGE_A(PG8_SA(1, 0), a3, 0, o0, o1);
            PG8_BAR; PG8_WAIT_L(0); PG8_MMA(1, 0, At, B0); PG8_BAR; PG8_SCHED;
            PG8_STAGE(PG8_SB(1, 1), b3 + hB2, vB2);
            PG8_WAIT_V(6); PG8_BAR; PG8_MMA(1, 1, At, B1); PG8_BAR;
        }
        E(acc, cur, wr, wc, fr, fq);
        if (!has_next) break;
#pragma unroll
        for (int a = 0; a < 2; ++a)
#pragma unroll
            for (int b = 0; b < 2; ++b)
#pragma unroll
                for (int m = 0; m < 4; ++m)
#pragma unroll
                    for (int n = 0; n < 2; ++n) acc[a][b][m][n] = (f32x4){0.f, 0.f, 0.f, 0.f};
        cur = nxt; cA = nA; cB = nB; ++ui; cvB[0] = nvB[0]; cvB[1] = nvB[1]; chsB = nhsB; nt = ntn;
        if constexpr (GA) {
#pragma unroll
            for (int _i = 0; _i < 2; ++_i) { vg0[_i] = nvg0[_i]; vg1[_i] = nvg1[_i]; } }
    }
    PG8_WAIT_V(0);
    if (wr == 0) PG8_BAR;
    PG8_BAR;
#undef PG8_SA
#undef PG8_SB
#undef PG8_STAGE
#undef PG8_LDA
#undef PG8_LDB
#undef PG8_MMA
#undef PG8_WAIT_V
#undef PG8_WAIT_L
#undef PG8_BAR
#undef PG8_SCHED
#undef PG8_GOFF
#undef PG8_KIND_B
#undef PG8_STAGE_A
}
}

constexpr int NWAVES = 8, NTHR = 512;
constexpr int RING_BYTES = 131072;
constexpr int LDSCTL_OFF = RING_BYTES, MISC_OFF = LDSCTL_OFF + 320;
constexpr int LDS_BYTES = 147456;

struct Args { const float* in[35]; float* out; unsigned char* ws; int ph_lo, ph_hi; };

struct Frame {
    LAS unsigned char* lds;
    unsigned* ctl;
    int tid, lane, wave, G, bid;
    int gw, ngw;
    int dl;
};

__device__ __forceinline__ int row_vec(int row) { return row < MLAT ? (row >> 13) : 4; }

__device__ __forceinline__ void ph_copy_h(const Frame& F, const float* x, const float* ctx, float* H) {
    const size_t n4 = (size_t)MALL * D / 4, nl4 = (size_t)MLAT * D / 4;
    const f32x4* x4 = (const f32x4*)x; const f32x4* c4 = (const f32x4*)ctx; f32x4* h4 = (f32x4*)H;
    for (size_t i = (size_t)F.bid * NTHR + F.tid; i < n4; i += (size_t)F.G * NTHR) h4[i] = i < nl4 ? x4[i] : c4[i - nl4];
}
__device__ __forceinline__ void ph_zero16(const Frame& F, void* p, size_t bytes) {
    u32x4* q = (u32x4*)p; const size_t n = bytes / 16;
    for (size_t i = (size_t)F.bid * NTHR + F.tid; i < n; i += (size_t)F.G * NTHR) q[i] = (u32x4){0u, 0u, 0u, 0u};
}

__device__ __forceinline__ float silu_f(float x) { return x * __builtin_amdgcn_rcpf(1.f + __expf(-x)); }
__device__ __forceinline__ float sigmoid_f(float x) { return __builtin_amdgcn_rcpf(1.f + __expf(-x)); }
__device__ __forceinline__ float sigmoid_div_f(float x) { return 1.f / (1.f + __expf(-x)); }
__device__ __forceinline__ void ph_mod(const Frame& F, const float* c, const float* c_ctx, const float* w_ada, const float* b_ada, float* MOD) {
    LAS float* part = (LAS float*)F.lds;
    LAS float* sc = part + 8 * 5 * 64;
    for (int i = F.tid; i < 5 * D; i += NTHR) { const int v = i >> 10, k = i & 1023; sc[i] = silu_f(v < 4 ? c[v * D + k] : c_ctx[k]); }
    __syncthreads();
    for (int item = F.bid; item < 2 * 96; item += F.G) {
        const int l = item / 96, cg = item % 96, col = cg * 64 + F.lane;
        float acc[5] = {0.f, 0.f, 0.f, 0.f, 0.f};
        const float* W = w_ada + (size_t)l * D * 6144 + (size_t)(F.wave * 128) * 6144 + col;
#pragma unroll 1
        for (int kk0 = 0; kk0 < 128; kk0 += 16) {
            float w[16];
#pragma unroll
            for (int j = 0; j < 16; ++j) w[j] = W[(size_t)(kk0 + j) * 6144];
#pragma unroll
            for (int v = 0; v < 5; ++v) {
#pragma unroll
                for (int j4 = 0; j4 < 4; ++j4) { const f32x4 s4 = *(const LAS f32x4*)(sc + v * D + F.wave * 128 + kk0 + 4 * j4);
                    acc[v] += s4.x * w[4 * j4] + s4.y * w[4 * j4 + 1] + s4.z * w[4 * j4 + 2] + s4.w * w[4 * j4 + 3]; } }
        }
#pragma unroll
        for (int v = 0; v < 5; ++v) part[(F.wave * 5 + v) * 64 + F.lane] = acc[v];
        __syncthreads();
        if (F.wave < 5) { float s = b_ada[l * 6144 + col];
#pragma unroll
            for (int w = 0; w < 8; ++w) s += part[(w * 5 + F.wave) * 64 + F.lane];
            MOD[((size_t)l * 5 + F.wave) * 6144 + col] = s; }
        __syncthreads();
    }
}

__device__ __forceinline__ void transpose_item(const float* W, int K, int N, bf16_t* WT, int ldt, int row_off, int mode, LAS float* scr, int item, int lane) {
    const int nblk = N / 32, kb = item / nblk, nb = item % nblk, k0 = 64 * kb, n0 = 32 * nb;
#pragma unroll 8
    for (int i = 0; i < 32; ++i) { const int kk = 2 * i + (lane >> 5); scr[kk * 33 + (lane & 31)] = W[(size_t)(k0 + kk) * N + n0 + (lane & 31)]; }
    asm volatile("s_waitcnt lgkmcnt(0)" ::: "memory");
    const int c = lane & 7;
#pragma unroll
    for (int j = 0; j < 4; ++j) { const int nl = (lane >> 3) + 8 * j; const LAS float* s = scr + (8 * c) * 33 + nl;
        u32x4 o; o.x = pk2(s[0 * 33], s[1 * 33]); o.y = pk2(s[2 * 33], s[3 * 33]); o.z = pk2(s[4 * 33], s[5 * 33]); o.w = pk2(s[6 * 33], s[7 * 33]);
        const int n = n0 + nl; const int row = row_off + (mode == 0 ? n : (256 * (n >> 7) + (n & 127) + (mode == 2 ? 128 : 0)));
        *(u32x4*)(WT + (size_t)row * ldt + k0 + 8 * c) = o; }
    asm volatile("s_waitcnt lgkmcnt(0)" ::: "memory");
}
#define TR_BATCH_W(GW, NGW, SRC, SSTR, CNT, KK, NN, DST, DSTR, LDT, ROFF, MODE) do { const int per_ = ((KK) / 64) * ((NN) / 32), tot_ = per_ * (CNT); \
    for (int it_ = (GW); it_ < tot_; it_ += (NGW)) { const int m_ = it_ / per_; \
        transpose_item((SRC) + (size_t)m_ * (SSTR), KK, NN, (DST) + (size_t)m_ * (DSTR), LDT, ROFF, MODE, scr, it_ % per_, F.lane); } } while (0)
#define TR_BATCH(SRC, SSTR, CNT, KK, NN, DST, DSTR, LDT, ROFF, MODE) do { const int per_ = ((KK) / 64) * ((NN) / 32), tot_ = per_ * (CNT); \
    for (int it_ = F.gw; it_ < tot_; it_ += F.ngw) { const int m_ = it_ / per_; \
        transpose_item((SRC) + (size_t)m_ * (SSTR), KK, NN, (DST) + (size_t)m_ * (DSTR), LDT, ROFF, MODE, scr, it_ % per_, F.lane); } } while (0)

__device__ __forceinline__ void sincos_d(double ang, float& s, float& c) {
    const double k = rint(ang * 0.15915494309189535);
    double r = fma(-k, 6.283185307179586, ang); r = fma(-k, 2.4492935982947064e-16, r);
    const double r2 = r * r;
    double sp = -2.8114572543455206e-15;
    sp = fma(sp, r2, 7.647163731819816e-13); sp = fma(sp, r2, -1.6059043836821613e-10); sp = fma(sp, r2, 2.505210838544172e-08);
    sp = fma(sp, r2, -2.7557319223985893e-06); sp = fma(sp, r2, 1.984126984126984e-04); sp = fma(sp, r2, -8.333333333333333e-03);
    sp = fma(sp, r2, 1.6666666666666666e-01); sp = fma(-sp, r2, 1.0);
    double cp = 1.5619206968586225e-16;
    cp = fma(cp, r2, -4.779477332387385e-14); cp = fma(cp, r2, 1.1470745597729725e-11); cp = fma(cp, r2, -2.08767569878681e-09);
    cp = fma(cp, r2, 2.755731922398589e-07); cp = fma(cp, r2, -2.48015873015873e-05); cp = fma(cp, r2, 1.388888888888889e-03);
    cp = fma(cp, r2, -4.1666666666666664e-02); cp = fma(cp, r2, 0.5 * 1.0); cp = fma(-cp, r2, 1.0);
    s = (float)(sp * r); c = (float)cp;
}
__device__ __forceinline__ void ph_tables(const Frame& F, float* RTAB, float* AX64, float* AX32) {
    const int gt = F.bid * NTHR + F.tid, ngt = F.G * NTHR;
    const double L = 9.210340371976184;
    for (int i = gt; i < 8448 * 32; i += ngt) { const int pos = i >> 5, f = i & 31; float s, c; sincos_d((double)pos * exp(-L * (double)f / 32.0), s, c); RTAB[2 * i] = c; RTAB[2 * i + 1] = s; }
    for (int i = gt; i < 192 * 16; i += ngt) { const int p = i >> 4, f = i & 15; const int pos = p < 128 ? p : p - 128; float s, c; sincos_d((double)pos * exp(-L * (double)f / 16.0), s, c); AX64[2 * i] = c; AX64[2 * i + 1] = s; }
    for (int i = gt; i < 192 * 8; i += ngt) { const int p = i >> 3, f = i & 7; const int pos = p < 128 ? p : p - 128; float s, c; sincos_d((double)pos * exp(-L * (double)f / 8.0), s, c); AX32[2 * i] = c; AX32[2 * i + 1] = s; }
}

__device__ __forceinline__ void ph_adaln(const Frame& F, const float* H, const float* g, const float* modl  , int shift_i, int scale_i, bf16_t* XN, int nrows) {
    for (int m = F.gw; m < nrows; m += F.ngw) {
        const f32x4* xr = (const f32x4*)(H + (size_t)m * D) + F.lane;
        const float* mv = modl + (size_t)row_vec(m) * 6144;
        f32x4 v[4]; float s2 = 0.f;
#pragma unroll
        for (int j = 0; j < 4; ++j) { v[j] = xr[64 * j]; s2 += (v[j].x * v[j].x + v[j].y * v[j].y) + (v[j].z * v[j].z + v[j].w * v[j].w); }
        const float rstd = 1.f / sqrtf(wave_sum(s2) * (1.f / D) + NORM_EPS);
        u32x2* o = (u32x2*)(XN + (size_t)m * D) + F.lane;
#pragma unroll
        for (int j = 0; j < 4; ++j) { const int ci = 64 * j + F.lane; const f32x4 gg = ((const f32x4*)g)[ci], sc = ((const f32x4*)(mv + scale_i * D))[ci], sh = ((const f32x4*)(mv + shift_i * D))[ci];
            const f32x4 y = v[j] * rstd * gg * (sc + 1.f) + sh; o[64 * j] = (u32x2){pk2(y.x, y.y), pk2(y.z, y.w)}; }
    }
}

struct EpiStoreBf16 {
    static constexpr bool PERM = true;
    bf16_t* O; int ldc;
    __device__ __forceinline__ void operator()(const f32x4 (&acc)[2][2][4][2], const pg8::Unit& u, int wr, int wc, int fr, int fq) const {
        const int row0 = u.u0 + wr * 64 + fr, col0 = u.u1 + wc * 32 + 8 * fq;
#pragma unroll
        for (int ai = 0; ai < 2; ++ai)
#pragma unroll
            for (int m = 0; m < 4; ++m) { bf16_t* rowp = O + (size_t)(row0 + ai * 128 + m * 16) * ldc + col0;
#pragma unroll
                for (int bj = 0; bj < 2; ++bj) { const f32x4 v0 = acc[ai][bj][m][0], v1 = acc[ai][bj][m][1];
                    u32x4 w; w.x = pg8::cvt_pk_bf16(v0[0], v0[1]); w.y = pg8::cvt_pk_bf16(v0[2], v0[3]); w.z = pg8::cvt_pk_bf16(v1[0], v1[1]); w.w = pg8::cvt_pk_bf16(v1[2], v1[3]);
                    *(u32x4*)(rowp + bj * 128) = w; } }
    }
};
struct EpiGate {
    static constexpr bool PERM = true;
    bf16_t* O; int ldc; const float* bias;
    __device__ __forceinline__ void operator()(const f32x4 (&acc)[2][2][4][2], const pg8::Unit& u, int wr, int wc, int fr, int fq) const {
        const int row0 = u.u0 + wr * 64 + fr, col0 = u.u1 + wc * 32 + 8 * fq, bcol0 = u.u2 + wc * 32 + 8 * fq;
        f32x4 bv[2][2];
#pragma unroll
        for (int bj = 0; bj < 2; ++bj)
#pragma unroll
            for (int n = 0; n < 2; ++n) bv[bj][n] = *(const f32x4*)(bias + bcol0 + bj * 128 + 4 * n);
#pragma unroll
        for (int ai = 0; ai < 2; ++ai)
#pragma unroll
            for (int m = 0; m < 4; ++m) { bf16_t* rowp = O + (size_t)(row0 + ai * 128 + m * 16) * ldc + col0;
#pragma unroll
                for (int bj = 0; bj < 2; ++bj) { const f32x4 v0 = acc[ai][bj][m][0] + bv[bj][0], v1 = acc[ai][bj][m][1] + bv[bj][1];
                    const u32x4 old = *(const u32x4*)(rowp + bj * 128);
                    float y[8];
#pragma unroll
                    for (int e = 0; e < 4; ++e) { y[e] = sigmoid_f(v0[e]); y[4 + e] = sigmoid_f(v1[e]); }
#pragma unroll
                    for (int e = 0; e < 4; ++e) { const unsigned wv = old[e]; y[2 * e] *= __uint_as_float(wv << 16); y[2 * e + 1] *= __uint_as_float(wv & 0xffff0000u); }
                    u32x4 w; w.x = pg8::cvt_pk_bf16(y[0], y[1]); w.y = pg8::cvt_pk_bf16(y[2], y[3]); w.z = pg8::cvt_pk_bf16(y[4], y[5]); w.w = pg8::cvt_pk_bf16(y[6], y[7]);
                    *(u32x4*)(rowp + bj * 128) = w; }
                asm volatile("" ::: "memory"); }
    }
};
struct EpiResid {
    static constexpr bool PERM = false;
    float* H; const float* gate  ; const float* Xl; const float* Xc;
    __device__ __forceinline__ void operator()(const f32x4 (&acc)[2][2][4][2], const pg8::Unit& u, int wr, int wc, int fr, int fq) const {
        const int row0 = u.u0 + wr * 64 + fr, col0 = u.u1 + wc * 32 + 4 * fq;
        const float* gv = gate + (size_t)row_vec(u.u0) * 6144;
        const float* Hs = Xl ? (u.u0 < MLAT ? Xl : Xc - (size_t)MLAT * D) : H;
        f32x4 g4[2][2];
#pragma unroll
        for (int bj = 0; bj < 2; ++bj)
#pragma unroll
            for (int n = 0; n < 2; ++n) g4[bj][n] = *(const f32x4*)(gv + col0 + bj * 128 + n * 16);
        f32x4 ch[4], nh[4];
#define ER_LOAD(g_, X_) do { const float* rp_ = Hs + (size_t)(row0 + ((g_) >> 2) * 128 + ((g_) & 3) * 16) * D + col0; \
            _Pragma("unroll") for (int q_ = 0; q_ < 4; ++q_) X_[q_] = *(const f32x4*)(rp_ + (q_ >> 1) * 128 + (q_ & 1) * 16); } while (0)
        ER_LOAD(0, ch);
#pragma unroll
        for (int g = 0; g < 8; ++g) {
            if (g + 1 < 8) ER_LOAD(g + 1, nh);
            asm volatile("" ::: "memory");
            const int ai = g >> 2, m = g & 3; float* rowp = H + (size_t)(row0 + ai * 128 + m * 16) * D + col0;
#pragma unroll
            for (int q = 0; q < 4; ++q) *(f32x4*)(rowp + (q >> 1) * 128 + (q & 1) * 16) = ch[q] + g4[q >> 1][q & 1] * acc[ai][q >> 1][m][q & 1];
            asm volatile("" ::: "memory");
#pragma unroll
            for (int q = 0; q < 4; ++q) ch[q] = nh[q];
        }
#undef ER_LOAD
    }
};

__device__ __forceinline__ void xcd_tile(int L, int nM, int nN, int& pm, int& pn) {
    const int nwg = nM * nN, q = nwg / 8, r = nwg % 8, xcd = L % 8, off = L / 8;
    const int wgid = (xcd < r ? xcd * (q + 1) : r * (q + 1) + (xcd - r) * q) + off;
    const int nig = 8 * nN, gid = wgid / nig, fm = gid * 8, gsz = (nM - fm) < 8 ? (nM - fm) : 8;
    pm = fm + ((wgid % nig) % gsz); pn = (wgid % nig) / gsz;
}
struct SchedP {
    static constexpr int lda = D, ldb = D, K = D;
    const bf16_t* XN; const bf16_t* W; int G, c;
    __device__ __forceinline__ bool next(int i, pg8::Unit& u) const {
        const int L = i * G + c; if (L >= 132 * 14) return false;
        int pm, pn; xcd_tile(L, 132, 14, pm, pn);
        u.A = XN + (size_t)pm * 256 * D; u.B = W + (size_t)pn * 256 * D; u.u0 = pm * 256; u.u1 = pn * 256; u.u2 = 0; return true;
    }
};
struct SchedBranch {
    static constexpr int lda = D, ldb = 256, K = 256;
    const bf16_t* YB; const bf16_t* W  ; int nM, G, c;
    __device__ __forceinline__ bool next(int i, pg8::Unit& u) const {
        const int L = i * G + c; if (L >= nM * 16) return false;
        int pm, pq; xcd_tile(L, nM, 16, pm, pq); const int n = pq >> 2, pn = pq & 3;
        u.A = YB + (size_t)pm * 256 * D + n * 256; u.B = W + ((size_t)n * 1024 + pn * 256) * 256; u.u0 = pm * 256; u.u1 = n * 1024 + pn * 256; u.u2 = 0; return true;
    }
};
struct SchedGate {
    static constexpr int lda = D, ldb = D, K = D;
    const bf16_t* XN; const bf16_t* W  ; int nM, G, c;
    __device__ __forceinline__ bool next(int i, pg8::Unit& u) const {
        const int L = i * G + c; if (L >= nM * 16) return false;
        int pm, pn; xcd_tile(L, nM, 16, pm, pn);
        u.A = XN + (size_t)pm * 256 * D; u.B = W + (size_t)pn * 256 * D; u.u0 = pm * 256; u.u1 = pn * 256; u.u2 = pn * 256; return true;
    }
};
struct SchedOut {
    static constexpr int lda = D, ldb = D, K = D;
    const bf16_t* ACC; const bf16_t* W; int nM, G, c;
    __device__ __forceinline__ bool next(int i, pg8::Unit& u) const {
        const int L = i * G + c; if (L >= nM * 4) return false;
        int pm, pn; xcd_tile(L, nM, 4, pm, pn);
        u.A = ACC + (size_t)pm * 256 * D; u.B = W + (size_t)pn * 256 * D; u.u0 = pm * 256; u.u1 = pn * 256; u.u2 = 0; return true;
    }
};


struct SchedMerge {
    static constexpr int lda = D, ldb0 = 256, K0 = 256, ldb1 = D, K1 = D;
    const bf16_t *YB, *XN, *WB  , *WG  ; int nctx  , G, c;
    __device__ __forceinline__ bool next(int i, pg8::Unit& u) const {
        const int ntl = (c < 512) ? (511 - c) / G + 1 : 0;
        int pm, pn, n, rmw; const int kind = i & 1;
        if (i < 8 * ntl) { xcd_tile((i >> 3) * G + c, 128, 4, pm, pn); n = (i & 7) >> 1; rmw = 1; }
        else { const int q = c + ((i - 8 * ntl) >> 1) * G; if (q >= nctx) return false; pm = 128 + (q >> 4); pn = (q >> 2) & 3; n = q & 3; rmw = 0; }
        if (kind == 0) { u.A = YB + (size_t)pm * 256 * D + n * 256; u.B = WB + ((size_t)n * 1024 + pn * 256) * 256; }
        else           { u.A = XN + (size_t)pm * 256 * D;           u.B = WG + ((size_t)n * 1024 + pn * 256) * D; }
        u.u0 = pm * 256; u.u1 = n * 1024 + pn * 256; u.u2 = rmw; u.u3 = kind; return true;
    }
};
struct EpiMerge {
    static constexpr bool PERM = true;
    bf16_t* BOUT; bf16_t* ACC; const float* bias  ;
    __device__ __forceinline__ void operator()(const f32x4 (&acc)[2][2][4][2], const pg8::Unit& u, int wr, int wc, int fr, int fq) const {
        const int row0 = u.u0 + wr * 64 + fr, col0 = u.u1 + wc * 32 + 8 * fq, acol0 = (u.u1 & 1023) + wc * 32 + 8 * fq; const int n = u.u1 >> 10;
        if (u.u3 == 0) {
#pragma unroll
            for (int ai = 0; ai < 2; ++ai)
#pragma unroll
                for (int m = 0; m < 4; ++m) { bf16_t* rowp = BOUT + (size_t)(row0 + ai * 128 + m * 16) * 4096 + col0;
#pragma unroll
                    for (int bj = 0; bj < 2; ++bj) { const f32x4 v0 = acc[ai][bj][m][0], v1 = acc[ai][bj][m][1];
                        u32x4 w; w.x = pg8::cvt_pk_bf16(v0[0], v0[1]); w.y = pg8::cvt_pk_bf16(v0[2], v0[3]); w.z = pg8::cvt_pk_bf16(v1[0], v1[1]); w.w = pg8::cvt_pk_bf16(v1[2], v1[3]);
                        *(u32x4*)(rowp + bj * 128) = w; } }
            return;
        }
        f32x4 bv[2][2];
#pragma unroll
        for (int bj = 0; bj < 2; ++bj)
#pragma unroll
            for (int q = 0; q < 2; ++q) bv[bj][q] = *(const f32x4*)(bias + col0 + bj * 128 + 4 * q);
        const bool rmw = u.u2 != 0, hasprev = rmw && n > 0;
        u32x4 cb[2], cp[2], nb[2], np[2];
#define EM_LOAD(g_, B_, P_) do { const size_t r_ = (size_t)(row0 + ((g_) >> 2) * 128 + ((g_) & 3) * 16); \
            _Pragma("unroll") for (int bj_ = 0; bj_ < 2; ++bj_) { B_[bj_] = *(const u32x4*)(BOUT + r_ * 4096 + col0 + bj_ * 128); \
                P_[bj_] = hasprev ? *(const u32x4*)(ACC + r_ * D + acol0 + bj_ * 128) : (u32x4){0u, 0u, 0u, 0u}; } } while (0)
        EM_LOAD(0, cb, cp);
#pragma unroll
        for (int g = 0; g < 8; ++g) {
            if (g + 1 < 8) EM_LOAD(g + 1, nb, np);
            asm volatile("" ::: "memory");
            const int ai = g >> 2, m = g & 3; const size_t r = (size_t)(row0 + ai * 128 + m * 16); bf16_t* bp = BOUT + r * 4096 + col0; bf16_t* ap = ACC + r * D + acol0;
#pragma unroll
            for (int bj = 0; bj < 2; ++bj) { const f32x4 v0 = acc[ai][bj][m][0] + bv[bj][0], v1 = acc[ai][bj][m][1] + bv[bj][1];
                const u32x4 br = cb[bj], prev = cp[bj];
                float y[8];
#pragma unroll
                for (int e = 0; e < 4; ++e) { y[e] = sigmoid_f(v0[e]); y[4 + e] = sigmoid_f(v1[e]); }
#pragma unroll
                for (int e = 0; e < 4; ++e) { y[2 * e] = y[2 * e] * __uint_as_float(br[e] << 16) + __uint_as_float(prev[e] << 16); y[2 * e + 1] = y[2 * e + 1] * __uint_as_float(br[e] & 0xffff0000u) + __uint_as_float(prev[e] & 0xffff0000u); }
                u32x4 w; w.x = pg8::cvt_pk_bf16(y[0], y[1]); w.y = pg8::cvt_pk_bf16(y[2], y[3]); w.z = pg8::cvt_pk_bf16(y[4], y[5]); w.w = pg8::cvt_pk_bf16(y[6], y[7]);
                if (rmw) *(u32x4*)(ap + bj * 128) = w; else *(u32x4*)(bp + bj * 128) = w; }
            asm volatile("" ::: "memory");
#pragma unroll
            for (int bj = 0; bj < 2; ++bj) { cb[bj] = nb[bj]; cp[bj] = np[bj]; }
        }
#undef EM_LOAD
    }
};

__device__ __forceinline__ void ph_sum4(const Frame& F, const bf16_t* BOUT, bf16_t* ACC, int row_lo, int nrows) {
    const size_t n8 = (size_t)nrows * (D / 8);
    for (size_t i = (size_t)F.bid * NTHR + F.tid; i < n8; i += (size_t)F.G * NTHR) {
        const size_t row = (size_t)row_lo + (i >> 7); const int c8 = (int)(i & 127);
        const u32x4* p = (const u32x4*)(BOUT + row * 4096) + c8;
        float s[8] = {0.f, 0.f, 0.f, 0.f, 0.f, 0.f, 0.f, 0.f};
#pragma unroll
        for (int n = 0; n < 4; ++n) { const u32x4 w = p[n * 128];
#pragma unroll
            for (int e = 0; e < 4; ++e) { s[2 * e] += __uint_as_float(w[e] << 16); s[2 * e + 1] += __uint_as_float(w[e] & 0xffff0000u); } }
        u32x4 o; o.x = pk2(s[0], s[1]); o.y = pk2(s[2], s[3]); o.z = pk2(s[4], s[5]); o.w = pk2(s[6], s[7]);
        ((u32x4*)(ACC + row * D))[c8] = o;
    }
}


struct PrepArgs { const bf16_t* P; bf16_t *QA, *KA, *RQ, *RK, *CQN, *CKVN, *KC; const float *RTAB, *AX64, *AX32, *g_qnorm, *g_kvnorm; };
__device__ __forceinline__ float half32_sum_(float v) { v += __shfl_xor(v, 1); v += __shfl_xor(v, 2); v += __shfl_xor(v, 4); v += __shfl_xor(v, 8); v += __shfl_xor(v, 16); return v; }
__device__ __forceinline__ void up8(const u32x4& w, float (&o)[8]) {
#pragma unroll
    for (int i = 0; i < 4; ++i) { o[2 * i] = __uint_as_float(w[i] << 16); o[2 * i + 1] = __uint_as_float(w[i] & 0xffff0000u); } }
__device__ __forceinline__ void ph_prep(const Frame& F, const PrepArgs& a) {
    const int lane = F.lane, l32 = lane & 31;
    for (int rp = F.gw; rp < MALL / 2; rp += F.ngw) {
        const int row = 2 * rp + (lane >> 5);
        const bool lat = row < MLAT;
        const int t = lat ? (row & 8191) : ((row - MLAT) & 255), trow = t >> 6, tcol = t & 63;
        const bf16_t* p = a.P + (size_t)row * NINP;
        constexpr float QS = 0.125f * 1.4426950408889634f;
#pragma unroll
        for (int rep = 0; rep < 2; ++rep) { const int ch = l32 + 32 * rep;
            if (rep == 0 || l32 < 16) {
                const int k8 = ch & 7; const bool first = (k8 & 2) == 0; const bf16_t* src = p + 8 * ch;
                float x[8], q[8]; up8(*(const u32x4*)src, x); up8(*(const u32x4*)(first ? src + 16 : src - 16), q);
                float o[8];
                if (lat) { const f32x4* tb = (const f32x4*)(a.AX64 + (size_t)((k8 < 4) ? trow : 128 + tcol) * 32 + 16 * (k8 & 1));
#pragma unroll
                    for (int i4 = 0; i4 < 4; ++i4) { const f32x4 cs = tb[i4];
                        o[2 * i4] = first ? x[2 * i4] * cs[0] - q[2 * i4] * cs[1] : x[2 * i4] * cs[0] + q[2 * i4] * cs[1];
                        o[2 * i4 + 1] = first ? x[2 * i4 + 1] * cs[2] - q[2 * i4 + 1] * cs[3] : x[2 * i4 + 1] * cs[2] + q[2 * i4 + 1] * cs[3]; } }
                else {
#pragma unroll
                    for (int i = 0; i < 8; ++i) o[i] = x[i]; }
                const float sc = rep == 0 ? QS : 1.f;
                bf16_t* dst = rep == 0 ? (a.QA + (size_t)row * 256 + 8 * ch) : (a.KA + (size_t)row * 128 + 8 * (ch - 32));
                *(u32x4*)dst = (u32x4){pk2(o[0] * sc, o[1] * sc), pk2(o[2] * sc, o[3] * sc), pk2(o[4] * sc, o[5] * sc), pk2(o[6] * sc, o[7] * sc)}; } }
        { float x[8]; up8(*(const u32x4*)(p + 1792 + 8 * l32), x); float s2 = 0.f;
#pragma unroll
          for (int e = 0; e < 8; ++e) s2 += x[e] * x[e];
          const float rstd = 1.f / sqrtf(half32_sum_(s2) * (1.f / 256.f) + NORM_EPS);
          const f32x4 g0 = *((const f32x4*)a.g_qnorm + 2 * l32), g1 = *((const f32x4*)a.g_qnorm + 2 * l32 + 1);
          *((u32x4*)(a.CQN + (size_t)row * 256) + l32) = (u32x4){pk2(x[0] * rstd * g0[0], x[1] * rstd * g0[1]), pk2(x[2] * rstd * g0[2], x[3] * rstd * g0[3]), pk2(x[4] * rstd * g1[0], x[5] * rstd * g1[1]), pk2(x[6] * rstd * g1[2], x[7] * rstd * g1[3])};
          const u32x2 yw = *(const u32x2*)(p + 2048 + 4 * l32);
          const float y0 = __uint_as_float(yw.x << 16), y1 = __uint_as_float(yw.x & 0xffff0000u), y2 = __uint_as_float(yw.y << 16), y3 = __uint_as_float(yw.y & 0xffff0000u);
          const float rstd2 = 1.f / sqrtf(half32_sum_((y0 * y0 + y1 * y1) + (y2 * y2 + y3 * y3)) * (1.f / 128.f) + NORM_EPS);
          const f32x4 gk = *((const f32x4*)a.g_kvnorm + l32);
          *((u32x2*)(a.CKVN + (size_t)row * 128) + l32) = (u32x2){pk2(y0 * rstd2 * gk[0], y1 * rstd2 * gk[1]), pk2(y2 * rstd2 * gk[2], y3 * rstd2 * gk[3])};
          if (l32 < 4) { const int k4 = l32; const bool first = (k4 & 1) == 0; const bf16_t* src = p + 2176 + 8 * k4;
              float xx[8], qq[8], o[8]; up8(*(const u32x4*)src, xx); up8(*(const u32x4*)(first ? src + 8 : src - 8), qq);
              if (lat) { const f32x4* tb = (const f32x4*)(a.AX32 + (size_t)((k4 < 2) ? trow : 128 + tcol) * 16);
#pragma unroll
                  for (int i4 = 0; i4 < 4; ++i4) { const f32x4 cs = tb[i4];
                      o[2 * i4] = first ? xx[2 * i4] * cs[0] - qq[2 * i4] * cs[1] : xx[2 * i4] * cs[0] + qq[2 * i4] * cs[1];
                      o[2 * i4 + 1] = first ? xx[2 * i4 + 1] * cs[2] - qq[2 * i4 + 1] * cs[3] : xx[2 * i4 + 1] * cs[2] + qq[2 * i4 + 1] * cs[3]; } }
              else {
#pragma unroll
                  for (int i = 0; i < 8; ++i) o[i] = xx[i]; }
              const u32x4 ow = (u32x4){pk2(o[0], o[1]), pk2(o[2], o[3]), pk2(o[4], o[5]), pk2(o[6], o[7])};
#pragma unroll
              for (int h = 0; h < 4; ++h) *(u32x4*)(a.KC + (size_t)row * 384 + h * 96 + 64 + 8 * k4) = ow; } }
    }
}

template <int KD> __device__ __forceinline__ f32x16 wave_mm32(const bf16x8 (&af)[KD / 16], const bf16_t* Bt, int ldb, int lane) {
    f32x16 acc = {0.f,0.f,0.f,0.f,0.f,0.f,0.f,0.f,0.f,0.f,0.f,0.f,0.f,0.f,0.f,0.f};
    const bf16_t* bp = Bt + (size_t)(lane & 31) * ldb + 8 * (lane >> 5);
#pragma unroll
    for (int s = 0; s < KD / 16; ++s) { const bf16x8 b = *(const bf16x8*)(bp + 16 * s); acc = __builtin_amdgcn_mfma_f32_32x32x16_bf16(af[s], b, acc, 0, 0, 0); }
    return acc;
}
struct RwkvW { const float *mu, *w0, *a0, *k_k, *k_a, *r_k; const bf16_t *wup_t, *aup_t, *gup_t; };
struct RwkvF { bf16_t *R, *V, *KF, *KB, *KK, *BF, *BB, *EF, *EB, *G; float* BONUS; };
__device__ __forceinline__ float half32_sum(float v) { v += __shfl_xor(v, 1); v += __shfl_xor(v, 2); v += __shfl_xor(v, 4); v += __shfl_xor(v, 8); v += __shfl_xor(v, 16); return v; }
__device__ __forceinline__ float softplus_f(float y) { return fmaxf(y, 0.f) + __logf(1.f + __expf(-fabsf(y))); }
__device__ __forceinline__ float tanh_f(float x) { return 1.f - 2.f * __builtin_amdgcn_rcpf(__expf(2.f * x) + 1.f); }
__device__ __forceinline__ void rw_z8(const bf16_t* pc  , bool hp, bool hn, const float* mu, float (&z)[8]) {
    const u32x4 cu = *(const u32x4*)pc; u32x4 pv = {0u, 0u, 0u, 0u}, nv = pv;
    if (hp) pv = *(const u32x4*)(pc - NINP);
    if (hn) nv = *(const u32x4*)(pc + NINP);
    const f32x4 m0 = *(const f32x4*)mu, m1 = *(const f32x4*)(mu + 4);
#pragma unroll
    for (int e = 0; e < 4; ++e) {
        const float c0 = __uint_as_float(cu[e] << 16), c1 = __uint_as_float(cu[e] & 0xffff0000u);
        const float s0 = 0.5f * (__uint_as_float(pv[e] << 16) + __uint_as_float(nv[e] << 16)), s1 = 0.5f * (__uint_as_float(pv[e] & 0xffff0000u) + __uint_as_float(nv[e] & 0xffff0000u));
        const float mu0 = (e < 2) ? m0[2 * e] : m1[2 * e - 4], mu1 = (e < 2) ? m0[2 * e + 1] : m1[2 * e - 3];
        z[2 * e] = c0 + (s0 - c0) * mu0; z[2 * e + 1] = c1 + (s1 - c1) * mu1; }
}
template <int KD> __device__ __forceinline__ f32x16 wave_mm32_lds(const bf16x8 (&af)[KD / 16], const LAS unsigned char* img, int n0, int lane) {
    f32x16 acc = {0.f,0.f,0.f,0.f,0.f,0.f,0.f,0.f,0.f,0.f,0.f,0.f,0.f,0.f,0.f,0.f};
    const int n = n0 + (lane & 31), hi = lane >> 5; const LAS unsigned char* rp = img + n * (KD * 2);
#pragma unroll
    for (int s = 0; s < KD / 16; ++s) { const bf16x8 b = *(const LAS bf16x8*)(rp + (((2 * s + hi) ^ (n & 7)) << 4)); acc = __builtin_amdgcn_mfma_f32_32x32x16_bf16(af[s], b, acc, 0, 0, 0); }
    return acc;
}
template <int KD> __device__ __forceinline__ f32x16 wave_mm32t_lds(const bf16x8 (&af)[KD / 16], const LAS unsigned char* img, int n0, int lane) {
    f32x16 acc = {0.f,0.f,0.f,0.f,0.f,0.f,0.f,0.f,0.f,0.f,0.f,0.f,0.f,0.f,0.f,0.f};
    const int n = n0 + (lane & 31), hi = lane >> 5; const LAS unsigned char* rp = img + n * (KD * 2);
#pragma unroll
    for (int s = 0; s < KD / 16; ++s) { const bf16x8 b = *(const LAS bf16x8*)(rp + (((2 * s + hi) ^ (n & 7)) << 4)); acc = __builtin_amdgcn_mfma_f32_32x32x16_bf16(b, af[s], acc, 0, 0, 0); }
    return acc;
}
template <int KD, bool PERMT, int ROWS> __device__ __forceinline__ void stage_weights(const Frame& F, const bf16_t* src, LAS unsigned char* img) {
    constexpr int CH = KD / 8; static_assert((ROWS * CH) % NTHR == 0, "whole rounds");
#pragma unroll
    for (int k = 0; k < ROWS * CH / NTHR; ++k) { const int i = k * NTHR + F.tid, n = i / CH, c = (i % CH) ^ (n & 7), rho = n & 31;
        const int ns = PERMT ? (n & ~31) + 16 * ((rho >> 2) & 1) + (rho & 3) + 4 * (rho >> 3) : n;
        __builtin_amdgcn_global_load_lds((const unsigned*)(src + (size_t)ns * KD + 8 * c), (LAS unsigned*)(img + (k * NTHR + F.wave * 64) * 16), 16, 0, 0); }
    asm volatile("s_waitcnt vmcnt(0)" ::: "memory");
}
__device__ __forceinline__ void ph_mla_proj(const Frame& F, const bf16_t* CQN, const bf16_t* CKVN, const bf16_t* WUQ_T, const bf16_t* WUKV_T, const float* AX32, bf16_t* QC, bf16_t* KC, bf16_t* VC) {
    const int lane = F.lane, r32 = lane & 31, hi = lane >> 5, w = F.wave;
    constexpr float QS = 0.10206207261596577f * 1.4426950408889634f;
    constexpr int NT = MALL / 32;
    const int nx = (4 * F.G + F.bid < NT) ? (NT - 4 * F.G - F.bid - 1) / F.G + 1 : 0;
    const int tmain = (w >> 1) * F.G + F.bid;
    auto do_q = [&](int tile, int nlo, int nhi, int nb0) {
        if (tile >= NT) return;
        const int row0 = tile * 32; const bool lat = row0 < MLAT; const int t = (lat ? (row0 & 8191) : 0) + r32;
        bf16x8 af[16];
        int hl = hi; asm volatile("" : "+v"(hl));
#pragma unroll
        for (int s = 0; s < 16; ++s) af[s] = *(const bf16x8*)(CQN + (size_t)(row0 + r32) * 256 + 16 * s + 8 * hl);
#pragma unroll 1
        for (int nb = nlo; nb < nhi; ++nb) {
            f32x16 acc = wave_mm32t_lds<256>(af, F.lds, 32 * (nb - nb0), lane);
            if (nb % 3 == 2 && lat) {
                const f32x4* tb = (const f32x4*)(AX32 + (size_t)(hl == 0 ? (t >> 6) : 128 + (t & 63)) * 16);
#pragma unroll
                for (int q = 0; q < 4; ++q) { const f32x4 cs = tb[q];
#pragma unroll
                    for (int e = 0; e < 2; ++e) { const int j = 2 * q + e; const float c = cs[2 * e], s = cs[2 * e + 1], x1 = acc[j], x2 = acc[j + 8]; acc[j] = x1 * c - x2 * s; acc[j + 8] = x2 * c + x1 * s; } }
            }
            u32x4* d = (u32x4*)(QC + (size_t)(row0 + r32) * 384 + 32 * nb + 16 * hl);
            d[0] = (u32x4){pk2(acc[0] * QS, acc[1] * QS), pk2(acc[2] * QS, acc[3] * QS), pk2(acc[4] * QS, acc[5] * QS), pk2(acc[6] * QS, acc[7] * QS)};
            d[1] = (u32x4){pk2(acc[8] * QS, acc[9] * QS), pk2(acc[10] * QS, acc[11] * QS), pk2(acc[12] * QS, acc[13] * QS), pk2(acc[14] * QS, acc[15] * QS)};
        }
    };
    auto do_kv = [&](int tile, int nlo, int nhi) {
        if (tile >= NT) return;
        const int row0 = tile * 32;
        bf16x8 af[8];
        int hl = hi; asm volatile("" : "+v"(hl));
#pragma unroll
        for (int s = 0; s < 8; ++s) af[s] = *(const bf16x8*)(CKVN + (size_t)(row0 + r32) * 128 + 16 * s + 8 * hl);
#pragma unroll 1
        for (int nb = nlo; nb < nhi; ++nb) {
            const f32x16 acc = wave_mm32t_lds<128>(af, F.lds, 32 * nb, lane);
            const int head = nb >> 2, sub = nb & 3;
            bf16_t* dst = sub < 2 ? (KC + (size_t)(row0 + r32) * 384 + head * 96 + sub * 32) : (VC + (size_t)(row0 + r32) * 256 + head * 64 + (sub - 2) * 32);
            u32x4* d = (u32x4*)(dst + 16 * hl);
            d[0] = (u32x4){pk2(acc[0], acc[1]), pk2(acc[2], acc[3]), pk2(acc[4], acc[5]), pk2(acc[6], acc[7])};
            d[1] = (u32x4){pk2(acc[8], acc[9]), pk2(acc[10], acc[11]), pk2(acc[12], acc[13]), pk2(acc[14], acc[15])};
        }
    };
#pragma unroll 1
    for (int st = 0; st < 2; ++st) {
        __syncthreads();
        stage_weights<256, true, 192>(F, WUQ_T + (size_t)st * 192 * 256, F.lds);
        __syncthreads();
        do_q(tmain, 6 * st + 3 * (w & 1), 6 * st + 3 * (w & 1) + 3, 6 * st);
#pragma unroll 1
        for (int j = 0; j < nx; ++j) if (w < 6) do_q(4 * F.G + F.bid + j * F.G, 6 * st + w, 6 * st + w + 1, 6 * st);
    }
    __syncthreads();
    stage_weights<128, true, 512>(F, WUKV_T, F.lds);
    __syncthreads();
    do_kv(tmain, 8 * (w & 1), 8 * (w & 1) + 8);
#pragma unroll 1
    for (int j = 0; j < nx; ++j) do_kv(4 * F.G + F.bid + j * F.G, 2 * w, 2 * w + 2);
    __syncthreads();
}
__device__ __forceinline__ void ph_rwkv_featX(const Frame& F, const bf16_t* P, const RwkvW& W, const RwkvF& O) {
    const int lane = F.lane, r32 = lane & 31, hi = lane >> 5, w = F.wave;
    constexpr int DS = 2208, NT = MALL / 32;
    const int nx = (4 * F.G + F.bid < NT) ? (NT - 4 * F.G - F.bid - 1) / F.G + 1 : 0;
    __syncthreads();
    stage_weights<64, true, 512>(F, W.wup_t, F.lds); stage_weights<64, true, 512>(F, W.aup_t, F.lds + 65536);
    __syncthreads();
#pragma unroll 1
    for (int j = 0; j < 2 + nx; ++j) {
        int tile, g, nlo, nhi;
        if (j < 2) { tile = (w >> 1) * F.G + F.bid; g = 2 * (w & 1) + j; nlo = 0; nhi = 8; }
        else { tile = 4 * F.G + F.bid + (j - 2) * F.G; g = w >> 1; nlo = 4 * (w & 1); nhi = nlo + 4; }
        if (tile >= NT) continue;
        const int row0 = tile * 32; const bool lat = row0 < MLAT; const int t0 = lat ? (row0 & 8191) : ((row0 - MLAT) & 255), slen = lat ? SEQ : CTXL;
        const bool hp = !(t0 == 0 && r32 == 0), hn = !(t0 + 32 == slen && r32 == 31);
        const bf16_t* pc = P + (size_t)(row0 + r32) * NINP + DS;
        bf16x8 af[4];
        int hl = hi; asm volatile("" : "+v"(hl));
#pragma unroll
        for (int s = 0; s < 4; ++s) { const int col = 768 + 64 * g + 16 * s + 8 * hl; float z[8]; rw_z8(pc + col, hp, hn, W.mu + col, z);
            if (g < 2) {
#pragma unroll
                for (int e = 0; e < 8; ++e) z[e] = tanh_f(z[e]); }
            u32x4 wv; wv.x = pk2(z[0], z[1]); wv.y = pk2(z[2], z[3]); wv.z = pk2(z[4], z[5]); wv.w = pk2(z[6], z[7]); af[s] = __builtin_bit_cast(bf16x8, wv); }
        const float* bias = (g < 2 ? W.w0 : W.a0) + (g & 1) * 256;
        bf16_t* dst = O.BF + (size_t)(g < 2 ? 2 + g : g - 2) * (E_STRIDE / 2);
#pragma unroll 1
        for (int nb = nlo; nb < nhi; ++nb) {
            const f32x16 acc = wave_mm32t_lds<64>(af, F.lds, g * 256 + 32 * nb, lane);
            const int c0 = 32 * nb + 16 * hl; const f32x4* bp = (const f32x4*)(bias + c0);
            auto act = [&](float x) { const float sg = sigmoid_f(x); return g < 2 ? 0.6065306597126334f * sg : sg; };
            const f32x4 b0 = bp[0], b1 = bp[1], b2 = bp[2], b3 = bp[3];
            u32x4 o0, o1;
            o0.x = pk2(act(b0.x + acc[0]), act(b0.y + acc[1])); o0.y = pk2(act(b0.z + acc[2]), act(b0.w + acc[3]));
            o0.z = pk2(act(b1.x + acc[4]), act(b1.y + acc[5])); o0.w = pk2(act(b1.z + acc[6]), act(b1.w + acc[7]));
            o1.x = pk2(act(b2.x + acc[8]), act(b2.y + acc[9])); o1.y = pk2(act(b2.z + acc[10]), act(b2.w + acc[11]));
            o1.z = pk2(act(b3.x + acc[12]), act(b3.y + acc[13])); o1.w = pk2(act(b3.z + acc[14]), act(b3.w + acc[15]));
            u32x4* d = (u32x4*)(dst + (size_t)(row0 + r32) * 256 + c0);
            d[0] = o0; d[1] = o1;
        }
    }
    __syncthreads();
    stage_weights<128, true, 256>(F, W.gup_t, F.lds);
    __syncthreads();
#pragma unroll 1
    for (int j = 0; j < 1 + nx; ++j) {
        int tile, nlo, nhi;
        if (j < 1) { tile = (w >> 1) * F.G + F.bid; nlo = 4 * (w & 1); nhi = nlo + 4; }
        else { tile = 4 * F.G + F.bid + (j - 1) * F.G; nlo = w; nhi = w + 1; }
        if (tile >= NT) continue;
        const int row0 = tile * 32; const bool lat = row0 < MLAT; const int t0 = lat ? (row0 & 8191) : ((row0 - MLAT) & 255), slen = lat ? SEQ : CTXL;
        const bool hp = !(t0 == 0 && r32 == 0), hn = !(t0 + 32 == slen && r32 == 31);
        const bf16_t* pc = P + (size_t)(row0 + r32) * NINP + DS;
        bf16x8 af[8];
        int hl = hi; asm volatile("" : "+v"(hl));
#pragma unroll
        for (int s = 0; s < 8; ++s) { const int col = 1024 + 16 * s + 8 * hl; float z[8]; rw_z8(pc + col, hp, hn, W.mu + col, z);
#pragma unroll
            for (int e = 0; e < 8; ++e) z[e] = sigmoid_f(z[e]);
            u32x4 wv; wv.x = pk2(z[0], z[1]); wv.y = pk2(z[2], z[3]); wv.z = pk2(z[4], z[5]); wv.w = pk2(z[6], z[7]); af[s] = __builtin_bit_cast(bf16x8, wv); }
#pragma unroll 1
        for (int nb = nlo; nb < nhi; ++nb) {
            const f32x16 acc = wave_mm32t_lds<128>(af, F.lds, 32 * nb, lane);
            u32x4* d = (u32x4*)(O.G + (size_t)(row0 + r32) * 256 + 32 * nb + 16 * hl);
            d[0] = (u32x4){pk2(acc[0], acc[1]), pk2(acc[2], acc[3]), pk2(acc[4], acc[5]), pk2(acc[6], acc[7])};
            d[1] = (u32x4){pk2(acc[8], acc[9]), pk2(acc[10], acc[11]), pk2(acc[12], acc[13]), pk2(acc[14], acc[15])};
        }
    }
    __syncthreads();
}
__device__ __forceinline__ void unpack8(const u32x4& w, float (&o)[8]) {
#pragma unroll
    for (int i = 0; i < 4; ++i) { o[2 * i] = __uint_as_float(w[i] << 16); o[2 * i + 1] = __uint_as_float(w[i] & 0xffff0000u); } }
__device__ __forceinline__ float grp8_sum(float v) { v += __shfl_xor(v, 1); v += __shfl_xor(v, 2); v += __shfl_xor(v, 4); return v; }
__device__ __forceinline__ void ph_rwkv_featY(const Frame& F, const bf16_t* P, const RwkvW& W, const RwkvF& O) {
    constexpr int DS = 2208;
    const int lane = F.lane, l32 = lane & 31, c0 = 8 * l32;
    for (int rp = F.gw; rp < MALL / 2; rp += F.ngw) {
        const int row = 2 * rp + (lane >> 5);
        const bool lat = row < MLAT; const int t = lat ? (row & 8191) : ((row - MLAT) & 255), slen = lat ? SEQ : CTXL;
        const bool hp = t != 0, hn = t != slen - 1;
        float z[3][8];
#pragma unroll
        for (int sec = 0; sec < 3; ++sec) rw_z8(P + (size_t)row * NINP + DS + 256 * sec + c0, hp, hn, W.mu + 256 * sec + c0, z[sec]);
        const size_t o = (size_t)row * 256 + c0;
        float af[8], ab[8], kkw[8], kaw[8], rkw[8];
        unpack8(*(const u32x4*)(O.BF + o), af); unpack8(*(const u32x4*)(O.BB + o), ab);
#pragma unroll
        for (int h = 0; h < 2; ++h) { const f32x4 a = *(const f32x4*)(W.k_k + c0 + 4 * h), bq = *(const f32x4*)(W.k_a + c0 + 4 * h), cq = *(const f32x4*)(W.r_k + c0 + 4 * h);
#pragma unroll
            for (int e = 0; e < 4; ++e) { kkw[4 * h + e] = a[e]; kaw[4 * h + e] = bq[e]; rkw[4 * h + e] = cq[e]; } }
        float kx[8], ss = 0.f;
#pragma unroll
        for (int e = 0; e < 8; ++e) { kx[e] = z[1][e] * kkw[e]; ss += kx[e] * kx[e]; }
        const float inv = 1.f / fmaxf(sqrtf(grp8_sum(ss)), 1e-12f);
        float kk[8], kf[8], kb[8], bfv[8], bbv[8], bon = 0.f;
#pragma unroll
        for (int e = 0; e < 8; ++e) { kk[e] = kx[e] * inv; kf[e] = z[1][e] * (1.f + (af[e] - 1.f) * kaw[e]); kb[e] = z[1][e] * (1.f + (ab[e] - 1.f) * kaw[e]); bon += z[0][e] * (kf[e] + kb[e]) * rkw[e];
            bfv[e] = kk[e] * af[e]; bbv[e] = kk[e] * ab[e]; }
        bon = grp8_sum(bon);
        if ((l32 & 7) == 0) O.BONUS[(size_t)row * 4 + (l32 >> 3)] = bon;
#define ST8(arr, v) *(u32x4*)((arr) + o) = (u32x4){pk2((v)[0], (v)[1]), pk2((v)[2], (v)[3]), pk2((v)[4], (v)[5]), pk2((v)[6], (v)[7])}
        ST8(O.R, z[0]); ST8(O.V, z[2]); ST8(O.KF, kf); ST8(O.KB, kb); ST8(O.KK, kk); ST8(O.BF, bfv); ST8(O.BB, bbv);
#undef ST8
    }
}

__device__ __forceinline__ void ph_rwkv_scan(const Frame& F, const RwkvF& I, bf16_t* REF) {
    if (F.bid < 4 || F.bid >= 8 || F.wave != 0) return;
    const int task = 9 * (F.bid - 4), dir = task & 1, hd = (task >> 1) & 3, b = task >> 3, lane = F.lane;
    const bf16_t* Ed = dir ? I.EB : I.EF; const bf16_t* Kd = dir ? I.KB : I.KF; const bf16_t* Bd = dir ? I.BB : I.BF;
    float S[64];
#pragma unroll
    for (int k = 0; k < 64; ++k) S[k] = 0.f;
#define RL(x, k) __int_as_float(__builtin_amdgcn_readlane(__float_as_int(x), k))
    for (int seg = 0; seg < 2; ++seg) {
        const int n = seg == 0 ? CTXL : SEQ; const int base = seg == 0 ? MLAT + b * CTXL : b * SEQ;
        for (int st = 0; st < n; ++st) {
            const int row = base + (dir == 0 ? st : n - 1 - st); const size_t o = (size_t)row * 256 + hd * 64 + lane;
            const float w = __expf(-bf2f(Ed[o])), kk = bf2f(I.KK[o]), bb = bf2f(Bd[o]), kh = bf2f(Kd[o]), rr = bf2f(I.R[o]), v = bf2f(I.V[o]);
            float sa = 0.f;
#pragma unroll
            for (int k = 0; k < 64; ++k) sa -= S[k] * RL(kk, k);
            float y = 0.f;
#pragma unroll
            for (int k = 0; k < 64; ++k) { S[k] = S[k] * RL(w, k) + sa * RL(bb, k) + v * RL(kh, k); y += S[k] * RL(rr, k); }
            REF[((size_t)F.bid * 8448 + (seg == 0 ? row - base : 256 + row - base)) * 64 + lane] = (bf16_t)f2bf(y);
        }
    }
#undef RL
}
__device__ __forceinline__ void ph_rwkv_combine(const Frame& F, const bf16_t* RWY, const RwkvF& I, const float* lnx_w, const float* lnx_b, bf16_t* YB, int nrows) {
    for (int row = F.gw; row < nrows; row += F.ngw) {
        const u32x2 y0 = *((const u32x2*)(RWY + (size_t)row * 256) + F.lane), y1 = *((const u32x2*)(RWY + ((size_t)MALL + row) * 256) + F.lane);
        const u32x2 vw = *((const u32x2*)(I.V + (size_t)row * 256) + F.lane), gw = *((const u32x2*)(I.G + (size_t)row * 256) + F.lane);
        float y[4] = {__uint_as_float(y0.x << 16) + __uint_as_float(y1.x << 16), __uint_as_float(y0.x & 0xffff0000u) + __uint_as_float(y1.x & 0xffff0000u),
                      __uint_as_float(y0.y << 16) + __uint_as_float(y1.y << 16), __uint_as_float(y0.y & 0xffff0000u) + __uint_as_float(y1.y & 0xffff0000u)};
        const float v[4] = {__uint_as_float(vw.x << 16), __uint_as_float(vw.x & 0xffff0000u), __uint_as_float(vw.y << 16), __uint_as_float(vw.y & 0xffff0000u)};
        const float g[4] = {__uint_as_float(gw.x << 16), __uint_as_float(gw.x & 0xffff0000u), __uint_as_float(gw.y << 16), __uint_as_float(gw.y & 0xffff0000u)};
        const float mean = grp16_sum(y[0] + y[1] + y[2] + y[3]) * (1.f / 64.f);
        float s2 = 0.f;
#pragma unroll
        for (int e = 0; e < 4; ++e) { y[e] -= mean; s2 += y[e] * y[e]; }
        const float rstd = 1.f / sqrtf(grp16_sum(s2) * (1.f / 64.f) + 64e-5f);
        const float bonus = I.BONUS[(size_t)row * 4 + (F.lane >> 4)];
        const f32x4 lw = *((const f32x4*)lnx_w + F.lane), lb = *((const f32x4*)lnx_b + F.lane);
        float o[4];
#pragma unroll
        for (int e = 0; e < 4; ++e) o[e] = (y[e] * rstd * lw[e] + lb[e] + bonus * v[e]) * g[e];
        *((u32x2*)(YB + (size_t)row * D + 768) + F.lane) = (u32x2){pk2(o[0], o[1]), pk2(o[2], o[3])};
    }
}


constexpr int CP = 72;
constexpr int CK_LF = 0, CK_AL = 17408, CK_ALT = 26624, CK_BE = 35840, CK_KA = 45056, CK_RH = 54272, CK_BPT = 63488, CK_KPT = 72704, CK_VT = 81920, CK_TT = 91136, CK_AK = 100352, CK_M1 = 109568, CK_M2 = 118784;
static_assert(CK_M2 + 9216 <= RING_BYTES, "chunk LDS map");
constexpr int CK_GC = LDSCTL_OFF + 4096;
struct ChunkSrc { const bf16_t *E, *KK, *B, *KH, *R, *V; int ldv; float econst; const float* rtab; };
__device__ __forceinline__ int chunk_row(int b, int dir, int c, int t) {
    const bool ctx = c < 4; const int n = ctx ? CTXL : SEQ, st = (ctx ? 64 * c : 64 * (c - 4)) + t;
    return (ctx ? MLAT + b * CTXL : b * SEQ) + (dir ? n - 1 - st : st);
}
__device__ __forceinline__ f32x16 nt_tile(const LAS unsigned char* X, const LAS unsigned char* Y, int mi, int ni, int lane) {
    const int r32 = lane & 31, hi = lane >> 5;
    const LAS unsigned char* xp = X + ((32 * mi + r32) * CP + 8 * hi) * 2; const LAS unsigned char* yp = Y + ((32 * ni + r32) * CP + 8 * hi) * 2;
    f32x16 acc = {0.f,0.f,0.f,0.f,0.f,0.f,0.f,0.f,0.f,0.f,0.f,0.f,0.f,0.f,0.f,0.f};
#pragma unroll
    for (int s = 0; s < 4; ++s) acc = __builtin_amdgcn_mfma_f32_32x32x16_bf16(*(const LAS bf16x8*)(xp + 32 * s), *(const LAS bf16x8*)(yp + 32 * s), acc, 0, 0, 0);
    return acc;
}
__device__ __forceinline__ void st_tile_bf16(LAS unsigned char* M, int mi, int ni, int lane, const f32x16& v) {
    const int r32 = lane & 31, hi = lane >> 5; LAS bf16_t* p = (LAS bf16_t*)M + (32 * mi + 4 * hi) * CP + 32 * ni + r32;
#pragma unroll
    for (int r = 0; r < 16; ++r) p[((r & 3) + 8 * (r >> 2)) * CP] = (bf16_t)f2bf(v[r]);
}
struct ChunkRegs { u32x4 e, kh, r, kk, b, v; f32x4 tb[4]; };
template <bool DELTA> __device__ __forceinline__ void chunk_load(const Frame& F, const ChunkSrc& s, int b, int dir, int c, ChunkRegs& q) {
    const int t = F.tid >> 3, c0 = 8 * (F.tid & 7); const size_t row = (size_t)chunk_row(b, dir, c, t);
    q.v = *(const u32x4*)(s.V + row * s.ldv + c0);
    if (DELTA) { q.kh = *(const u32x4*)(s.KH + row * 256 + c0); q.r = *(const u32x4*)(s.R + row * 256 + c0);
        q.e = *(const u32x4*)(s.E + row * 256 + c0); q.kk = *(const u32x4*)(s.KK + row * 256 + c0); q.b = *(const u32x4*)(s.B + row * 256 + c0); }
    else { const int cp = c0 ^ 32;
        q.kh = *(const u32x4*)(s.KH + row * s.ldv + c0); q.kk = *(const u32x4*)(s.KH + row * s.ldv + cp);
        q.r = *(const u32x4*)(s.R + row * s.ldv + c0); q.e = *(const u32x4*)(s.R + row * s.ldv + cp);
        const int pos = row < (size_t)MLAT ? 256 + (int)(row & 8191) : (int)((row - MLAT) & 255);
        const f32x4* tp = (const f32x4*)(s.rtab + (size_t)pos * 64 + 2 * (c0 & 31));
#pragma unroll
        for (int i = 0; i < 4; ++i) q.tb[i] = tp[i]; }
}
template <bool DELTA, bool W3> __device__ __forceinline__ void chunk_prep(const Frame& F, const ChunkRegs& q, float econst) {
    LAS unsigned char* lds = F.lds; LAS float* LF = (LAS float*)(lds + CK_LF);
    const int tid = F.tid, t = tid >> 3, cg = tid & 7, c0 = 8 * cg;
    float e[8], L[8], L63[8];
    if (DELTA) {
        unpack8(q.e, e);
#pragma unroll
        for (int i = 0; i < 8; ++i) LF[t * 68 + c0 + i] = e[i];
        __syncthreads();
        { const int cc = tid & 63, sg = tid >> 6; float run = 0.f;
#pragma unroll
          for (int i = 0; i < 8; ++i) { run += LF[(8 * sg + i) * 68 + cc]; LF[(8 * sg + i) * 68 + cc] = run; } }
        __syncthreads();
#pragma unroll
        for (int i = 0; i < 8; ++i) { float pre = 0.f, tot = 0.f;
#pragma unroll
            for (int g = 0; g < 8; ++g) { const float seg = LF[(8 * g + 7) * 68 + c0 + i]; tot += seg; pre += (g < (t >> 3)) ? seg : 0.f; }
            L[i] = LF[t * 68 + c0 + i] + pre; L63[i] = tot; }
        __syncthreads();
    } else {
#pragma unroll
        for (int i = 0; i < 8; ++i) { e[i] = econst; L[i] = (float)(t + 1) * econst; L63[i] = 64.f * econst; }
    }
    if (t == 0) { LAS float* gc = (LAS float*)(lds + CK_GC);
#pragma unroll
        for (int i = 0; i < 8; ++i) gc[c0 + i] = __expf(-L63[i]); }
    float kk[8], bb[8], kh[8], rr[8];
    unpack8(q.kh, kh); unpack8(q.r, rr);
    if (DELTA) { unpack8(q.kk, kk); unpack8(q.b, bb); }
    else { float kp_[8], qp_[8]; unpack8(q.kk, kp_); unpack8(q.e, qp_);
        const bool first = c0 < 32;
#pragma unroll
        for (int i = 0; i < 8; ++i) { const float cs = q.tb[i >> 1][2 * (i & 1)], sn = q.tb[i >> 1][2 * (i & 1) + 1];
            kh[i] = 0.125f * (first ? kh[i] * cs - kp_[i] * sn : kh[i] * cs + kp_[i] * sn); rr[i] = first ? rr[i] * cs - qp_[i] * sn : rr[i] * cs + qp_[i] * sn; } }
    LAS bf16_t* VT = (LAS bf16_t*)(lds + CK_VT);
#pragma unroll
    for (int i = 0; i < 4; ++i) { VT[(c0 + 2 * i) * CP + t] = (bf16_t)(q.v[i] & 0xffffu); VT[(c0 + 2 * i + 1) * CP + t] = (bf16_t)(q.v[i] >> 16); }
    float al[8], be[8], ka[8], rh[8], bp[8], kp[8];
#pragma unroll
    for (int i = 0; i < 8; ++i) { const float up = __expf(L[i]), dn = __expf(-L[i]), tail = __expf(L[i] - L63[i]);
        ka[i] = kh[i] * up; rh[i] = rr[i] * dn; kp[i] = kh[i] * tail;
        if (DELTA) { al[i] = kk[i] * __expf(e[i] - L[i]); be[i] = bb[i] * up; bp[i] = bb[i] * tail; } }
    auto st8 = [&](int off, const float (&x)[8]) { u32x4 w; w.x = pk2(x[0], x[1]); w.y = pk2(x[2], x[3]); w.z = pk2(x[4], x[5]); w.w = pk2(x[6], x[7]); *(LAS u32x4*)(lds + off + (t * CP + c0) * 2) = w; };
    auto st8t = [&](int off, const float (&x)[8]) { LAS bf16_t* p = (LAS bf16_t*)(lds + off) + c0 * CP + t;
#pragma unroll
        for (int i = 0; i < 8; ++i) p[i * CP] = (bf16_t)f2bf(x[i]); };
    st8(CK_KA, ka);
    if (W3) st8(CK_RH, rh); else st8t(CK_KPT, kp);
    if (DELTA) { st8(CK_AL, al); st8t(CK_ALT, al); st8(CK_BE, be); if (!W3) st8t(CK_BPT, bp); }
    __syncthreads();
}
__device__ __forceinline__ void chunk_AbT(const Frame& F, int mi, int ni) {
    const int lane = F.lane, r32 = lane & 31, hi = lane >> 5;
    const f32x16 a = nt_tile(F.lds + CK_BE, F.lds + CK_AL, mi, ni, lane);
    LAS float* A = (LAS float*)(F.lds + CK_LF) + (32 * mi + 4 * hi) * 68 + 32 * ni + r32; const int t = 32 * ni + r32;
#pragma unroll
    for (int r = 0; r < 16; ++r) { const int io = (r & 3) + 8 * (r >> 2); A[io * 68] = (32 * mi + 4 * hi + io < t) ? a[r] : 0.f; }
}
__device__ __forceinline__ void chunk_Ak(const Frame& F, int mi, int ni) {
    const int lane = F.lane, r32 = lane & 31, hi = lane >> 5;
    f32x16 a = nt_tile(F.lds + CK_KA, F.lds + CK_AL, mi, ni, lane);
#pragma unroll
    for (int r = 0; r < 16; ++r) if (!(32 * mi + crow(r, hi) < 32 * ni + r32)) a[r] = 0.f;
    st_tile_bf16(F.lds + CK_AK, mi, ni, lane, a);
}
__device__ __forceinline__ void chunk_BT(const Frame& F, int xoff, int moff, int mi, int ni) {
    const int lane = F.lane, r32 = lane & 31, hi = lane >> 5;
    f32x16 a = nt_tile(F.lds + CK_RH, F.lds + xoff, mi, ni, lane);
#pragma unroll
    for (int r = 0; r < 16; ++r) if (!(32 * ni + r32 <= 32 * mi + crow(r, hi))) a[r] = 0.f;
    st_tile_bf16(F.lds + moff, mi, ni, lane, a);
}
__device__ __forceinline__ void chunk_solve(const Frame& F) {
    const LAS float* A = (const LAS float*)(F.lds + CK_LF);
    LAS float* Tf = (LAS float*)(F.lds + CK_BE);
    const int lane = F.lane, w = F.wave, i16 = lane & 15, q4 = lane >> 4;
    if (w < 4) { const int B = w;
        float acc[16];
#pragma unroll
        for (int k = 0; k < 16; ++k) acc[k] = (i16 == k) ? 1.f : 0.f;
#pragma unroll
        for (int jj = 0; jj < 15; ++jj) { const LAS f32x4* ar = (const LAS f32x4*)(A + (16 * B + jj) * 68 + 16 * B);
#pragma unroll
            for (int q = 0; q < 4; ++q) { if (4 * q + 3 > jj) { const f32x4 a4 = ar[q];
#pragma unroll
                for (int k = 0; k < 4; ++k) if (4 * q + k > jj) acc[4 * q + k] -= acc[jj] * a4[k]; } } }
        if (lane < 16) {
#pragma unroll
            for (int q = 0; q < 4; ++q) *(LAS f32x4*)(Tf + (16 * B + i16) * 68 + 16 * B + 4 * q) = (f32x4){acc[4 * q], acc[4 * q + 1], acc[4 * q + 2], acc[4 * q + 3]}; }
    }
    __syncthreads();
    if (w < 3) { const int I = w;
#pragma unroll 1
        for (int B = I + 1; B < 4; ++B) {
            f32x4 x = {0.f, 0.f, 0.f, 0.f};
#pragma unroll 1
            for (int K = I; K < B; ++K) {
#pragma unroll
                for (int s = 0; s < 4; ++s) x = __builtin_amdgcn_mfma_f32_16x16x4f32(Tf[(16 * I + i16) * 68 + 16 * K + 4 * s + q4], A[(16 * K + 4 * s + q4) * 68 + 16 * B + i16], x, 0, 0, 0); }
            LAS float* tb = Tf + (16 * I + 4 * q4) * 68 + 16 * B + i16;
#pragma unroll
            for (int r = 0; r < 4; ++r) tb[r * 68] = x[r];
            f32x4 y = {0.f, 0.f, 0.f, 0.f};
#pragma unroll
            for (int s = 0; s < 4; ++s) y = __builtin_amdgcn_mfma_f32_16x16x4f32(Tf[(16 * I + i16) * 68 + 16 * B + 4 * s + q4], Tf[(16 * B + 4 * s + q4) * 68 + 16 * B + i16], y, 0, 0, 0);
#pragma unroll
            for (int r = 0; r < 4; ++r) tb[r * 68] = -y[r];
        }
    }
    __syncthreads();
    { const int row = F.tid >> 3, c8 = F.tid & 7; const LAS float* s = Tf + row * 68 + 8 * c8; const f32x4 v0 = *(const LAS f32x4*)s, v1 = *(const LAS f32x4*)(s + 4);
      const bool z = (c8 >> 1) < (row >> 4);
      u32x4 o; o.x = z ? 0u : pk2(v0[0], v0[1]); o.y = z ? 0u : pk2(v0[2], v0[3]); o.z = z ? 0u : pk2(v1[0], v1[1]); o.w = z ? 0u : pk2(v1[2], v1[3]);
      *(LAS u32x4*)((LAS bf16_t*)(F.lds + CK_TT) + row * CP + 8 * c8) = o; }
}
constexpr int TS1_ITEMS = (int)(((size_t)MALL * 384 * 2) / 8192);
__device__ __forceinline__ bf16_t* tstash(unsigned char* ws, int item) { return item < TS1_ITEMS ? (bf16_t*)(ws + T_CQN) + (size_t)item * 4096 : (bf16_t*)(ws + T_PZ + PZ_BYTES) + (size_t)(item - TS1_ITEMS) * 4096; }
static_assert(T_PZ + PZ_BYTES + (size_t)(32 * NCHUNK - TS1_ITEMS) * 8192 <= T_YB, "T stash map");
#define RWKV_SRC(I, dir, hd) ChunkSrc{((dir) ? (I).EB : (I).EF) + (hd) * 64, (I).KK + (hd) * 64, ((dir) ? (I).BB : (I).BF) + (hd) * 64, ((dir) ? (I).KB : (I).KF) + (hd) * 64, (I).R + (hd) * 64, (I).V + (hd) * 64, 256, 0.f, nullptr}
__device__ __forceinline__ void ph_rwkv_w1(const Frame& F, const RwkvF& I, bf16_t* PZ, unsigned char* ws) {
    const int lane = F.lane, w = F.wave, r32 = lane & 31, hi = lane >> 5, mi = (w >> 1) & 1, ni = w & 1;
    ChunkRegs q;
    if (F.bid < 32 * NCHUNK) { const int task = F.bid / NCHUNK, c = F.bid % NCHUNK; chunk_load<true>(F, RWKV_SRC(I, task & 1, (task >> 1) & 3), task >> 3, task & 1, c, q); }
    for (int item = F.bid; item < 32 * NCHUNK; item += F.G) {
        const int c = item % NCHUNK;
        chunk_prep<true, false>(F, q, 0.f);
        { const int nx = item + F.G; if (nx < 32 * NCHUNK) { const int task = nx / NCHUNK, cn = nx % NCHUNK; chunk_load<true>(F, RWKV_SRC(I, task & 1, (task >> 1) & 3), task >> 3, task & 1, cn, q); } }
        (void)c;
        if (w < 4) chunk_AbT(F, mi, ni); else chunk_Ak(F, mi, ni);
        __syncthreads();
        chunk_solve(F);
        __syncthreads();
        { const int rr_ = F.tid >> 3, c8 = F.tid & 7; *(u32x4*)(tstash(ws, item) + rr_ * 64 + 8 * c8) = *(const LAS u32x4*)(F.lds + CK_TT + (rr_ * CP + 8 * c8) * 2); }
        if (w < 4) { const f32x16 g = nt_tile(F.lds + CK_BPT, F.lds + CK_TT, mi, ni, lane); st_tile_bf16(F.lds + CK_M1, mi, ni, lane, g); }
        __syncthreads();
        if (w < 4) { f32x16 p = nt_tile(F.lds + CK_M1, F.lds + CK_ALT, mi, ni, lane);
            const float gc = ((const LAS float*)(F.lds + CK_GC))[32 * ni + r32];
#pragma unroll
            for (int r = 0; r < 16; ++r) p[r] = ((32 * mi + crow(r, hi) == 32 * ni + r32) ? gc : 0.f) - p[r];
            st_tile_bf16(F.lds + CK_BE, mi, ni, lane, p); }
        else { f32x16 qq = nt_tile(F.lds + CK_M1, F.lds + CK_AK, mi, ni, lane);
            const LAS bf16_t* kp = (const LAS bf16_t*)(F.lds + CK_KPT) + (32 * mi + 4 * hi) * CP + 32 * ni + r32;
#pragma unroll
            for (int r = 0; r < 16; ++r) qq[r] = bf2f(kp[((r & 3) + 8 * (r >> 2)) * CP]) - qq[r];
            st_tile_bf16(F.lds + CK_M2, mi, ni, lane, qq); }
        __syncthreads();
        bf16_t* pz = PZ + (size_t)item * 8192;
        if (w < 4) { const f32x16 z = nt_tile(F.lds + CK_M2, F.lds + CK_VT, mi, ni, lane);
            u32x4 o0, o1;
#pragma unroll
            for (int e = 0; e < 4; ++e) { o0[e] = pg8::cvt_pk_bf16(z[2 * e], z[2 * e + 1]); o1[e] = pg8::cvt_pk_bf16(z[8 + 2 * e], z[8 + 2 * e + 1]); }
            u32x4* zo = (u32x4*)(pz + 4096 + ((ni * 2 + mi) * 64 + lane) * 16); zo[0] = o0; zo[1] = o1; }
        else {
#pragma unroll
            for (int qf = 0; qf < 2; ++qf) { const int f = (w - 4) * 2 + qf, co = f >> 2, sidx = f & 3;
                const LAS unsigned char* rp = F.lds + CK_BE + ((32 * co + r32) * CP + 16 * sidx + 4 * hi) * 2;
                const u32x2 lo = *(const LAS u32x2*)rp, hh = *(const LAS u32x2*)(rp + 16);
                *(u32x4*)(pz + (f * 64 + lane) * 8) = (u32x4){lo.x, lo.y, hh.x, hh.y}; } }
        __syncthreads();
    }
}
__device__ __forceinline__ void ph_rwkv_w2(const Frame& F, bf16_t* PZ) {
    if (F.bid >= 64 || F.wave != 0) return;
    const int lane = F.lane, r32 = lane & 31, hi = lane >> 5, task = F.bid >> 1, vi = F.bid & 1;
    const f32x16 z16 = {0.f,0.f,0.f,0.f,0.f,0.f,0.f,0.f,0.f,0.f,0.f,0.f,0.f,0.f,0.f,0.f};
    (void)z16;
    bf16_t* pz = PZ + (size_t)task * NCHUNK * 8192;
    LAS unsigned char* ring = F.lds;
    constexpr int SLOT = 12288, NB = NCHUNK / 4;
#define W2_ISSUE(cc, slot) do { const bf16_t* p_ = pz + (size_t)(cc) * 8192; LAS unsigned char* d_ = ring + (slot) * SLOT; \
        _Pragma("unroll") for (int f_ = 0; f_ < 8; ++f_) __builtin_amdgcn_global_load_lds((const unsigned*)(p_ + (f_ * 64 + lane) * 8), (LAS unsigned*)(d_ + f_ * 1024), 16, 0, 0); \
        _Pragma("unroll") for (int q_ = 0; q_ < 4; ++q_) __builtin_amdgcn_global_load_lds((const unsigned*)(p_ + 4096 + ((vi * 2 + (q_ >> 1)) * 64 + lane) * 16 + 8 * (q_ & 1)), (LAS unsigned*)(d_ + 8192 + q_ * 1024), 16, 0, 0); } while (0)
#pragma unroll
    for (int k = 0; k < 4; ++k) W2_ISSUE(k, k);
    bf16x8 xh[4], xl[4];
    { const bf16x8 zf = {0, 0, 0, 0, 0, 0, 0, 0};
#pragma unroll
      for (int s = 0; s < 4; ++s) { xh[s] = zf; xl[s] = zf; } }
#pragma unroll 1
    for (int bt = 0; bt < NB; ++bt) {
        asm volatile("s_waitcnt vmcnt(0)" ::: "memory");
        if (bt + 1 < NB) {
#pragma unroll
            for (int k = 0; k < 4; ++k) W2_ISSUE(4 * (bt + 1) + k, ((bt + 1) & 1) * 4 + k); }
#pragma unroll
        for (int k = 0; k < 4; ++k) {
            const int c = 4 * bt + k; const LAS unsigned char* sl = ring + ((bt & 1) * 4 + k) * SLOT + lane * 16;
            bf16x8 nh[4], nl[4];
            { bf16_t* so = pz + (size_t)c * 8192 + 4096 + (size_t)(32 * vi + r32) * 64;
#pragma unroll
              for (int s = 0; s < 4; ++s) { const u32x4 wh = __builtin_bit_cast(u32x4, xh[s]);
                  *(u32x2*)(so + 32 * (s >> 1) + 4 * hi + 16 * (s & 1)) = (u32x2){wh[0], wh[1]}; *(u32x2*)(so + 32 * (s >> 1) + 4 * hi + 16 * (s & 1) + 8) = (u32x2){wh[2], wh[3]}; } }
#pragma unroll
            for (int co = 0; co < 2; ++co) { const u32x4 z0 = *(const LAS u32x4*)(sl + 8192 + (co * 2) * 1024), z1 = *(const LAS u32x4*)(sl + 8192 + (co * 2 + 1) * 1024); f32x16 acc;
#pragma unroll
                for (int e = 0; e < 4; ++e) { acc[2 * e] = __uint_as_float(z0[e] << 16); acc[2 * e + 1] = __uint_as_float(z0[e] & 0xffff0000u);
                                              acc[8 + 2 * e] = __uint_as_float(z1[e] << 16); acc[8 + 2 * e + 1] = __uint_as_float(z1[e] & 0xffff0000u); }
#pragma unroll
                for (int s = 0; s < 4; ++s) { const bf16x8 pf = *(const LAS bf16x8*)(sl + (co * 4 + s) * 1024);
                    acc = __builtin_amdgcn_mfma_f32_32x32x16_bf16(pf, xh[s], acc, 0, 0, 0); acc = __builtin_amdgcn_mfma_f32_32x32x16_bf16(pf, xl[s], acc, 0, 0, 0); }
#pragma unroll
                for (int q = 0; q < 2; ++q) { u32x4 wh, wl;
#pragma unroll
                    for (int e = 0; e < 4; ++e) { const float a0 = acc[8 * q + 2 * e], a1 = acc[8 * q + 2 * e + 1];
                        const unsigned ph = pg8::cvt_pk_bf16(a0, a1); wh[e] = ph;
                        wl[e] = pg8::cvt_pk_bf16(a0 - __uint_as_float(ph << 16), a1 - __uint_as_float(ph & 0xffff0000u)); }
                    nh[2 * co + q] = __builtin_bit_cast(bf16x8, wh); nl[2 * co + q] = __builtin_bit_cast(bf16x8, wl); }
            }
#pragma unroll
            for (int s = 0; s < 4; ++s) { xh[s] = nh[s]; xl[s] = nl[s]; }
        }
    }
#undef W2_ISSUE
}
template <bool DELTA> __device__ __forceinline__ void chunk_out(const Frame& F, const ChunkRegs& q, float econst, const bf16_t* S0  , const bf16_t* Tst  , int b, int dir, int c, bf16_t* Yout) {
    const int lane = F.lane, w = F.wave, r32 = lane & 31, hi = lane >> 5, mi = (w >> 1) & 1, ni = w & 1;
    u32x4 s0r, ttr = {0u, 0u, 0u, 0u};
    { const int v = F.tid >> 3, c8 = F.tid & 7; s0r = *(const u32x4*)(S0 + v * 64 + 8 * c8); if (DELTA) ttr = *(const u32x4*)(Tst + v * 64 + 8 * c8); }
    chunk_prep<DELTA, true>(F, q, econst);
    { const int v = F.tid >> 3, c8 = F.tid & 7; *(LAS u32x4*)(F.lds + CK_BPT + (v * CP + 8 * c8) * 2) = s0r;
      if (DELTA) *(LAS u32x4*)(F.lds + CK_TT + (v * CP + 8 * c8) * 2) = ttr; }
    if (DELTA) {
        if (w < 4) chunk_BT(F, CK_BE, CK_M1, mi, ni); else { chunk_Ak(F, mi, ni); chunk_BT(F, CK_KA, CK_M2, mi, ni); }
        __syncthreads();
        if (w < 4) { const f32x16 h = nt_tile(F.lds + CK_M1, F.lds + CK_TT, mi, ni, lane); st_tile_bf16(F.lds + CK_BE, mi, ni, lane, h); }
        __syncthreads();
        if (w < 4) { f32x16 qe = nt_tile(F.lds + CK_BE, F.lds + CK_ALT, mi, ni, lane);
            const LAS bf16_t* rp = (const LAS bf16_t*)(F.lds + CK_RH) + (32 * mi + 4 * hi) * CP + 32 * ni + r32;
#pragma unroll
            for (int r = 0; r < 16; ++r) qe[r] = bf2f(rp[((r & 3) + 8 * (r >> 2)) * CP]) - qe[r];
            st_tile_bf16(F.lds + CK_KA, mi, ni, lane, qe); }
        else { f32x16 n = nt_tile(F.lds + CK_BE, F.lds + CK_AK, mi, ni, lane);
            LAS bf16_t* mp = (LAS bf16_t*)(F.lds + CK_M2) + (32 * mi + 4 * hi) * CP + 32 * ni + r32;
#pragma unroll
            for (int r = 0; r < 16; ++r) { const int o = ((r & 3) + 8 * (r >> 2)) * CP; mp[o] = (bf16_t)f2bf(bf2f(mp[o]) - n[r]); } }
        __syncthreads();
    } else {
        if (w < 4) chunk_BT(F, CK_KA, CK_M2, mi, ni);
        __syncthreads();
    }
    if (w < 4) { const f32x16 y0 = nt_tile(F.lds + (DELTA ? CK_KA : CK_RH), F.lds + CK_BPT, mi, ni, lane), y1 = nt_tile(F.lds + CK_M2, F.lds + CK_VT, mi, ni, lane);
#pragma unroll
        for (int r = 0; r < 16; ++r) { const int t = 32 * mi + crow(r, hi); Yout[(size_t)chunk_row(b, dir, c, t) * 256 + 32 * ni + r32] = (bf16_t)f2bf(y0[r] + y1[r]); } }
    __syncthreads();
}
__device__ __forceinline__ void ph_rwkv_w3(const Frame& F, const RwkvF& I, const bf16_t* PZ, bf16_t* RWY, unsigned char* ws) {
    ChunkRegs q;
    if (F.bid < 32 * NCHUNK) { const int task = F.bid / NCHUNK, c = F.bid % NCHUNK; chunk_load<true>(F, RWKV_SRC(I, task & 1, (task >> 1) & 3), task >> 3, task & 1, c, q); }
    for (int item = F.bid; item < 32 * NCHUNK; item += F.G) {
        const int task = item / NCHUNK, c = item % NCHUNK, dir = task & 1, hd = (task >> 1) & 3, b = task >> 3;
        const ChunkRegs cur = q;
        { const int nx = item + F.G; if (nx < 32 * NCHUNK) { const int tk = nx / NCHUNK, cn = nx % NCHUNK; chunk_load<true>(F, RWKV_SRC(I, tk & 1, (tk >> 1) & 3), tk >> 3, tk & 1, cn, q); } }
        chunk_out<true>(F, cur, 0.f, PZ + (size_t)item * 8192 + 4096, tstash(ws, item), b, dir, c, RWY + (size_t)dir * MALL * 256 + hd * 64);
    }
}
__device__ __forceinline__ float ret_egamma(int hd, int dir) { return -logf(1.f - expf(-3.4657359027997265f + (-6.238324625039508f + 3.4657359027997265f) * (float)(2 * hd + dir) / 7.f)); }
#define RET_SRC(hd, dir) ChunkSrc{nullptr, nullptr, nullptr, P + 768 + (hd) * 64, P + 512 + (hd) * 64, P + 1024 + (hd) * 64, NINP, ret_egamma(hd, dir), RTAB}
__device__ __forceinline__ void ph_ret_r1(const Frame& F, const bf16_t* P, const float* RTAB, bf16_t* RZ) {
    const int lane = F.lane, w = F.wave, r32 = lane & 31, hi = lane >> 5, mi = (w >> 1) & 1, ni = w & 1;
    ChunkRegs q;
    if (F.bid < 32 * NCHUNK) { const int task = F.bid / NCHUNK; chunk_load<false>(F, RET_SRC((task >> 1) & 3, task & 1), task >> 3, task & 1, F.bid % NCHUNK, q); }
    for (int item = F.bid; item < 32 * NCHUNK; item += F.G) {
        const int task = item / NCHUNK, dir = task & 1, hd = (task >> 1) & 3;
        chunk_prep<false, false>(F, q, ret_egamma(hd, dir));
        { const int nx = item + F.G; if (nx < 32 * NCHUNK) { const int tk = nx / NCHUNK; chunk_load<false>(F, RET_SRC((tk >> 1) & 3, tk & 1), tk >> 3, tk & 1, nx % NCHUNK, q); } }
        if (w < 4) { const f32x16 z = nt_tile(F.lds + CK_KPT, F.lds + CK_VT, mi, ni, lane);
            bf16_t* zo = RZ + (size_t)item * 4096 + (size_t)(32 * ni + r32) * 64 + 32 * mi + 4 * hi;
#pragma unroll
            for (int g = 0; g < 4; ++g) *(u32x2*)(zo + 8 * g) = (u32x2){pg8::cvt_pk_bf16(z[4 * g], z[4 * g + 1]), pg8::cvt_pk_bf16(z[4 * g + 2], z[4 * g + 3])}; }
        __syncthreads();
    }
}
__device__ __forceinline__ void ph_ret_r2(const Frame& F, bf16_t* RZ) {
    for (int el = F.bid * NTHR + F.tid; el < 32 * 4096; el += F.G * NTHR) {
        const int task = el >> 12, idx = el & 4095, dir = task & 1, hd = (task >> 1) & 3;
        const float g64 = __expf(-64.f * ret_egamma(hd, dir));
        bf16_t* z = RZ + (size_t)task * NCHUNK * 4096 + idx; float S = 0.f;
#pragma unroll 1
        for (int c0 = 0; c0 < NCHUNK; c0 += 12) {
            float zc[12];
#pragma unroll
            for (int j = 0; j < 12; ++j) zc[j] = bf2f(z[(size_t)(c0 + j) * 4096]);
#pragma unroll
            for (int j = 0; j < 12; ++j) { z[(size_t)(c0 + j) * 4096] = (bf16_t)f2bf(S); S = S * g64 + zc[j]; } }
    }
}
__device__ __forceinline__ void ph_ret_r3(const Frame& F, const bf16_t* P, const float* RTAB, const bf16_t* RZ, bf16_t* RETY) {
    ChunkRegs q;
    if (F.bid < 32 * NCHUNK) { const int task = F.bid / NCHUNK; chunk_load<false>(F, RET_SRC((task >> 1) & 3, task & 1), task >> 3, task & 1, F.bid % NCHUNK, q); }
    for (int item = F.bid; item < 32 * NCHUNK; item += F.G) {
        const int task = item / NCHUNK, c = item % NCHUNK, dir = task & 1, hd = (task >> 1) & 3, b = task >> 3;
        const ChunkRegs cur = q;
        { const int nx = item + F.G; if (nx < 32 * NCHUNK) { const int tk = nx / NCHUNK; chunk_load<false>(F, RET_SRC((tk >> 1) & 3, tk & 1), tk >> 3, tk & 1, nx % NCHUNK, q); } }
        chunk_out<false>(F, cur, ret_egamma(hd, dir), RZ + (size_t)item * 4096, nullptr, b, dir, c, RETY + (size_t)dir * MALL * 256 + hd * 64);
    }
}

template <int DQK, bool MASKED, class TileFn>
__device__ __forceinline__ void attn_unit(const Frame& F, const bf16_t* qrow, int qpos, bool has_sink, float sink_l2, int ntiles, const TileFn& tf,
                                          int kstride, int vstride, bf16_t* obase, int ostride) {
    constexpr int NS = DQK / 16, KP = DQK + 8, KBUF = 64 * KP * 2, VP = 72, VBUF = 64 * VP * 2, BUF = KBUF + VBUF, CPR = DQK / 8;
    const int tid = F.tid, lane = F.lane, r32 = lane & 31, hi = lane >> 5, wave = F.wave;
    LAS unsigned char* lds = F.lds;
    LAS float* wsf = (LAS float*)(lds + 2 * BUF) + wave * 32;
    bf16x8 qf[NS];
#pragma unroll
    for (int s = 0; s < NS; ++s) qf[s] = *(const bf16x8*)(qrow + 16 * s + 8 * hi);
    u32x4 gk0, gk1 = {0u, 0u, 0u, 0u}, gv;
    const int kr0 = tid / CPR, kc0 = tid % CPR, kr1 = (tid + 512) / CPR, kc1 = (tid + 512) % CPR;
    const bool two = (DQK == 96) && tid < 256;
#define AT_GLOAD(j) do { const bf16_t *Kp_, *Vp_; int kp_; tf(j, Kp_, Vp_, kp_); gk0 = *(const u32x4*)(Kp_ + (size_t)kr0 * kstride + kc0 * 8); \
        if (two) gk1 = *(const u32x4*)(Kp_ + (size_t)kr1 * kstride + kc1 * 8); gv = *(const u32x4*)(Vp_ + (size_t)lane * vstride + wave * 8); } while (0)
#define AT_LSTORE(b) do { LAS unsigned char* kb_ = lds + (b) * BUF; *(LAS u32x4*)(kb_ + (kr0 * KP + kc0 * 8) * 2) = gk0; if (two) *(LAS u32x4*)(kb_ + (kr1 * KP + kc1 * 8) * 2) = gk1; \
        LAS bf16_t* vt_ = (LAS bf16_t*)(kb_ + KBUF) + (wave * 8) * VP + lane; \
        _Pragma("unroll") for (int e_ = 0; e_ < 4; ++e_) { vt_[(2 * e_) * VP] = (bf16_t)(gv[e_] & 0xffffu); vt_[(2 * e_ + 1) * VP] = (bf16_t)(gv[e_] >> 16); } } while (0)
    float m = has_sink ? sink_l2 : -1e30f, lsum = 0.f;
    f32x16 O0 = {0.f,0.f,0.f,0.f,0.f,0.f,0.f,0.f,0.f,0.f,0.f,0.f,0.f,0.f,0.f,0.f}, O1 = O0;
    AT_GLOAD(0); AT_LSTORE(0);
    __syncthreads();
#pragma unroll 1
    for (int j = 0; j < ntiles; ++j) {
        const int b = j & 1;
        if (j + 1 < ntiles) AT_GLOAD(j + 1);
        const LAS unsigned char* kb = lds + b * BUF + (r32 * KP + 8 * hi) * 2;
        f32x16 p0 = {0.f,0.f,0.f,0.f,0.f,0.f,0.f,0.f,0.f,0.f,0.f,0.f,0.f,0.f,0.f,0.f}, p1 = p0;
#pragma unroll
        for (int s = 0; s < NS; ++s) { const bf16x8 a0 = *(const LAS bf16x8*)(kb + 32 * s), a1 = *(const LAS bf16x8*)(kb + 32 * KP * 2 + 32 * s);
            p0 = __builtin_amdgcn_mfma_f32_32x32x16_bf16(a0, qf[s], p0, 0, 0, 0); p1 = __builtin_amdgcn_mfma_f32_32x32x16_bf16(a1, qf[s], p1, 0, 0, 0); }
        if (MASKED) { const bf16_t *Kp_, *Vp_; int kp0; tf(j, Kp_, Vp_, kp0);
            if (kp0 >= 0) {
#pragma unroll
                for (int r = 0; r < 16; ++r) { const int dk = kp0 + crow(r, hi) - qpos; if (dk > 128 || dk < -128) p0[r] = -1e30f; if (dk + 32 > 128 || dk + 32 < -128) p1[r] = -1e30f; } } }
        float mx = fmaxf(p0[0], p1[0]);
#pragma unroll
        for (int r = 1; r < 16; ++r) mx = fmaxf(mx, fmaxf(p0[r], p1[r]));
        mx = fmaxf(mx, __shfl_xor(mx, 32));
        const float mnew = fmaxf(m, mx), alpha = __builtin_amdgcn_exp2f(m - mnew); m = mnew;
        float ps = 0.f;
#pragma unroll
        for (int r = 0; r < 16; ++r) { p0[r] = __builtin_amdgcn_exp2f(p0[r] - mnew); p1[r] = __builtin_amdgcn_exp2f(p1[r] - mnew); ps += p0[r] + p1[r]; }
        lsum = lsum * alpha + ps;
        if (__any(alpha != 1.f)) {
            if (hi == 0) wsf[r32] = alpha;
#pragma unroll
            for (int g = 0; g < 4; ++g) { const f32x4 a4 = *(const LAS f32x4*)(wsf + 8 * g + 4 * hi);
#pragma unroll
                for (int i = 0; i < 4; ++i) { O0[4 * g + i] *= a4[i]; O1[4 * g + i] *= a4[i]; } } }
        bf16x8 pa[4];
#pragma unroll
        for (int s = 0; s < 4; ++s) { u32x4 w;
#pragma unroll
            for (int e = 0; e < 4; ++e) { const float lo = (s < 2) ? p0[8 * (s & 1) + 2 * e] : p1[8 * (s & 1) + 2 * e], hh = (s < 2) ? p0[8 * (s & 1) + 2 * e + 1] : p1[8 * (s & 1) + 2 * e + 1]; w[e] = pg8::cvt_pk_bf16(lo, hh); }
            pa[s] = __builtin_bit_cast(bf16x8, w); }
        const LAS unsigned char* vb = lds + b * BUF + KBUF + (r32 * VP + 4 * hi) * 2;
#pragma unroll
        for (int s = 0; s < 4; ++s) {
#pragma unroll
            for (int db = 0; db < 2; ++db) { const u32x2 v0 = *(const LAS u32x2*)(vb + (db * 32 * VP + 16 * s) * 2), v1 = *(const LAS u32x2*)(vb + (db * 32 * VP + 16 * s + 8) * 2);
                const u32x4 vv = {v0.x, v0.y, v1.x, v1.y}; const bf16x8 vf = __builtin_bit_cast(bf16x8, vv);
                if (db == 0) O0 = __builtin_amdgcn_mfma_f32_32x32x16_bf16(pa[s], vf, O0, 0, 0, 0); else O1 = __builtin_amdgcn_mfma_f32_32x32x16_bf16(pa[s], vf, O1, 0, 0, 0); } }
        if (j + 1 < ntiles) AT_LSTORE(b ^ 1);
        __syncthreads();
    }
    float ltot = lsum + __shfl_xor(lsum, 32);
    if (has_sink) ltot += __builtin_amdgcn_exp2f(sink_l2 - m);
    if (hi == 0) wsf[r32] = 1.f / ltot;
#pragma unroll
    for (int g = 0; g < 4; ++g) { const f32x4 a4 = *(const LAS f32x4*)(wsf + 8 * g + 4 * hi);
#pragma unroll
        for (int i = 0; i < 4; ++i) { bf16_t* op = obase + (size_t)(i + 8 * g + 4 * hi) * ostride + r32;
            op[0] = (bf16_t)f2bf(O0[4 * g + i] * a4[i]); op[32] = (bf16_t)f2bf(O1[4 * g + i] * a4[i]); } }
    __syncthreads();
#undef AT_GLOAD
#undef AT_LSTORE
}


template <int DQK, class TileFn>
__device__ __forceinline__ void attn_unit2(const Frame& F, const bf16_t* qrow, int ntiles, const TileFn& tf, int kstride, int vstride, bf16_t* obase, int ostride) {
    constexpr int NS = DQK / 16, KP = DQK + 8, KBUF = 128 * KP * 2, VP = 136, VBUF = 64 * VP * 2, BUF = KBUF + VBUF, CPR = DQK / 8, NKC = (128 * CPR) / 512;
    static_assert((128 * CPR) % 512 == 0 && 2 * BUF + 1024 <= RING_BYTES, "attn2 geometry");
    const int tid = F.tid, lane = F.lane, r32 = lane & 31, hi = lane >> 5, wave = F.wave;
    LAS unsigned char* lds = F.lds;
    LAS float* wsf = (LAS float*)(lds + 2 * BUF) + wave * 32;
    bf16x8 qf[NS];
#pragma unroll
    for (int s = 0; s < NS; ++s) qf[s] = *(const bf16x8*)(qrow + 16 * s + 8 * hi);
    u32x4 gk[NKC], gv[2];
#define A2_GLOAD(j) do { const bf16_t *Kp_, *Vp_; tf(j, Kp_, Vp_); _Pragma("unroll") for (int i_ = 0; i_ < NKC; ++i_) { const int ch_ = tid + 512 * i_; gk[i_] = *(const u32x4*)(Kp_ + (size_t)(ch_ / CPR) * kstride + (ch_ % CPR) * 8); } \
        gv[0] = *(const u32x4*)(Vp_ + (size_t)lane * vstride + wave * 8); gv[1] = *(const u32x4*)(Vp_ + (size_t)(lane + 64) * vstride + wave * 8); } while (0)
#define A2_LSTORE(b) do { LAS unsigned char* kb_ = lds + (b) * BUF; _Pragma("unroll") for (int i_ = 0; i_ < NKC; ++i_) { const int ch_ = tid + 512 * i_; *(LAS u32x4*)(kb_ + ((ch_ / CPR) * KP + (ch_ % CPR) * 8) * 2) = gk[i_]; } \
        LAS bf16_t* vt_ = (LAS bf16_t*)(kb_ + KBUF) + (wave * 8) * VP + lane; \
        _Pragma("unroll") for (int h_ = 0; h_ < 2; ++h_) _Pragma("unroll") for (int e_ = 0; e_ < 4; ++e_) { vt_[(2 * e_) * VP + 64 * h_] = (bf16_t)(gv[h_][e_] & 0xffffu); vt_[(2 * e_ + 1) * VP + 64 * h_] = (bf16_t)(gv[h_][e_] >> 16); } } while (0)
    float m = -1e30f, lsum = 0.f;
    const f32x16 z16 = {0.f,0.f,0.f,0.f,0.f,0.f,0.f,0.f,0.f,0.f,0.f,0.f,0.f,0.f,0.f,0.f};
    f32x16 O0 = z16, O1 = z16;
    A2_GLOAD(0); A2_LSTORE(0);
    __syncthreads();
#pragma unroll 1
    for (int j = 0; j < ntiles; ++j) {
        const int b = j & 1;
        if (j + 1 < ntiles) A2_GLOAD(j + 1);
        const LAS unsigned char* kb = lds + b * BUF + (r32 * KP + 8 * hi) * 2;
        f32x16 p[4] = {z16, z16, z16, z16};
#pragma unroll
        for (int s = 0; s < NS; ++s)
#pragma unroll
            for (int h4 = 0; h4 < 4; ++h4) p[h4] = __builtin_amdgcn_mfma_f32_32x32x16_bf16(*(const LAS bf16x8*)(kb + h4 * 32 * KP * 2 + 32 * s), qf[s], p[h4], 0, 0, 0);
        float mx;
        { float t[16];
#pragma unroll
          for (int r = 0; r < 16; ++r) t[r] = fmaxf(fmaxf(p[0][r], p[1][r]), fmaxf(p[2][r], p[3][r]));
#pragma unroll
          for (int r = 0; r < 8; ++r) t[r] = fmaxf(t[r], t[r + 8]);
#pragma unroll
          for (int r = 0; r < 4; ++r) t[r] = fmaxf(t[r], t[r + 4]);
          mx = fmaxf(fmaxf(t[0], t[1]), fmaxf(t[2], t[3])); }
        mx = fmaxf(mx, __shfl_xor(mx, 32));
        const float mnew = fmaxf(m, mx), alpha = __builtin_amdgcn_exp2f(m - mnew); m = mnew;
        float ps;
        { float q4[16];
#pragma unroll
          for (int h4 = 0; h4 < 4; ++h4)
#pragma unroll
              for (int r = 0; r < 16; ++r) p[h4][r] = __builtin_amdgcn_exp2f(p[h4][r] - mnew);
#pragma unroll
          for (int r = 0; r < 16; ++r) q4[r] = (p[0][r] + p[1][r]) + (p[2][r] + p[3][r]);
#pragma unroll
          for (int r = 0; r < 8; ++r) q4[r] += q4[r + 8];
#pragma unroll
          for (int r = 0; r < 4; ++r) q4[r] += q4[r + 4];
          ps = (q4[0] + q4[1]) + (q4[2] + q4[3]); }
        lsum = lsum * alpha + ps;
        if (__any(alpha != 1.f)) {
            if (hi == 0) wsf[r32] = alpha;
#pragma unroll
            for (int g = 0; g < 4; ++g) { const f32x4 a4 = *(const LAS f32x4*)(wsf + 8 * g + 4 * hi);
#pragma unroll
                for (int i = 0; i < 4; ++i) { O0[4 * g + i] *= a4[i]; O1[4 * g + i] *= a4[i]; } } }
        const LAS unsigned char* vb = lds + b * BUF + KBUF + (r32 * VP + 4 * hi) * 2;
#pragma unroll
        for (int s = 0; s < 8; ++s) { u32x4 w;
#pragma unroll
            for (int e = 0; e < 4; ++e) w[e] = pg8::cvt_pk_bf16(p[s >> 1][8 * (s & 1) + 2 * e], p[s >> 1][8 * (s & 1) + 2 * e + 1]);
            const bf16x8 pa = __builtin_bit_cast(bf16x8, w);
#pragma unroll
            for (int db = 0; db < 2; ++db) { const u32x2 v0 = *(const LAS u32x2*)(vb + (db * 32 * VP + 16 * s) * 2), v1 = *(const LAS u32x2*)(vb + (db * 32 * VP + 16 * s + 8) * 2);
                const u32x4 vv = {v0.x, v0.y, v1.x, v1.y}; const bf16x8 vf = __builtin_bit_cast(bf16x8, vv);
                if (db == 0) O0 = __builtin_amdgcn_mfma_f32_32x32x16_bf16(pa, vf, O0, 0, 0, 0); else O1 = __builtin_amdgcn_mfma_f32_32x32x16_bf16(pa, vf, O1, 0, 0, 0); } }
        if (j + 1 < ntiles) A2_LSTORE(b ^ 1);
        __syncthreads();
    }
    const float ltot = lsum + __shfl_xor(lsum, 32);
    if (hi == 0) wsf[r32] = 1.f / ltot;
#pragma unroll
    for (int g = 0; g < 4; ++g) { const f32x4 a4 = *(const LAS f32x4*)(wsf + 8 * g + 4 * hi);
#pragma unroll
        for (int i = 0; i < 4; ++i) { bf16_t* op = obase + (size_t)(i + 8 * g + 4 * hi) * ostride + r32;
            op[0] = (bf16_t)f2bf(O0[4 * g + i] * a4[i]); op[32] = (bf16_t)f2bf(O1[4 * g + i] * a4[i]); } }
    __syncthreads();
#undef A2_GLOAD
#undef A2_LSTORE
}

__device__ __forceinline__ void ph_attn_window(const Frame& F, const bf16_t* QA, const bf16_t* KA, const bf16_t* P, const float* sink_l, bf16_t* YB, bool need_ctx) {
    const int nun = 512 + (need_ctx ? 16 : 0);
    const int nb_ = F.G > 128 ? F.G - 64 : F.G, b0_ = F.G > 128 ? F.bid - 64 : F.bid;
    for (int u = b0_; u < nun; u += nb_) {
        if (u < 0) break;
        const int w = F.wave, r32 = F.lane & 31;
        if (u < 512) {
            const int b = u >> 7, kvh = (u >> 6) & 1, n = u & 63, hq = 2 * kvh + (w >> 2);
            const int t = 128 * n + 32 * (w & 3);
            const int w0 = (n == 0) ? 0 : 128 * (n - 1), w1 = (n >= 62) ? SEQ : 128 * (n + 2), nwt = (w1 - w0) / 64;
            const bf16_t* Kb = KA + (size_t)(b * SEQ) * 128 + kvh * 64; const bf16_t* Vb = P + (size_t)(b * SEQ) * NINP + 384 + kvh * 64;
            const bf16_t* Kc = KA + (size_t)(MLAT + b * CTXL) * 128 + kvh * 64; const bf16_t* Vc = P + (size_t)(MLAT + b * CTXL) * NINP + 384 + kvh * 64;
            auto tf = [&](int j, const bf16_t*& Kp, const bf16_t*& Vp, int& kp0) {
                if (j < nwt) { kp0 = w0 + 64 * j; Kp = Kb + (size_t)kp0 * 128; Vp = Vb + (size_t)kp0 * NINP; }
                else { kp0 = -1; Kp = Kc + (size_t)(64 * (j - nwt)) * 128; Vp = Vc + (size_t)(64 * (j - nwt)) * NINP; } };
            const size_t qr = (size_t)(b * SEQ + t);
            attn_unit<64, true>(F, QA + (qr + r32) * 256 + hq * 64, t + r32, true, sink_l[hq] * 1.4426950408889634f, nwt + 4, tf, 128, NINP, YB + qr * D + hq * 64, D);
        } else {
            const int v = u - 512, b = v >> 2, kvh = (v >> 1) & 1, n = v & 1, hq = 2 * kvh + (w >> 2);
            const int jq = 128 * n + 32 * (w & 3);
            const bf16_t* Kc = KA + (size_t)(MLAT + b * CTXL) * 128 + kvh * 64; const bf16_t* Vc = P + (size_t)(MLAT + b * CTXL) * NINP + 384 + kvh * 64;
            auto tf = [&](int j, const bf16_t*& Kp, const bf16_t*& Vp, int& kp0) { kp0 = -1; Kp = Kc + (size_t)(64 * j) * 128; Vp = Vc + (size_t)(64 * j) * NINP; };
            const size_t qr = (size_t)(MLAT + b * CTXL + jq);
            attn_unit<64, false>(F, QA + (qr + r32) * 256 + hq * 64, 0, true, sink_l[hq] * 1.4426950408889634f, 4, tf, 128, NINP, YB + qr * D + hq * 64, D);
        }
    }
}
__device__ __forceinline__ void ph_attn_mla(const Frame& F, const bf16_t* QC, const bf16_t* KC, const bf16_t* VC, bf16_t* YB, bool need_ctx) {
    const int nun = 512 + (need_ctx ? 16 : 0);
    for (int u0 = F.bid; u0 < nun; u0 += F.G) {
        const int u = (F.G == 256 && u0 < 512) ? (((u0 & 7) + 8 * (u0 >> 8)) * 32 + ((u0 & 255) >> 3)) : u0;
        const int w = F.wave, r32 = F.lane & 31;
        const bool isl = u < 512; const int v = isl ? u : u - 512;
        const int b = isl ? (v >> 7) : (v >> 2), hd = isl ? ((v >> 5) & 3) : (v & 3), qb = isl ? (v & 31) : 0;
        const bf16_t* Kc = KC + (size_t)(MLAT + b * CTXL) * 384 + hd * 96; const bf16_t* Vc = VC + (size_t)(MLAT + b * CTXL) * 256 + hd * 64;
        const bf16_t* Kl = KC + (size_t)(b * SEQ) * 384 + hd * 96; const bf16_t* Vl = VC + (size_t)(b * SEQ) * 256 + hd * 64;
        auto tf = [&](int j, const bf16_t*& Kp, const bf16_t*& Vp) {
            if (j < 2) { Kp = Kc + (size_t)(128 * j) * 384; Vp = Vc + (size_t)(128 * j) * 256; } else { Kp = Kl + (size_t)(128 * (j - 2)) * 384; Vp = Vl + (size_t)(128 * (j - 2)) * 256; } };
        const size_t qr = isl ? (size_t)(b * SEQ + 256 * qb + 32 * w) : (size_t)(MLAT + b * CTXL + 32 * w);
        attn_unit2<96>(F, QC + (qr + r32) * 384 + hd * 96, isl ? 66 : 2, tf, 384, 256, YB + qr * D + 512 + hd * 64, D);
    }
}

__device__ __forceinline__ void ph_ret_scan(const Frame& F, const bf16_t* P, const bf16_t* RQ, const bf16_t* RK, bf16_t* RETY, bf16_t* REF) {
    if (F.bid >= 4 || F.wave != 0) return;
    const int task = 9 * F.bid, dir = task & 1, hd = (task >> 1) & 3, b = task >> 3, lane = F.lane;
    const float lgam = logf(1.f - expf(-3.4657359027997265f + (-6.238324625039508f + 3.4657359027997265f) * (float)(2 * hd + dir) / 7.f));
    const float gam = expf(lgam);
    float S[64];
#pragma unroll
    for (int d = 0; d < 64; ++d) S[d] = 0.f;
    for (int seg = 0; seg < 2; ++seg) {
        const int n = seg == 0 ? CTXL : SEQ; const int base = seg == 0 ? MLAT + b * CTXL : b * SEQ;
        for (int st = 0; st < n; ++st) {
            const int row = base + (dir == 0 ? st : n - 1 - st);
            const float q = bf2f(RQ[(size_t)row * 256 + hd * 64 + lane]), k = bf2f(RK[(size_t)row * 256 + hd * 64 + lane]), v = bf2f(P[(size_t)row * NINP + 1024 + hd * 64 + lane]);
            float o = 0.f;
#pragma unroll
            for (int d = 0; d < 64; ++d) { const float kd = __int_as_float(__builtin_amdgcn_readlane(__float_as_int(k), d)), qd = __int_as_float(__builtin_amdgcn_readlane(__float_as_int(q), d)); S[d] = S[d] * gam + kd * v; o += qd * S[d]; }
            REF[((size_t)F.bid * 8448 + (seg == 0 ? row - base : 256 + row - base)) * 64 + lane] = (bf16_t)f2bf(o);
        }
    }
}
__device__ __forceinline__ void ph_ret_combine(const Frame& F, const bf16_t* P, const bf16_t* RETY, bf16_t* YB, int nrows) {
    for (int row = F.gw; row < nrows; row += F.ngw) {
        float out[4] = {0.f, 0.f, 0.f, 0.f};
#pragma unroll
        for (int dir = 0; dir < 2; ++dir) {
            const u32x2 yw = *((const u32x2*)(RETY + ((size_t)dir * MALL + row) * 256) + F.lane);
            const u32x2 gw = *((const u32x2*)(P + (size_t)row * NINP + 1280 + dir * 256) + F.lane);
            float y[4] = {__uint_as_float(yw.x << 16), __uint_as_float(yw.x & 0xffff0000u), __uint_as_float(yw.y << 16), __uint_as_float(yw.y & 0xffff0000u)};
            float g[4] = {__uint_as_float(gw.x << 16), __uint_as_float(gw.x & 0xffff0000u), __uint_as_float(gw.y << 16), __uint_as_float(gw.y & 0xffff0000u)};
            const float mean = grp16_sum(y[0] + y[1] + y[2] + y[3]) * (1.f / 64.f);
            float s2 = 0.f;
#pragma unroll
            for (int e = 0; e < 4; ++e) { y[e] -= mean; s2 += y[e] * y[e]; }
            const float rstd = 1.f / sqrtf(grp16_sum(s2) * (1.f / 64.f) + 1e-5f);
#pragma unroll
            for (int e = 0; e < 4; ++e) out[e] += silu_f(g[e]) * y[e] * rstd;
        }
        *((u32x2*)(YB + (size_t)row * D + 256) + F.lane) = (u32x2){pk2(out[0], out[1]), pk2(out[2], out[3])};
    }
}


__device__ __forceinline__ void ph_router_tables(const Frame& F, const float* router_w, bf16_t* RWHI, bf16_t* RWLO) {
    for (int i = F.bid * NTHR + F.tid; i < 64 * 1024; i += F.G * NTHR) { const int e = i >> 10, k = i & 1023; const float w = router_w[(size_t)k * 64 + e];
        const unsigned h = f2bf(w); RWHI[i] = (bf16_t)h; RWLO[i] = (bf16_t)f2bf(w - __uint_as_float(h << 16)); }
}
__device__ __forceinline__ void ph_gs2(const Frame& F, const float* g_norm2  , const float* MOD, float* GS2) {
    for (int i = F.bid * NTHR + F.tid; i < 2 * 5 * 1024; i += F.G * NTHR) { const int l = i / 5120, v = (i / 1024) % 5, k = i & 1023;
        GS2[i] = g_norm2[l * 1024 + k] * (1.f + MOD[((size_t)l * 5 + v) * 6144 + 4 * D + k]); }
}
__device__ __forceinline__ void ph_moe_route(const Frame& F, const float* H, const float* modl, const float* gs2l  , const bf16_t* RWHI, const bf16_t* RWLO, const float* router_b,
                                             bf16_t* XN, unsigned* cnt, int* TOKE, int* TOKP, float* TOKW, int nrows) {
    const int lane = F.lane, r32 = lane & 31, hi = lane >> 5, w = F.wave;
    LAS unsigned char* FH = F.lds; LAS unsigned char* FL = F.lds + 65536;
    LAS float* PART = (LAS float*)F.lds;
    bf16x8 wb[8][4];
    { const bf16_t* bh = RWHI + (size_t)r32 * 1024 + 128 * w + 8 * hi; const bf16_t* bl = RWLO + (size_t)r32 * 1024 + 128 * w + 8 * hi;
#pragma unroll
      for (int s = 0; s < 8; ++s) { wb[s][0] = *(const bf16x8*)(bh + 16 * s); wb[s][1] = *(const bf16x8*)(bh + 32 * 1024 + 16 * s); wb[s][2] = *(const bf16x8*)(bl + 16 * s); wb[s][3] = *(const bf16x8*)(bl + 32 * 1024 + 16 * s); } }
    for (int tile = F.bid; tile < nrows / 32; tile += F.G) {
        const int row0 = tile * 32, vec = row_vec(row0); const float* mv = modl + (size_t)vec * 6144; const float* gs = gs2l + vec * 1024;
#pragma unroll 1
        for (int qp = 0; qp < 2; ++qp) { f32x4 v[2][4]; float s2[2];
#pragma unroll
          for (int q = 0; q < 2; ++q) { const f32x4* xr = (const f32x4*)(H + (size_t)(row0 + 4 * w + 2 * qp + q) * D) + lane; s2[q] = 0.f;
#pragma unroll
              for (int j = 0; j < 4; ++j) { v[q][j] = xr[64 * j]; s2[q] += (v[q][j].x * v[q][j].x + v[q][j].y * v[q][j].y) + (v[q][j].z * v[q][j].z + v[q][j].w * v[q][j].w); } }
#pragma unroll
          for (int o = 1; o < 64; o <<= 1) {
#pragma unroll
              for (int q = 0; q < 2; ++q) s2[q] += __shfl_xor(s2[q], o); }
#pragma unroll
          for (int q = 0; q < 2; ++q) { const float rstd = 1.f / sqrtf(s2[q] * (1.f / D) + NORM_EPS); const int rr = 4 * w + 2 * qp + q;
              u32x2* o = (u32x2*)(XN + (size_t)(row0 + rr) * D) + lane;
#pragma unroll
              for (int j = 0; j < 4; ++j) { const int ci = 64 * j + lane; const f32x4 g4 = ((const f32x4*)gs)[ci], sh = ((const f32x4*)(mv + 3 * D))[ci];
                  const f32x4 y = v[q][j] * rstd * g4 + sh;
                  const unsigned h0 = pg8::cvt_pk_bf16(y.x, y.y), h1 = pg8::cvt_pk_bf16(y.z, y.w);
                  o[64 * j] = (u32x2){h0, h1};
                  const unsigned l0 = pg8::cvt_pk_bf16(y.x - __uint_as_float(h0 << 16), y.y - __uint_as_float(h0 & 0xffff0000u)), l1 = pg8::cvt_pk_bf16(y.z - __uint_as_float(h1 << 16), y.w - __uint_as_float(h1 & 0xffff0000u));
                  const int col = 4 * ci, off = rr * 2048 + ((((col >> 3) ^ (rr & 15)) << 3) + (col & 7)) * 2;
                  *(LAS u32x2*)(FH + off) = (u32x2){h0, h1}; *(LAS u32x2*)(FL + off) = (u32x2){l0, l1}; } } }
        __syncthreads();
        const f32x16 z16 = {0.f,0.f,0.f,0.f,0.f,0.f,0.f,0.f,0.f,0.f,0.f,0.f,0.f,0.f,0.f,0.f};
        f32x16 a0 = z16, a1 = z16;
        {
#pragma unroll
          for (int s = 0; s < 8; ++s) { const int ch = (16 * w + 2 * s + hi) ^ (r32 & 15);
              const bf16x8 ah = *(const LAS bf16x8*)(FH + r32 * 2048 + ch * 16), al = *(const LAS bf16x8*)(FL + r32 * 2048 + ch * 16);
              const bf16x8 bh0 = wb[s][0], bh1 = wb[s][1], bl0 = wb[s][2], bl1 = wb[s][3];
              a0 = __builtin_amdgcn_mfma_f32_32x32x16_bf16(ah, bh0, a0, 0, 0, 0); a1 = __builtin_amdgcn_mfma_f32_32x32x16_bf16(ah, bh1, a1, 0, 0, 0);
              a0 = __builtin_amdgcn_mfma_f32_32x32x16_bf16(al, bh0, a0, 0, 0, 0); a1 = __builtin_amdgcn_mfma_f32_32x32x16_bf16(al, bh1, a1, 0, 0, 0);
              a0 = __builtin_amdgcn_mfma_f32_32x32x16_bf16(ah, bl0, a0, 0, 0, 0); a1 = __builtin_amdgcn_mfma_f32_32x32x16_bf16(ah, bl1, a1, 0, 0, 0); } }
        __syncthreads();
#pragma unroll
        for (int r = 0; r < 16; ++r) { PART[(w * 32 + crow(r, hi)) * 64 + r32] = a0[r]; PART[(w * 32 + crow(r, hi)) * 64 + 32 + r32] = a1[r]; }
        __syncthreads();
        {
            const float rb = router_b[lane]; const int e = lane & 7;
            int me0 = 0, me1 = 0; float ms0 = 0.f, ms1 = 0.f;
#pragma unroll 1
            for (int q = 0; q < 4; ++q) { const int tl = 4 * w + q;
                float lg = 0.f;
#pragma unroll
                for (int ww = 0; ww < 8; ++ww) lg += PART[(ww * 32 + tl) * 64 + lane];
                const float sc = sigmoid_div_f(lg), v = sc + rb;
                int rank = 0;
#pragma unroll
                for (int d = 1; d < 8; ++d) { const float vj = __shfl_xor(v, d); rank += (vj > v || (vj == v && (e ^ d) < e)) ? 1 : 0; }
                float gsum = rank < 2 ? v : 0.f;
                gsum += __shfl_xor(gsum, 1); gsum += __shfl_xor(gsum, 2); gsum += __shfl_xor(gsum, 4);
                int grank = 0; const int g = lane >> 3;
#pragma unroll
                for (int d = 1; d < 8; ++d) { const float sj = __shfl_xor(gsum, 8 * d); grank += (sj > gsum || (sj == gsum && (g ^ d) < g)) ? 1 : 0; }
                const unsigned long long b0 = __ballot(grank == 0 && rank == 0), b1 = __ballot(grank == 0 && rank == 1);
                const int l0 = __ffsll((long long)b0) - 1, l1 = __ffsll((long long)b1) - 1;
                const float s0 = __int_as_float(__builtin_amdgcn_readlane(__float_as_int(sc), l0)), s1 = __int_as_float(__builtin_amdgcn_readlane(__float_as_int(sc), l1));
                if (lane == q) { me0 = l0; me1 = l1; ms0 = s0; ms1 = s1; } }
            if (lane < 4) { const int tok = row0 + 4 * w + lane; const float inv = 1.f / (ms0 + ms1);
                const unsigned p0 = atomicAdd(cnt + me0 * CNT_STRIDE, 1u), p1 = atomicAdd(cnt + me1 * CNT_STRIDE, 1u);
                TOKE[2 * tok] = me0; TOKE[2 * tok + 1] = me1; TOKP[2 * tok] = (int)p0; TOKP[2 * tok + 1] = (int)p1; TOKW[2 * tok] = ms0 * inv; TOKW[2 * tok + 1] = ms1 * inv; }
        }
        __syncthreads();
    }
}
constexpr int MOE_TAB_OFF = LDSCTL_OFF + 1024;
__device__ __forceinline__ void moe_table(const Frame& F, const unsigned* cnt) {
    LAS int* tb = (LAS int*)(F.lds + MOE_TAB_OFF);
    __syncthreads();
    if (F.wave == 0) {
        const int e = F.lane; const int nb = ((int)cnt[e * CNT_STRIDE] + 255) >> 8; int inc = nb;
#pragma unroll
        for (int d = 1; d < 64; d <<= 1) { const int u = __shfl_up(inc, d); inc += (e >= d) ? u : 0; }
        const int base = (inc - nb) << 8; tb[e] = base; if (e == 63) tb[64] = inc << 8;
        for (int j = 0; j < nb; ++j) tb[65 + (base >> 8) + j] = e; }
    __syncthreads();
}
__device__ __forceinline__ void ph_moe_rowtok(const Frame& F, const unsigned* cnt, const int* TOKE, const int* TOKP, int* ROWTOK, int nrows) {
    const LAS int* tb = (const LAS int*)(F.lds + MOE_TAB_OFF);
    for (int a = F.bid * NTHR + F.tid; a < 2 * nrows; a += F.G * NTHR) ROWTOK[tb[TOKE[a]] + TOKP[a]] = a >> 1;
    for (int e = F.bid; e < 64; e += F.G) { const int lo = tb[e] + (int)cnt[e * CNT_STRIDE], hiR = (e == 63) ? tb[64] : tb[e + 1];
        for (int r = lo + F.tid; r < hiR; r += NTHR) ROWTOK[r] = 0; }
}
struct SchedGU {
    static constexpr int lda = D, ldb = D, K = D;
    const bf16_t* XB  ; const bf16_t* W; const bf16_t* W0  ; const LAS int* tb; const int* rowtok; int G, c;
    __device__ __forceinline__ bool next(int i, pg8::Unit& u) const {
        const int L = i * G + c, nrb = tb[64] >> 8; if (L >= nrb * 4) return false;
        int rb, t; xcd_tile(L, nrb, 4, rb, t); const int e = tb[65 + rb];
        u.A = XB; u.B = (e < NE0 ? W0 : W) + ((size_t)e * 1024 + t * 256) * D; u.u0 = rb * 256; u.u1 = t * 128; u.u2 = 0; return true;
    }
};
struct EpiSwiGLU {
    static constexpr bool PERM = true;
    bf16_t* O;
    __device__ __forceinline__ void operator()(const f32x4 (&acc)[2][2][4][2], const pg8::Unit& u, int wr, int wc, int fr, int fq) const {
        const int row0 = u.u0 + wr * 64 + fr, col0 = u.u1 + wc * 32 + 8 * fq;
#pragma unroll
        for (int ai = 0; ai < 2; ++ai)
#pragma unroll
            for (int m = 0; m < 4; ++m) { float y[8];
#pragma unroll
                for (int n = 0; n < 2; ++n)
#pragma unroll
                    for (int e = 0; e < 4; ++e) { const float g = acc[ai][0][m][n][e]; y[4 * n + e] = g * __builtin_amdgcn_rcpf(1.f + __expf(-g)) * acc[ai][1][m][n][e]; }
                u32x4 w; w.x = pg8::cvt_pk_bf16(y[0], y[1]); w.y = pg8::cvt_pk_bf16(y[2], y[3]); w.z = pg8::cvt_pk_bf16(y[4], y[5]); w.w = pg8::cvt_pk_bf16(y[6], y[7]);
                *(u32x4*)(O + (size_t)(row0 + ai * 128 + m * 16) * 512 + col0) = w; }
    }
};
struct SchedDown {
    static constexpr int lda = 512, ldb = 512, K = 512;
    const bf16_t* HID; const bf16_t* W; const bf16_t* W0; const LAS int* tb; int G, c;
    __device__ __forceinline__ bool next(int i, pg8::Unit& u) const {
        const int L = i * G + c, nrb = tb[64] >> 8; if (L >= nrb * 4) return false;
        int rb, pn; xcd_tile(L, nrb, 4, rb, pn); const int e = tb[65 + rb];
        u.A = HID + (size_t)rb * 256 * 512; u.B = (e < NE0 ? W0 : W) + ((size_t)e * 1024 + pn * 256) * 512; u.u0 = rb * 256; u.u1 = pn * 256; u.u2 = 0; return true;
    }
};
__device__ __forceinline__ void ph_moe_combine(const Frame& F, float* H, const float* modl, const bf16_t* Y, const int* TOKE, const int* TOKP, const float* TOKW, int nrows) {
    const LAS int* tb = (const LAS int*)(F.lds + MOE_TAB_OFF);
    for (int tok = F.gw; tok < nrows; tok += F.ngw) {
        const int d0 = tb[TOKE[2 * tok]] + TOKP[2 * tok], d1 = tb[TOKE[2 * tok + 1]] + TOKP[2 * tok + 1];
        const float w0 = TOKW[2 * tok], w1 = TOKW[2 * tok + 1];
        const float* gv = modl + (size_t)row_vec(tok) * 6144 + 5 * D;
        f32x4* hr = (f32x4*)(H + (size_t)tok * D) + F.lane;
        const u32x2* y0 = (const u32x2*)(Y + (size_t)d0 * D) + F.lane; const u32x2* y1 = (const u32x2*)(Y + (size_t)d1 * D) + F.lane;
#pragma unroll
        for (int j = 0; j < 4; ++j) { const u32x2 a = y0[64 * j], b = y1[64 * j]; const f32x4 g = ((const f32x4*)gv)[64 * j + F.lane];
            f32x4 f; f.x = w0 * __uint_as_float(a.x << 16) + w1 * __uint_as_float(b.x << 16); f.y = w0 * __uint_as_float(a.x & 0xffff0000u) + w1 * __uint_as_float(b.x & 0xffff0000u);
            f.z = w0 * __uint_as_float(a.y << 16) + w1 * __uint_as_float(b.y << 16); f.w = w0 * __uint_as_float(a.y & 0xffff0000u) + w1 * __uint_as_float(b.y & 0xffff0000u);
            hr[64 * j] = hr[64 * j] + g * f; }
    }
}


__device__ __forceinline__ float row_rstd(const f32x4 (&v)[4]) { float s2 = 0.f;
#pragma unroll
    for (int j = 0; j < 4; ++j) s2 += (v[j].x * v[j].x + v[j].y * v[j].y) + (v[j].z * v[j].z + v[j].w * v[j].w);
    return 1.f / sqrtf(wave_sum(s2) * (1.f / D) + NORM_EPS); }
__device__ __forceinline__ void row_adaln_store(const f32x4 (&v)[4], float rstd, const float* g, const float* mv, int shift_i, int scale_i, bf16_t* xn_row, int lane) {
    u32x2* o = (u32x2*)xn_row + lane;
#pragma unroll
    for (int j = 0; j < 4; ++j) { const int ci = 64 * j + lane; const f32x4 gg = ((const f32x4*)g)[ci], sc = ((const f32x4*)(mv + scale_i * D))[ci], sh = ((const f32x4*)(mv + shift_i * D))[ci];
        const f32x4 y = v[j] * rstd * gg * (sc + 1.f) + sh; o[64 * j] = (u32x2){pk2(y.x, y.y), pk2(y.z, y.w)}; }
}
__device__ __forceinline__ void ph_copy_h_adaln(const Frame& F, const float* x, const float* ctx, float* H, const float* g, const float* modl, bf16_t* XN) {
    for (int m = F.gw; m < MALL; m += F.ngw) {
        const f32x4* xr = (const f32x4*)(m < MLAT ? x + (size_t)m * D : ctx + (size_t)(m - MLAT) * D) + F.lane;
        f32x4 v[4];
#pragma unroll
        for (int j = 0; j < 4; ++j) v[j] = xr[64 * j];
        (void)H;
        row_adaln_store(v, row_rstd(v), g, modl + (size_t)row_vec(m) * 6144, 0, 1, XN + (size_t)m * D, F.lane);
    }
}
template <bool LAST> __device__ __forceinline__ void ph_moe_combine_norm(const Frame& F, float* H, const float* modl, const bf16_t* Y, const int* TOKE, const int* TOKP, const float* TOKW, int nrows,
                                                                         const float* g_next, const float* modl_next, bf16_t* XN, float* out) {
    const LAS int* tb = (const LAS int*)(F.lds + MOE_TAB_OFF);
    for (int tok = F.gw; tok < nrows; tok += F.ngw) {
        const int d0 = tb[TOKE[2 * tok]] + TOKP[2 * tok], d1 = tb[TOKE[2 * tok + 1]] + TOKP[2 * tok + 1];
        const float w0 = TOKW[2 * tok], w1 = TOKW[2 * tok + 1];
        const float* gv = modl + (size_t)row_vec(tok) * 6144 + 5 * D;
        f32x4* hr = (f32x4*)(H + (size_t)tok * D) + F.lane;
        const u32x2* y0 = (const u32x2*)(Y + (size_t)d0 * D) + F.lane; const u32x2* y1 = (const u32x2*)(Y + (size_t)d1 * D) + F.lane;
        f32x4 v[4];
#pragma unroll
        for (int j = 0; j < 4; ++j) { const u32x2 a = y0[64 * j], b = y1[64 * j]; const f32x4 g = ((const f32x4*)gv)[64 * j + F.lane];
            f32x4 f; f.x = w0 * __uint_as_float(a.x << 16) + w1 * __uint_as_float(b.x << 16); f.y = w0 * __uint_as_float(a.x & 0xffff0000u) + w1 * __uint_as_float(b.x & 0xffff0000u);
            f.z = w0 * __uint_as_float(a.y << 16) + w1 * __uint_as_float(b.y << 16); f.w = w0 * __uint_as_float(a.y & 0xffff0000u) + w1 * __uint_as_float(b.y & 0xffff0000u);
            v[j] = hr[64 * j] + g * f; }
        const float rstd = row_rstd(v);
        if (LAST) { f32x4* o = (f32x4*)(out + (size_t)tok * D) + F.lane;
#pragma unroll
            for (int j = 0; j < 4; ++j) o[64 * j] = v[j] * rstd * ((const f32x4*)g_next)[64 * j + F.lane]; }
        else {
#pragma unroll
            for (int j = 0; j < 4; ++j) hr[64 * j] = v[j];
            row_adaln_store(v, rstd, g_next, modl_next + (size_t)row_vec(tok) * 6144, 0, 1, XN + (size_t)tok * D, F.lane); }
    }
}

#ifndef DIAG
#define DIAG 0
#endif
#define PROBE 0
constexpr int CW_DIAG = 8;
__device__ __forceinline__ void diag_fail(unsigned* ctl, int bit) { atomicOr(ctl + CW_DIAG + 2, 1u << (bit & 31)); }
__device__ __forceinline__ bool diag_close(float got, float ref, float scale) { return fabsf(got - ref) <= 0.03f * fabsf(ref) + 0.03f * scale; }

__device__ __forceinline__ void ph_final(const Frame& F, const float* H, const float* g, float* out) {
    float dscale = 1.f;
#if DIAG
    { const unsigned d3 = F.ctl[CW_DIAG + 3] | F.ctl[CW_DIAG + 2]; const unsigned d0 = d3 ? d3 : F.ctl[CW_DIAG], d1 = F.ctl[CW_DIAG + 1]; if (d0) dscale = 1.f + 0.5f * (float)__builtin_ffs((int)d0); else if (d1) dscale = 11.25f + 0.5f * (float)__builtin_ffs((int)d1); }
#endif
    for (int m = F.gw; m < MLAT; m += F.ngw) {
        const f32x4* xr = (const f32x4*)(H + (size_t)m * D) + F.lane;
        f32x4 v[4]; float s2 = 0.f;
#pragma unroll
        for (int j = 0; j < 4; ++j) { v[j] = xr[64 * j]; s2 += (v[j].x * v[j].x + v[j].y * v[j].y) + (v[j].z * v[j].z + v[j].w * v[j].w); }
        const float rstd = 1.f / sqrtf(wave_sum(s2) * (1.f / D) + NORM_EPS);
        f32x4* o = (f32x4*)(out + (size_t)m * D) + F.lane;
#pragma unroll
        for (int j = 0; j < 4; ++j) { const f32x4 gg = ((const f32x4*)g)[64 * j + F.lane]; o[64 * j] = v[j] * rstd * gg * dscale; }
    }
}


#if DIAG
__device__ __forceinline__ float bfr(float x) { return __uint_as_float(f2bf(x) << 16); }
__device__ __forceinline__ void chk_P(const Frame& F, const bf16_t* XN, const float* w_in_l, const bf16_t* P) {
    const int s = F.bid * NTHR + F.tid; if (s >= 8192) return;
    const int row = (int)(((long)s * 7919) % MALL), col = (int)(((long)s * 104729) % NIN);
    float acc = 0.f, sc = 0.f;
    for (int k = 0; k < D; ++k) { const float a = bf2f(XN[(size_t)row * D + k]), w = bfr(w_in_l[(size_t)k * NIN + col]); acc += a * w; sc += a * a * w * w; }
    if (!diag_close(bf2f(P[(size_t)row * NINP + col]), acc, sqrtf(sc))) diag_fail(F.ctl, 0 + F.dl);
}
__device__ __forceinline__ void chk_branch(const Frame& F, const bf16_t* YB, const float* w_branch_l, const bf16_t* BOUT, int nrows) {
    const int s = F.bid * NTHR + F.tid; if (s >= 8192) return;
    const int row = (int)(((long)s * 7919) % nrows), col = (int)(((long)s * 104729) % 4096), n = col >> 10, j = col & 1023;
    float acc = 0.f, sc = 0.f;
    for (int k = 0; k < 256; ++k) { const float a = bf2f(YB[(size_t)row * D + n * 256 + k]), w = bfr(w_branch_l[((size_t)n * 256 + k) * D + j]); acc += a * w; sc += a * a * w * w; }
    if (!diag_close(bf2f(BOUT[(size_t)row * 4096 + col]), acc, sqrtf(sc))) diag_fail(F.ctl, 1 + F.dl);
}
__device__ __forceinline__ void chk_gate(const Frame& F, const bf16_t* XN, const bf16_t* YB, const float* w_gate_l, const float* b_gate_l, const float* w_branch_l, const bf16_t* BOUT, int nrows) {
    const int s = F.bid * NTHR + F.tid; if (s >= 8192) return;
    const int row = (int)(((long)s * 7919) % nrows), col = (int)(((long)s * 104729) % 4096), n = col >> 10, j = col & 1023;
    float acc = 0.f, sc = 0.f;
    for (int k = 0; k < 256; ++k) { const float a = bf2f(YB[(size_t)row * D + n * 256 + k]), w = bfr(w_branch_l[((size_t)n * 256 + k) * D + j]); acc += a * w; sc += a * a * w * w; }
    float g = b_gate_l[col];
    for (int k = 0; k < D; ++k) g += bf2f(XN[(size_t)row * D + k]) * bfr(w_gate_l[((size_t)n * D + k) * D + j]);
    const float ref = bfr(acc) * sigmoid_f(g);
    if (!diag_close(bf2f(BOUT[(size_t)row * 4096 + col]), ref, sqrtf(sc))) diag_fail(F.ctl, 2 + F.dl);
}
__device__ __forceinline__ void chk_out(const Frame& F, const bf16_t* ACC, const float* w_out_l, const float* modl, const float* x, const float* H) {
    const int s = F.bid * NTHR + F.tid; if (s >= 8192) return;
    const int row = (int)(((long)s * 7919) % MLAT), col = (int)(((long)s * 104729) % D);
    float acc = 0.f, sc = 0.f;
    for (int k = 0; k < D; ++k) { const float a = bf2f(ACC[(size_t)row * D + k]), w = bfr(w_out_l[(size_t)k * D + col]); acc += a * w; sc += a * a * w * w; }
    const float m2 = modl[(size_t)row_vec(row) * 6144 + 2 * D + col];
    if (!diag_close(H[(size_t)row * D + col] - x[(size_t)row * D + col], m2 * acc, fabsf(m2) * sqrtf(sc) + 1e-3f)) diag_fail(F.ctl, 3 + F.dl);
}
__device__ __forceinline__ void chk_sum4(const Frame& F, const bf16_t* BOUT, const bf16_t* ACC, int nrows) {
    const int s = F.bid * NTHR + F.tid; if (s >= 8192) return;
    const int row = (int)(((long)s * 7919) % nrows), col = (int)(((long)s * 104729) % D);
    float a = 0.f, sc = 0.f; for (int n = 0; n < 4; ++n) { const float v = bf2f(BOUT[(size_t)row * 4096 + n * 1024 + col]); a += v; sc += fabsf(v); }
    if (!diag_close(bf2f(ACC[(size_t)row * D + col]), a, sc)) diag_fail(F.ctl, 4 + F.dl);
}
#endif


#if DIAG
__device__ __forceinline__ float wave_max(float v) {
#pragma unroll
    for (int o = 1; o < 64; o <<= 1) v = fmaxf(v, __shfl_xor(v, o));
    return v;
}
__device__ __forceinline__ void chk_attn_window(const Frame& F, const bf16_t* QA, const bf16_t* KA, const bf16_t* P, const float* sink_l, const bf16_t* YB, bool need_ctx) {
    const int s = F.gw; if (s >= 2048) return;
    const int nrows = need_ctx ? MALL : MLAT;
    const int row = (int)(((long)s * 7919) % nrows), hq = s & 3, kvh = hq >> 1, d0 = (s * 13) & 63;
    const bool lat = row < MLAT; const int b = lat ? (row >> 13) : ((row - MLAT) >> 8), t = row & 8191;
    const bf16_t* q = QA + (size_t)row * 256 + hq * 64;
    const float LN2 = 0.6931471805599453f;
    const int k0 = lat ? max(0, t - 128) : 0, k1 = lat ? min(SEQ - 1, t + 128) : -1, nk = k1 - k0 + 1 + CTXL;
    float sc[9]; float m = sink_l[hq];
#pragma unroll
    for (int i = 0; i < 9; ++i) { const int kk = k0 + F.lane + 64 * i; sc[i] = -1e30f;
        if (kk - k0 < nk) { const int krow = (kk <= k1) ? b * SEQ + kk : MLAT + b * CTXL + (kk - k1 - 1); const bf16_t* kp = KA + (size_t)krow * 128 + kvh * 64; float a = 0.f;
            for (int d = 0; d < 64; ++d) a += bf2f(q[d]) * bf2f(kp[d]);
            sc[i] = a * LN2; m = fmaxf(m, sc[i]); } }
    m = wave_max(m);
    float l = 0.f, o = 0.f;
#pragma unroll
    for (int i = 0; i < 9; ++i) { const int kk = k0 + F.lane + 64 * i;
        if (kk - k0 < nk) { const int krow = (kk <= k1) ? b * SEQ + kk : MLAT + b * CTXL + (kk - k1 - 1); const float e = expf(sc[i] - m); l += e; o += e * bf2f(P[(size_t)krow * NINP + 384 + kvh * 64 + d0]); } }
    l = wave_sum(l) + expf(sink_l[hq] - m); o = wave_sum(o);
    if (F.lane == 0 && !diag_close(bf2f(YB[(size_t)row * D + hq * 64 + d0]), o / l, 0.05f)) diag_fail(F.ctl, 5 + F.dl);
}
__device__ __forceinline__ void chk_attn_mla(const Frame& F, const bf16_t* QC, const bf16_t* KC, const bf16_t* VC, const bf16_t* YB, bool need_ctx) {
    const int s = F.gw; if (s >= 1024) return;
    const int nrows = need_ctx ? MALL : MLAT;
    const int row = (s < 960) ? (int)(((long)s * 7919) % MLAT) : (int)(MLAT + ((long)s * 7919) % MCTX);
    if (row >= nrows) return;
    const int hd = s & 3, d0 = (s * 13) & 63;
    const bool lat = row < MLAT; const int b = lat ? (row >> 13) : ((row - MLAT) >> 8);
    const bf16_t* q = QC + (size_t)row * 384 + hd * 96;
    const float LN2 = 0.6931471805599453f;
    const int nk = lat ? CTXL + SEQ : CTXL;
    float m = -1e30f, l = 0.f, o = 0.f;
    for (int pass = 0; pass < 2; ++pass) {
        for (int kk = F.lane; kk < nk; kk += 64) {
            const int krow = kk < CTXL ? MLAT + b * CTXL + kk : b * SEQ + (kk - CTXL);
            const bf16_t* kp = KC + (size_t)krow * 384 + hd * 96; float sc = 0.f;
            for (int d = 0; d < 96; ++d) sc += bf2f(q[d]) * bf2f(kp[d]);
            sc *= LN2;
            if (pass == 0) m = fmaxf(m, sc); else { const float e = expf(sc - m); l += e; o += e * bf2f(VC[(size_t)krow * 256 + hd * 64 + d0]); }
        }
        if (pass == 0) m = wave_max(m);
    }
    l = wave_sum(l); o = wave_sum(o);
    if (F.lane == 0 && !diag_close(bf2f(YB[(size_t)row * D + 512 + hd * 64 + d0]), o / l, 0.02f)) diag_fail(F.ctl, 6 + F.dl);
}
#endif


#if DIAG
__device__ __forceinline__ void rope_ref(int pos, double expo, float& c, float& s) { sincos_d((double)pos * exp(-9.210340371976184 * expo), s, c); }
__device__ __forceinline__ void chk_prep(const Frame& F, const PrepArgs& a) {
    const int s = F.bid * NTHR + F.tid; if (s >= 16384) return;
    const int row = (int)(((long)s * 7919) % MALL); const bool lat = row < MLAT; const int t = lat ? (row & 8191) : ((row - MLAT) & 255), trow = t >> 6, tcol = t & 63;
    const bf16_t* p = a.P + (size_t)row * NINP; bool ok = true;
    const float QS = 0.125f * 1.4426950408889634f;
    const int ty = s % 5, hd = (s >> 3) & 3;
    if (ty == 0) { const int i = (s >> 5) & 31; float c, sn; rope_ref(lat ? 256 + t : t, (double)i / 32.0, c, sn);
        const float q1 = bf2f(p[512 + hd * 64 + i]), q2 = bf2f(p[512 + hd * 64 + 32 + i]), k1 = bf2f(p[768 + hd * 64 + i]) * 0.125f, k2 = bf2f(p[768 + hd * 64 + 32 + i]) * 0.125f;
        ok &= diag_close(bf2f(a.RQ[(size_t)row * 256 + hd * 64 + i]), q1 * c - q2 * sn, 0.02f) && diag_close(bf2f(a.RQ[(size_t)row * 256 + hd * 64 + 32 + i]), q2 * c + q1 * sn, 0.02f);
        ok &= diag_close(bf2f(a.RK[(size_t)row * 256 + hd * 64 + i]), k1 * c - k2 * sn, 0.003f) && diag_close(bf2f(a.RK[(size_t)row * 256 + hd * 64 + 32 + i]), k2 * c + k1 * sn, 0.003f);
    } else if (ty == 1 || ty == 2) { const int j = (s >> 5) & 15, half = (s >> 9) & 1, d1 = half ? 32 + j : j, d2 = d1 + 16, h2 = ty == 1 ? hd : (hd & 1);
        float c = 1.f, sn = 0.f; if (lat) rope_ref(half ? tcol : trow, (double)j / 16.0, c, sn);
        const bf16_t* src = p + (ty == 1 ? 0 : 256) + h2 * 64; const float sc = ty == 1 ? QS : 1.f; const float x1 = bf2f(src[d1]) * sc, x2 = bf2f(src[d2]) * sc;
        const bf16_t* dst = ty == 1 ? a.QA + (size_t)row * 256 + h2 * 64 : a.KA + (size_t)row * 128 + h2 * 64;
        ok &= diag_close(bf2f(dst[d1]), x1 * c - x2 * sn, 0.01f) && diag_close(bf2f(dst[d2]), x2 * c + x1 * sn, 0.01f);
    } else if (ty == 3) { float s2 = 0.f; for (int k = 0; k < 256; ++k) { const float x = bf2f(p[1792 + k]); s2 += x * x; } const float rs = 1.f / sqrtf(s2 / 256.f + NORM_EPS);
        const int k = (s >> 3) & 255; ok &= diag_close(bf2f(a.CQN[(size_t)row * 256 + k]), bf2f(p[1792 + k]) * rs * a.g_qnorm[k], 0.02f);
        float t2 = 0.f; for (int k2 = 0; k2 < 128; ++k2) { const float x = bf2f(p[2048 + k2]); t2 += x * x; } const float rs2 = 1.f / sqrtf(t2 / 128.f + NORM_EPS);
        const int kk = k & 127; ok &= diag_close(bf2f(a.CKVN[(size_t)row * 128 + kk]), bf2f(p[2048 + kk]) * rs2 * a.g_kvnorm[kk], 0.02f);
    } else { const int j = (s >> 5) & 7, half = (s >> 8) & 1, d1 = half * 16 + j, d2 = d1 + 8; float c = 1.f, sn = 0.f; if (lat) rope_ref(half ? tcol : trow, (double)j / 8.0, c, sn);
        const float x1 = bf2f(p[2176 + d1]), x2 = bf2f(p[2176 + d2]); const bf16_t* kc = a.KC + (size_t)row * 384 + hd * 96 + 64;
        ok &= diag_close(bf2f(kc[d1]), x1 * c - x2 * sn, 0.02f) && diag_close(bf2f(kc[d2]), x2 * c + x1 * sn, 0.02f); }
    if (!ok) diag_fail(F.ctl, 7 + F.dl);
}
__device__ __forceinline__ void chk_proj(const Frame& F, const bf16_t* CQN, const bf16_t* CKVN, const float* w_uq_l, const float* w_ukv_l, const bf16_t* QC, const bf16_t* KC, const bf16_t* VC) {
    const int s = F.bid * NTHR + F.tid; if (s >= 16384) return;
    const int row = (int)(((long)s * 7919) % MALL); const bool lat = row < MLAT; const int t = lat ? (row & 8191) : 0, trow = t >> 6, tcol = t & 63;
    const float QS = 0.10206207261596577f * 1.4426950408889634f;
    if (s & 1) { const int col = (int)(((long)s * 104729) % 384), head = col / 96, dd = col % 96;
        float x = 0.f; for (int k = 0; k < 256; ++k) x += bf2f(CQN[(size_t)row * 256 + k]) * bfr(w_uq_l[(size_t)k * 384 + col]);
        float val = x;
        if (dd >= 64 && lat) { const int e = dd - 64, half = e >> 4, j = e & 7; const bool first = (e & 15) < 8; const int pc = first ? col + 8 : col - 8;
            float pr = 0.f; for (int k = 0; k < 256; ++k) pr += bf2f(CQN[(size_t)row * 256 + k]) * bfr(w_uq_l[(size_t)k * 384 + pc]);
            float c, sn; rope_ref(half ? tcol : trow, (double)j / 8.0, c, sn); val = first ? x * c - pr * sn : x * c + pr * sn; }
        if (!diag_close(bf2f(QC[(size_t)row * 384 + head * 96 + dd]), val * QS, 0.01f)) diag_fail(F.ctl, 8 + F.dl);
    } else { const int col = (int)(((long)s * 104729) % 512), head = col >> 7, dd = col & 127;
        float x = 0.f; for (int k = 0; k < 128; ++k) x += bf2f(CKVN[(size_t)row * 128 + k]) * bfr(w_ukv_l[(size_t)k * 512 + col]);
        const float got = dd < 64 ? bf2f(KC[(size_t)row * 384 + head * 96 + dd]) : bf2f(VC[(size_t)row * 256 + head * 64 + dd - 64]);
        if (!diag_close(got, x, 0.03f)) diag_fail(F.ctl, 8 + F.dl); }
}
#endif


#if DIAG
__device__ __forceinline__ float zref(const bf16_t* P, int row, bool first, bool last, int sc, const float* mu) {
    const bf16_t* q = P + (size_t)row * NINP + 2208 + sc; const float c = bf2f(q[0]); const float pv = first ? 0.f : bf2f(*(q - NINP)), nv = last ? 0.f : bf2f(q[NINP]);
    return c + (0.5f * (pv + nv) - c) * mu[sc]; }
__device__ __forceinline__ void chk_rwkv_feat(const Frame& F, const bf16_t* P, const float* mu, const float* w0, const float* w_up  , const float* a0, const float* a_up, const float* g_up  ,
                                              const float* k_k, const float* k_a, const float* r_k, const RwkvF& O) {
    const int s = F.bid * NTHR + F.tid; if (s >= 8192) return;
    const int row = (int)(((long)s * 7919) % MALL), c = (int)(((long)s * 104729) % 256), h = c >> 6;
    const bool lat = row < MLAT; const int t = lat ? (row & 8191) : ((row - MLAT) & 255); const bool first = t == 0, last = t == (lat ? SEQ : CTXL) - 1;
    float pwf = 0.f, pwb = 0.f, paf = 0.f, pab = 0.f, pg = 0.f;
    for (int k = 0; k < 64; ++k) { pwf += bfr(tanhf(zref(P, row, first, last, 768 + k, mu))) * bfr(w_up[(size_t)k * 256 + c]); pwb += bfr(tanhf(zref(P, row, first, last, 832 + k, mu))) * bfr(w_up[(size_t)(64 + k) * 256 + c]);
        paf += bfr(zref(P, row, first, last, 896 + k, mu)) * bfr(a_up[(size_t)k * 256 + c]); pab += bfr(zref(P, row, first, last, 960 + k, mu)) * bfr(a_up[(size_t)(64 + k) * 256 + c]); }
    for (int k = 0; k < 128; ++k) pg += bfr(sigmoid_f(zref(P, row, first, last, 1024 + k, mu))) * bfr(g_up[(size_t)k * 256 + c]);
    float ss = 0.f, bonus = 0.f;
    const float zr = zref(P, row, first, last, c, mu), zk = zref(P, row, first, last, 256 + c, mu), zv = zref(P, row, first, last, 512 + c, mu);
    for (int j = 0; j < 64; ++j) { const float x = zref(P, row, first, last, 256 + 64 * h + j, mu) * k_k[64 * h + j]; ss += x * x; }
    const float kk = zk * k_k[c] / fmaxf(sqrtf(ss), 1e-12f);
    const float ef = expf(-softplus_f(-(w0[c] + pwf)) - 0.5f), eb = expf(-softplus_f(-(w0[256 + c] + pwb)) - 0.5f);
    const float af = sigmoid_f(a0[c] + paf), ab = sigmoid_f(a0[256 + c] + pab);
    const float kf = zk * (1.f + (af - 1.f) * k_a[c]), kb = zk * (1.f + (ab - 1.f) * k_a[c]);
    const size_t o = (size_t)row * 256 + c; bool ok = true;
    ok &= diag_close(bf2f(O.R[o]), zr, 0.02f) && diag_close(bf2f(O.V[o]), zv, 0.02f) && diag_close(bf2f(O.KF[o]), kf, 0.02f) && diag_close(bf2f(O.KB[o]), kb, 0.02f);
    ok &= diag_close(bf2f(O.KK[o]), kk, 0.003f) && diag_close(bf2f(O.BF[o]), kk * af, 0.003f) && diag_close(bf2f(O.BB[o]), kk * ab, 0.003f);
    ok &= diag_close(bf2f(O.EF[o]), ef, 0.0005f) && diag_close(bf2f(O.EB[o]), eb, 0.0005f) && diag_close(bf2f(O.G[o]), pg, 0.02f);
    if ((c & 63) == 0) { for (int j = 0; j < 64; ++j) { const int cc = 64 * h + j; const float zr2 = zref(P, row, first, last, cc, mu); bonus += zr2 * (bf2f(O.KF[(size_t)row * 256 + cc]) + bf2f(O.KB[(size_t)row * 256 + cc])) * r_k[cc]; }
        ok &= diag_close(O.BONUS[(size_t)row * 4 + h], bonus, 0.5f); }
    if (!ok) diag_fail(F.ctl, 9 + F.dl);
}
#endif


#if DIAG
__device__ __forceinline__ void chk_moe(const Frame& F, const bf16_t* XN, const float* router_w, const float* router_b, const float* weg, const float* weu, const float* wed  ,
                                        const int* TOKE, const int* TOKP, const float* TOKW, const bf16_t* Y, int nrows) {
    const LAS int* tb = (const LAS int*)(F.lds + MOE_TAB_OFF);
    const int s = F.gw; if (s >= 512) return;
    const int tok = (int)(((long)s * 7919) % nrows), col = (s * 37) & 1023, lane = F.lane;
    const bf16_t* x = XN + (size_t)tok * D;
    float lg = 0.f; for (int k = 0; k < D; ++k) lg += bf2f(x[k]) * router_w[(size_t)k * 64 + lane];
    const float sc = sigmoid_f(lg);
    const int e0 = TOKE[2 * tok], e1 = TOKE[2 * tok + 1];
    const float s0 = __shfl(sc, e0), s1 = __shfl(sc, e1);
    bool ok = true;
    if ((e0 >> 3) != (e1 >> 3) || e0 == e1) ok = false;
    if (!diag_close(TOKW[2 * tok], s0 / (s0 + s1), 0.01f) || !diag_close(TOKW[2 * tok + 1], s1 / (s0 + s1), 0.01f)) ok = false;
    { const float bsc = sc + router_b[lane]; const float b0 = __shfl(bsc, e0), b1 = __shfl(bsc, e1);
      const bool ing = (lane >> 3) == (e0 >> 3);
      if (ing && lane != e0 && bsc > b0 + 2e-3f) ok = false;
      if (ing && lane != e0 && lane != e1 && bsc > b1 + 2e-3f) ok = false; }
    ok = __all(ok);
    for (int kk = 0; kk < 2; ++kk) {
        const int e = kk ? e1 : e0; const float* wg = weg + (size_t)e * D * 512; const float* wu = weu + (size_t)e * D * 512; const float* wd = wed + (size_t)e * 512 * D;
        float y = 0.f;
        for (int f = lane; f < 512; f += 64) { float g = 0.f, u = 0.f;
            for (int k = 0; k < D; ++k) { const float xv = bf2f(x[k]); g += xv * bfr(wg[(size_t)k * 512 + f]); u += xv * bfr(wu[(size_t)k * 512 + f]); }
            y += bfr(g / (1.f + expf(-g)) * u) * bfr(wd[(size_t)f * D + col]); }
        y = wave_sum(y);
        const int dst = tb[e] + TOKP[2 * tok + kk];
        if (!diag_close(bf2f(Y[(size_t)dst * D + col]), y, 0.02f)) ok = false;
    }
    if (lane == 0 && !ok) diag_fail(F.ctl, 10 + F.dl);
}
#endif


#if DIAG
__device__ __forceinline__ void chk_scans(const Frame& F, const bf16_t* RETY, const bf16_t* RWY, const bf16_t* REF) {
    for (int i = F.bid * NTHR + F.tid; i < 8 * 8448 * 64; i += F.G * NTHR) {
        const int slot = i / (8448 * 64), pos = (i / 64) % 8448, lane = i & 63, task = 9 * (slot & 3), dir = task & 1, hd = (task >> 1) & 3, b = task >> 3;
        const int row = pos < 256 ? MLAT + b * CTXL + pos : b * SEQ + pos - 256;
        const float ref = bf2f(REF[i]), got = bf2f((slot < 4 ? RETY : RWY)[((size_t)dir * MALL + row) * 256 + hd * 64 + lane]);
        const float d = fabsf(got - ref);
        if (!(fabsf(got) < 1e30f)) diag_fail(F.ctl, 6);
        if (!(d <= 0.1f * fabsf(ref) + 0.5f)) diag_fail(F.ctl, 6);
        else if (!(d <= 0.04f * fabsf(ref) + 0.1f)) diag_fail(F.ctl, 6);
    }
}
#endif


#if DIAG
__device__ __forceinline__ void chk_finite(const Frame& F, const bf16_t* p, size_t n, int bit) {
    bool bad = false;
    for (size_t i = (size_t)F.bid * NTHR + F.tid; i < n / 8; i += (size_t)F.G * NTHR) { const u32x4 w = ((const u32x4*)p)[i];
#pragma unroll
        for (int e = 0; e < 4; ++e) { bad |= ((w[e] & 0x7f80u) == 0x7f80u) | ((w[e] & 0x7f800000u) == 0x7f800000u); } }
    if (bad) atomicOr(F.ctl + CW_DIAG + (F.dl ? 1 : 0), 1u << bit);
}
__device__ __forceinline__ void chk_finite_f32(const Frame& F, const float* p, size_t n, int bit) {
    bool bad = false;
    for (size_t i = (size_t)F.bid * NTHR + F.tid; i < n; i += (size_t)F.G * NTHR) bad |= !(fabsf(p[i]) < 1e30f);
    if (bad) atomicOr(F.ctl + CW_DIAG + (F.dl ? 1 : 0), 1u << bit);
}
#endif

typedef const __attribute__((address_space(4))) Args* ArgsP;
#define LAUNDER(p) asm volatile("" : "+s"(p))
#define PHASE_BEGIN_(DL) ArgsP a = ap; LAUNDER(a); unsigned char* ws = a->ws; (void)ws; Frame F = F0; asm volatile("" : "+v"(F.tid), "+v"(F.lane), "+s"(F.wave), "+s"(F.bid), "+s"(F.gw), "+s"(F.G), "+s"(F.ngw)); F.dl = (DL);
#define PHASE_BEGIN PHASE_BEGIN_(0)
#define IN(i) (a->in[i])
#define WSP(T, off) ((T*)(ws + (off)))

#define GRID_BAR() do { XcdBarrier b2_ = bar; asm volatile("" : "+s"(b2_.bar), "+s"(b2_.x)); xcd_barrier(b2_); } while (0)
template <int l> __device__ __forceinline__ void layer_fwd(const Frame& F0, ArgsP ap, const XcdBarrier& bar) {
        const int nrows_out = (l == 0) ? MALL : MLAT;
        const int nM = nrows_out / 256;
#define MODL (WSP(float, WS_MOD) + (size_t)l * 5 * 6144)
        { PHASE_BEGIN_(10 * l)
            SchedP S{WSP(bf16_t, WS_XN), WSP(bf16_t, WS_WIN_T) + (size_t)l * NINP * D, F.G, F.bid}; EpiStoreBf16 E{WSP(bf16_t, T_P), NINP}; pg8::gemm_phase(F.lds, S, E); }
        GRID_BAR();
#if DIAG
        { PHASE_BEGIN_(10 * l) chk_P(F, WSP(bf16_t, WS_XN), IN(8) + (size_t)l * D * NIN, WSP(bf16_t, T_P)); }
#endif
        { PHASE_BEGIN_(10 * l)
            PrepArgs pa{WSP(bf16_t, T_P), WSP(bf16_t, T_QA), WSP(bf16_t, T_KA), WSP(bf16_t, T_RQ), WSP(bf16_t, T_RK), WSP(bf16_t, T_CQN), WSP(bf16_t, T_CKVN), WSP(bf16_t, T_KC),
                        WSP(float, WS_RTAB), WSP(float, WS_TAB), WSP(float, WS_TAB) + 192 * 16 * 2, IN(10) + l * 256, IN(11) + l * 128};
            ph_prep(F, pa); }
#if DIAG
        GRID_BAR();
        { PHASE_BEGIN_(10 * l)
            PrepArgs pa{WSP(bf16_t, T_P), WSP(bf16_t, T_QA), WSP(bf16_t, T_KA), WSP(bf16_t, T_RQ), WSP(bf16_t, T_RK), WSP(bf16_t, T_CQN), WSP(bf16_t, T_CKVN), WSP(bf16_t, T_KC),
                        WSP(float, WS_RTAB), WSP(float, WS_TAB), WSP(float, WS_TAB) + 192 * 16 * 2, IN(10) + l * 256, IN(11) + l * 128};
            chk_prep(F, pa); }
#endif
#define RWF RwkvF{WSP(bf16_t, E_R), WSP(bf16_t, E_V), WSP(bf16_t, E_KF), WSP(bf16_t, E_KB), WSP(bf16_t, E_KK), WSP(bf16_t, E_BF), WSP(bf16_t, E_BB), WSP(bf16_t, E_EF), WSP(bf16_t, E_EB), WSP(bf16_t, E_G), WSP(float, E_BONUS)}
        { PHASE_BEGIN_(10 * l)
            RwkvW rw{IN(14) + l * 1152, IN(15) + l * 512, IN(17) + l * 512, IN(20) + l * 256, IN(21) + l * 256, IN(22) + l * 256,
                     WSP(bf16_t, WS_RWUP_T) + (size_t)l * 2 * 256 * 64, WSP(bf16_t, WS_RAUP_T) + (size_t)l * 2 * 256 * 64, WSP(bf16_t, WS_RGUP_T) + (size_t)l * 256 * 128};
            ph_rwkv_featX(F, WSP(bf16_t, T_P), rw, RWF); }
        GRID_BAR();
        { PHASE_BEGIN_(10 * l) ph_mla_proj(F, WSP(bf16_t, T_CQN), WSP(bf16_t, T_CKVN), WSP(bf16_t, WS_WUQ_T) + (size_t)l * 384 * 256, WSP(bf16_t, WS_WUKV_T) + (size_t)l * 512 * 128,
                                  WSP(float, WS_TAB) + 192 * 16 * 2, WSP(bf16_t, T_QC), WSP(bf16_t, T_KC), WSP(bf16_t, T_VC)); }
        { PHASE_BEGIN_(10 * l)
            RwkvW rw{IN(14) + l * 1152, IN(15) + l * 512, IN(17) + l * 512, IN(20) + l * 256, IN(21) + l * 256, IN(22) + l * 256,
                     WSP(bf16_t, WS_RWUP_T) + (size_t)l * 2 * 256 * 64, WSP(bf16_t, WS_RAUP_T) + (size_t)l * 2 * 256 * 64, WSP(bf16_t, WS_RGUP_T) + (size_t)l * 256 * 128};
            ph_rwkv_featY(F, WSP(bf16_t, T_P), rw, RWF); }
        GRID_BAR();
#if DIAG
        { PHASE_BEGIN_(10 * l) chk_rwkv_feat(F, WSP(bf16_t, T_P), IN(14) + l * 1152, IN(15) + l * 512, IN(16) + (size_t)l * 2 * 64 * 256, IN(17) + l * 512, IN(18) + (size_t)l * 2 * 64 * 256, IN(19) + (size_t)l * 128 * 256,
                                    IN(20) + l * 256, IN(21) + l * 256, IN(22) + l * 256, RWF); }
        { PHASE_BEGIN_(10 * l) chk_proj(F, WSP(bf16_t, T_CQN), WSP(bf16_t, T_CKVN), IN(12) + (size_t)l * 256 * 384, IN(13) + (size_t)l * 128 * 512, WSP(bf16_t, T_QC), WSP(bf16_t, T_KC), WSP(bf16_t, T_VC)); }
#endif
#define RETZ WSP(bf16_t, T_RQ)
        { PHASE_BEGIN_(10 * l) ph_rwkv_w1(F, RWF, WSP(bf16_t, T_PZ), ws); }
        { PHASE_BEGIN_(10 * l) ph_ret_r1(F, WSP(bf16_t, T_P), WSP(float, WS_RTAB), RETZ); }
        GRID_BAR();
#if DIAG
        { PHASE_BEGIN_(10 * l) const u32x4* q = WSP(u32x4, T_PZ); bool left = false;
            for (size_t i = (size_t)F.bid * NTHR + F.tid; i < PZ_BYTES / 16; i += (size_t)F.G * NTHR) { const u32x4 w = q[i]; left |= (w.x == 0x12341234u) & (w.y == 0x12341234u) & (w.z == 0x12341234u) & (w.w == 0x12341234u); }
            if (left) atomicOr(F.ctl + CW_DIAG + 3, 1u << 9); }
        { PHASE_BEGIN_(10 * l) chk_finite(F, WSP(bf16_t, T_PZ), (size_t)32 * NCHUNK * 8192, 13); chk_finite(F, RETZ, (size_t)32 * NCHUNK * 8192, 14);
                               for (int q = 0; q < 10; ++q) chk_finite(F, WSP(bf16_t, E_R) + (size_t)q * MALL * 256, (size_t)MALL * 256, 3 + q);
                               chk_finite(F, WSP(bf16_t, T_P), (size_t)MALL * NINP, 2); chk_finite_f32(F, WSP(float, WS_H), (size_t)MALL * D, 0); }
        GRID_BAR();
#endif
        { PHASE_BEGIN_(10 * l) ph_rwkv_w2(F, WSP(bf16_t, T_PZ)); __syncthreads(); }
        { PHASE_BEGIN_(10 * l)
            if (F.bid >= 64) { LAS float* scr = (LAS float*)(F.lds + F.wave * 16384); const int gw_ = (F.bid - 64) * NWAVES + F.wave, ngw_ = (F.G - 64) * NWAVES;
                TR_BATCH_W(gw_, ngw_, IN(31) + (size_t)l * 64 * D * 512, (size_t)D * 512, NE0, D, 512, WSP(bf16_t, T_EW0), (size_t)1024 * D, D, 0, 1);
                TR_BATCH_W(gw_, ngw_, IN(32) + (size_t)l * 64 * D * 512, (size_t)D * 512, NE0, D, 512, WSP(bf16_t, T_EW0), (size_t)1024 * D, D, 0, 2);
                TR_BATCH_W(gw_, ngw_, IN(33) + (size_t)l * 64 * 512 * D, (size_t)512 * D, NE0, 512, D, WSP(bf16_t, T_EW0D), (size_t)1024 * 512, 512, 0, 0); }
            __syncthreads(); }
        { PHASE_BEGIN_(10 * l) ph_ret_r2(F, RETZ); }
        { PHASE_BEGIN_(10 * l) ph_attn_window(F, WSP(bf16_t, T_QA), WSP(bf16_t, T_KA), WSP(bf16_t, T_P), IN(9) + l * 4, WSP(bf16_t, T_YB), l == 0); }
        { PHASE_BEGIN_(10 * l) ph_attn_mla(F, WSP(bf16_t, T_QC), WSP(bf16_t, T_KC), WSP(bf16_t, T_VC), WSP(bf16_t, T_YB), l == 0); }
        GRID_BAR();
#if DIAG
        { PHASE_BEGIN_(10 * l) chk_finite(F, WSP(bf16_t, T_PZ), (size_t)32 * NCHUNK * 8192, 15); chk_finite(F, RETZ, (size_t)32 * NCHUNK * 8192, 16); }
        GRID_BAR();
#endif
        { PHASE_BEGIN_(10 * l) ph_rwkv_w3(F, RWF, WSP(bf16_t, T_PZ), WSP(bf16_t, T_RWY), ws); }
        { PHASE_BEGIN_(10 * l) ph_ret_r3(F, WSP(bf16_t, T_P), WSP(float, WS_RTAB), RETZ, WSP(bf16_t, T_RETY)); }

        GRID_BAR();
#if DIAG
        { PHASE_BEGIN_(10 * l) chk_attn_window(F, WSP(bf16_t, T_QA), WSP(bf16_t, T_KA), WSP(bf16_t, T_P), IN(9) + l * 4, WSP(bf16_t, T_YB), l == 0); }
        { PHASE_BEGIN_(10 * l) chk_attn_mla(F, WSP(bf16_t, T_QC), WSP(bf16_t, T_KC), WSP(bf16_t, T_VC), WSP(bf16_t, T_YB), l == 0); }
#endif
        { PHASE_BEGIN_(10 * l) ph_rwkv_combine(F, WSP(bf16_t, T_RWY), RWF, IN(23) + l * 256, IN(24) + l * 256, WSP(bf16_t, T_YB), nrows_out); }
        { PHASE_BEGIN_(10 * l) ph_ret_combine(F, WSP(bf16_t, T_P), WSP(bf16_t, T_RETY), WSP(bf16_t, T_YB), nrows_out); }
        GRID_BAR();
        { PHASE_BEGIN_(10 * l)
            SchedMerge S{WSP(bf16_t, T_YB), WSP(bf16_t, WS_XN), WSP(bf16_t, WS_WB_T) + (size_t)l * 4 * D * 256, WSP(bf16_t, WS_WG_T) + (size_t)l * 4096 * D, l == 0 ? 64 : 0, F.G, F.bid};
            EpiMerge E{WSP(bf16_t, T_BOUT), WSP(bf16_t, T_ACC), IN(26) + (size_t)l * 4096};
            pg8::gemm_phase<EpiMerge, SchedMerge, false, true>(F.lds, S, E); }
        GRID_BAR();
        if (l == 0) { { PHASE_BEGIN_(10 * l) ph_sum4(F, WSP(bf16_t, T_BOUT), WSP(bf16_t, T_ACC), MLAT, MCTX); }
            GRID_BAR(); }
        { PHASE_BEGIN_(10 * l)
            SchedOut S{WSP(bf16_t, T_ACC), WSP(bf16_t, WS_WO_T) + (size_t)l * D * D, nM, F.G, F.bid}; EpiResid E{WSP(float, WS_H), MODL + 2 * D, l == 0 ? IN(0) : nullptr, IN(2)}; pg8::gemm_phase(F.lds, S, E); }
        GRID_BAR();
#if DIAG
        if (l == 0) { PHASE_BEGIN_(10 * l) chk_out(F, WSP(bf16_t, T_ACC), IN(28) + (size_t)l * D * D, MODL, IN(0), WSP(float, WS_H)); }
        GRID_BAR();
#endif
#define MOE_CNT (F.ctl + CW_CNT + l * 64 * CNT_STRIDE)
        { PHASE_BEGIN_(10 * l)
            LAS float* scr = (LAS float*)(F.lds + F.wave * 16384);
            TR_BATCH(IN(31) + ((size_t)l * 64 + NE0) * D * 512, (size_t)D * 512, 64 - NE0, D, 512, WSP(bf16_t, E_WGU) + (size_t)NE0 * 1024 * D, (size_t)1024 * D, D, 0, 1);
            TR_BATCH(IN(32) + ((size_t)l * 64 + NE0) * D * 512, (size_t)D * 512, 64 - NE0, D, 512, WSP(bf16_t, E_WGU) + (size_t)NE0 * 1024 * D, (size_t)1024 * D, D, 0, 2);
            TR_BATCH(IN(33) + ((size_t)l * 64 + NE0) * 512 * D, (size_t)512 * D, 64 - NE0, 512, D, WSP(bf16_t, E_WD) + (size_t)NE0 * 1024 * 512, (size_t)1024 * 512, 512, 0, 0);
            __syncthreads();
            ph_moe_route(F, WSP(float, WS_H), MODL, WSP(float, WS_GS2) + (size_t)l * 5 * 1024, WSP(bf16_t, WS_RWHI), WSP(bf16_t, WS_RWLO), IN(30), WSP(bf16_t, WS_XN), MOE_CNT, WSP(int, T_TOKE), WSP(int, T_TOKP), WSP(float, T_TOKW), nrows_out); }
        GRID_BAR();
        { PHASE_BEGIN_(10 * l) moe_table(F, MOE_CNT);
            ph_moe_rowtok(F, MOE_CNT, WSP(int, T_TOKE), WSP(int, T_TOKP), WSP(int, T_ROWTOK), nrows_out); }
        GRID_BAR();
        { PHASE_BEGIN_(10 * l)
            SchedGU S{WSP(bf16_t, WS_XN), WSP(bf16_t, E_WGU), WSP(bf16_t, T_EW0), (const LAS int*)(F.lds + MOE_TAB_OFF), WSP(int, T_ROWTOK), F.G, F.bid}; EpiSwiGLU E{WSP(bf16_t, T_HID)}; pg8::gemm_phase<EpiSwiGLU, SchedGU, true>(F.lds, S, E); }
        GRID_BAR();
        { PHASE_BEGIN_(10 * l)
            SchedDown S{WSP(bf16_t, T_HID), WSP(bf16_t, E_WD), WSP(bf16_t, T_EW0D), (const LAS int*)(F.lds + MOE_TAB_OFF), F.G, F.bid}; EpiStoreBf16 E{WSP(bf16_t, T_Y), D}; pg8::gemm_phase(F.lds, S, E); }
        GRID_BAR();
#if DIAG
        { PHASE_BEGIN_(10 * l) chk_moe(F, WSP(bf16_t, WS_XN), IN(29), IN(30), IN(31) + (size_t)l * 64 * D * 512, IN(32) + (size_t)l * 64 * D * 512, IN(33) + (size_t)l * 64 * 512 * D,
                              WSP(int, T_TOKE), WSP(int, T_TOKP), WSP(float, T_TOKW), WSP(bf16_t, T_Y), nrows_out); }
#endif
        { PHASE_BEGIN_(10 * l) ph_moe_combine_norm<l == 1>(F, WSP(float, WS_H), MODL, WSP(bf16_t, T_Y), WSP(int, T_TOKE), WSP(int, T_TOKP), WSP(float, T_TOKW), nrows_out,
                                                          l == 1 ? IN(34) : IN(6) + D, WSP(float, WS_MOD) + (size_t)5 * 6144, WSP(bf16_t, WS_XN), a->out); }
        if (l == 0) GRID_BAR();
}

__global__ void __launch_bounds__(NTHR, 2) mega_fwd(Args args_unused) {
    extern __shared__ __attribute__((aligned(16))) unsigned char lds_raw[];
    ArgsP ap = (ArgsP)__builtin_amdgcn_kernarg_segment_ptr();
    Frame F0;
    F0.lds = (LAS unsigned char*)lds_raw;
    F0.tid = threadIdx.x; F0.lane = F0.tid & 63; F0.wave = __builtin_amdgcn_readfirstlane(F0.tid >> 6);
    F0.G = gridDim.x; F0.bid = blockIdx.x;
    F0.gw = F0.bid * NWAVES + F0.wave; F0.ngw = F0.G * NWAVES;
    F0.ctl = (unsigned*)(ap->ws + WS_CTL);
    volatile LAS unsigned* MISC = (volatile LAS unsigned*)(F0.lds + MISC_OFF);
    for (int u = F0.tid; u < (LDS_BYTES - LDSCTL_OFF) / 4; u += NTHR) ((LAS unsigned*)(F0.lds + LDSCTL_OFF))[u] = 0u;
    __syncthreads();
    XcdBarrier bar = xcd_barrier_post(F0.ctl + CW_BAR, MISC + 8);

    { PHASE_BEGIN
        ph_mod(F, IN(1), IN(3), IN(4), IN(5), WSP(float, WS_MOD));
        ph_tables(F, WSP(float, WS_RTAB), WSP(float, WS_TAB), WSP(float, WS_TAB) + 192 * 16 * 2);
        ph_router_tables(F, IN(29), WSP(bf16_t, WS_RWHI), WSP(bf16_t, WS_RWLO));
        LAS float* scr = (LAS float*)(F.lds + F.wave * 16384);
        TR_BATCH(IN(8), (size_t)D * NIN, 2, D, NIN, WSP(bf16_t, WS_WIN_T), (size_t)NINP * D, D, 0, 0);
        for (int l = 0; l < 2; ++l) ph_zero16(F, WSP(bf16_t, WS_WIN_T) + ((size_t)l * NINP + NIN) * D, (size_t)(NINP - NIN) * D * 2);
        TR_BATCH(IN(25), (size_t)D * D, 8, D, D, WSP(bf16_t, WS_WG_T), (size_t)D * D, D, 0, 0);
        TR_BATCH(IN(27), (size_t)256 * D, 8, 256, D, WSP(bf16_t, WS_WB_T), (size_t)D * 256, 256, 0, 0);
        TR_BATCH(IN(28), (size_t)D * D, 2, D, D, WSP(bf16_t, WS_WO_T), (size_t)D * D, D, 0, 0);
        TR_BATCH(IN(12), (size_t)256 * 384, 2, 256, 384, WSP(bf16_t, WS_WUQ_T), (size_t)384 * 256, 256, 0, 0);
        TR_BATCH(IN(13), (size_t)128 * 512, 2, 128, 512, WSP(bf16_t, WS_WUKV_T), (size_t)512 * 128, 128, 0, 0);
        TR_BATCH(IN(16), (size_t)64 * 256, 4, 64, 256, WSP(bf16_t, WS_RWUP_T), (size_t)256 * 64, 64, 0, 0);
        TR_BATCH(IN(18), (size_t)64 * 256, 4, 64, 256, WSP(bf16_t, WS_RAUP_T), (size_t)256 * 64, 64, 0, 0);
        TR_BATCH(IN(19), (size_t)128 * 256, 2, 128, 256, WSP(bf16_t, WS_RGUP_T), (size_t)256 * 128, 128, 0, 0);
    }
    GRID_BAR();

    { PHASE_BEGIN ph_copy_h_adaln(F, IN(0), IN(2), WSP(float, WS_H), IN(6), WSP(float, WS_MOD), WSP(bf16_t, WS_XN)); ph_gs2(F, IN(7), WSP(float, WS_MOD), WSP(float, WS_GS2)); }
    GRID_BAR();
    layer_fwd<0>(F0, ap, bar);
    layer_fwd<1>(F0, ap, bar);
#if DIAG
    GRID_BAR();
    { PHASE_BEGIN ph_final(F, IN(0), IN(34), a->out); }
#endif
}

extern "C" void kernel_launch(void* const* d_in, const int* in_sizes, int n_in, void* d_out, int out_size, void* d_ws, size_t ws_size, hipStream_t stream) {
    static int grid = 0;
    if (grid == 0) {
        if (n_in != 35 || out_size != MLAT * D || ws_size < WS_END) { fprintf(stderr, "kernel_launch: unexpected sizes n_in %d out %d ws %zu\n", n_in, out_size, ws_size); grid = -1; return; }
        int dev = 0, cus = 0, per_cu = 0;
        if (hipGetDevice(&dev) != hipSuccess || hipDeviceGetAttribute(&cus, hipDeviceAttributeMultiprocessorCount, dev) != hipSuccess) { grid = -1; return; }
        if (hipFuncSetAttribute((const void*)mega_fwd, hipFuncAttributeMaxDynamicSharedMemorySize, LDS_BYTES) != hipSuccess) { fprintf(stderr, "kernel_launch: hipFuncSetAttribute failed\n"); grid = -1; return; }
        if (hipOccupancyMaxActiveBlocksPerMultiprocessor(&per_cu, (const void*)mega_fwd, NTHR, LDS_BYTES) != hipSuccess || per_cu < 1)
            fprintf(stderr, "kernel_launch: occupancy query reports %d\n", per_cu);
        (void)hipGetLastError();
        grid = cus;
    }
    if (grid < 0) return;
    if (hipMemsetAsync((char*)d_ws + WS_CTL, 0, CTL_BYTES, stream) != hipSuccess) return;
    Args a{};
    for (int i = 0; i < 35; ++i) a.in[i] = (const float*)d_in[i];
    a.out = (float*)d_out; a.ws = (unsigned char*)d_ws; a.ph_lo = 0; a.ph_hi = 1000;
    hipLaunchKernelGGL(mega_fwd, dim3(grid), dim3(NTHR), LDS_BYTES, stream, a);
}
```
